# Optimizing an MI355X kernel written in HIP

```python
import jax, jax.numpy as jnp
from jax import lax
import numpy as np

D_MODEL = 1024
BATCH = 4
SEQ = 8192
DEPTH = 4

GRID_W = 64
CTX_LEN = 256
CHUNK = 128
ROWS_PER_CHUNK = CHUNK // GRID_W
A_HEADS = 4
A_HEAD_DIM = 64
A_WIDTH = A_HEADS * A_HEAD_DIM
B_HEADS = 4
B_DK = 64
B_DV = 128
B_QK = B_HEADS * B_DK
B_WIDTH = B_HEADS * B_DV
GATE_RANK = 16
GATE_TAU = 16.0
GLA_CHUNK = 64
S5_GROUPS = 16
S5_GROUP_CH = 16
S5_STATE = 64
C_WIDTH = S5_GROUPS * S5_GROUP_CH
MIX_WIDTH = A_WIDTH + B_WIDTH + C_WIDTH
IN_SPLITS = (A_WIDTH, A_WIDTH, B_QK, B_QK, B_WIDTH, B_WIDTH, 2 * GATE_RANK, C_WIDTH)
N_IN = sum(IN_SPLITS)
N_EXPERTS = 32
TOP_K = 4
D_EXPERT = 1024
SWIGLU_LIMIT = 7.0
SWIGLU_ALPHA = 1.702
MOE_BLOCK = 128
DN_ALPHA = (2 * DEPTH) ** 0.25
DN_BETA = (8 * DEPTH) ** -0.25
LN_EPS = 1e-5

kernel_name = 'hybrid_gmlp_gla_s5_moe_deepnorm_dit'

F32 = jnp.float32


def layer_norm(x, g, b):
    xf = x.astype(F32)
    mu = xf.mean(-1, keepdims=True)
    var = jnp.square(xf - mu).mean(-1, keepdims=True)
    return ((xf - mu) * lax.rsqrt(var + LN_EPS) * g + b).astype(x.dtype)


def chunk_spatial_gate(u, v, n_chunks, ln_g, ln_b, w_s, b_s):
    bsz, L, _ = u.shape
    v = layer_norm(v, ln_g, ln_b).reshape(bsz, n_chunks, CHUNK, A_HEADS, A_HEAD_DIM)
    mixed = jnp.einsum('hts,bnshc->bnthc', w_s, v) + b_s.T[:, :, None]
    return u * mixed.reshape(bsz, L, A_WIDTH)


def gla_direction(q, k, v, log_a, s0, strict, need_out):
    bsz, nh, L, dk = q.shape
    dv = v.shape[-1]
    n = L // GLA_CHUNK
    shp = (bsz, nh, n, GLA_CHUNK)
    q = q.reshape(*shp, dk)
    k = k.reshape(*shp, dk)
    v = v.reshape(*shp, dv)
    b = jnp.cumsum(log_a.reshape(*shp, dk).astype(F32), axis=3)
    b_last = b[:, :, :, -1:, :]
    ds = jnp.einsum('bhncd,bhnce->bhnde', k * jnp.exp(b_last - b), v)
    decay = jnp.exp(b_last[:, :, :, 0, :])

    def step(s, inp):
        ds_n, dec_n = inp
        return dec_n[..., None] * s + ds_n, s

    s_final, s_prev = lax.scan(step, s0, (jnp.moveaxis(ds, 2, 0), jnp.moveaxis(decay, 2, 0)))
    if not need_out:
        return None, s_final
    s_prev = jnp.moveaxis(s_prev, 0, 2)
    b_mid = b[:, :, :, GLA_CHUNK // 2:GLA_CHUNK // 2 + 1, :]
    scores = jnp.einsum('bhncd,bhnsd->bhncs', q * jnp.exp(b - b_mid), k * jnp.exp(b_mid - b))
    mask = jnp.tril(jnp.ones((GLA_CHUNK, GLA_CHUNK), bool), -1 if strict else 0)
    o = (jnp.einsum('bhncs,bhnse->bhnce', jnp.where(mask, scores, 0.0), v)
         + jnp.einsum('bhncd,bhnde->bhnce', q * jnp.exp(b), s_prev))
    return o.reshape(bsz, nh, L, dv), s_final


def gla_mixer(q, k, v, g, gl, gate_up, gate_b, norm_g, s0, need_out):
    bsz, L, _ = q.shape

    def heads(t, d):
        return t.reshape(bsz, L, B_HEADS, d).transpose(0, 2, 1, 3)

    def flip(t):
        return jnp.flip(t, axis=2)

    qh = heads(q, B_DK) * B_DK ** -0.5
    kh = heads(k, B_DK)
    vh = heads(v, B_DV)
    gl = gl.reshape(bsz, L, 2, GATE_RANK).astype(F32)
    log_a = jax.nn.log_sigmoid(jnp.einsum('blzr,zrk->zblk', gl, gate_up.astype(F32))
                               + gate_b.astype(F32)[:, None, None, :]) / GATE_TAU
    o_f, s_f = gla_direction(qh, kh, vh, heads(log_a[0], B_DK), s0[0], False, need_out)
    o_b, s_b = gla_direction(flip(qh), flip(kh), flip(vh), flip(heads(log_a[1], B_DK)), s0[1], True, need_out)
    states = jnp.stack([s_f, s_b])
    if not need_out:
        return None, states
    o = o_f + flip(o_b)
    o = o * lax.rsqrt(jnp.mean(jnp.square(o), -1, keepdims=True) + LN_EPS)
    o = o.transpose(0, 2, 1, 3).reshape(bsz, L, B_WIDTH) * norm_g
    return (o * jax.nn.silu(g)).astype(q.dtype), states


def _linear_combine(e1, e2):
    a1, b1 = e1
    a2, b2 = e2
    return a1 * a2, a2 * b1 + b2


def s5_direction(u, lam, dt, b_mat, c_mat, h0, reverse, need_out):
    lam_bar = jnp.exp(lam * dt[:, None])
    b_bar = ((lam_bar - 1.0) / lam)[..., None] * b_mat
    bu = jnp.einsum('blgh,gph->blgp', u, b_bar)
    edge = -1 if reverse else 0
    bu = bu.at[:, edge].add(lam_bar * h0)
    a = jnp.broadcast_to(lam_bar, bu.shape)
    _, h = lax.associative_scan(_linear_combine, (a, bu), axis=1, reverse=reverse)
    h_final = h[:, 0] if reverse else h[:, -1]
    if not need_out:
        return None, h_final
    return jnp.real(jnp.einsum('blgp,ghp->blgh', h, c_mat)), h_final


def s5_mixer(u, lam_re, lam_im, log_dt, b_re, b_im, c_re, c_im, d_skip, glu_w, glu_b, h0, need_out):
    bsz, L, _ = u.shape
    uf = u.astype(F32).reshape(bsz, L, S5_GROUPS, S5_GROUP_CH)

    def cplx(re, im):
        return lax.complex(re.astype(F32), im.astype(F32))

    lam = cplx(lam_re, lam_im)
    bm = cplx(b_re, b_im)
    cm = cplx(c_re, c_im)
    dt = jnp.exp(log_dt.astype(F32))
    y_f, h_f = s5_direction(uf, lam[0], dt[0], bm[0], cm[0], h0[0], False, need_out)
    y_b, h_b = s5_direction(uf, lam[1], dt[1], bm[1], cm[1], h0[1], True, need_out)
    states = jnp.stack([h_f, h_b])
    if not need_out:
        return None, states
    y = jax.nn.gelu((y_f + y_b + d_skip.astype(F32) * uf).reshape(bsz, L, C_WIDTH))
    return (y * jax.nn.sigmoid(y @ glu_w.astype(F32) + glu_b.astype(F32))).astype(u.dtype), states


def token_mixer(h, n_chunks, w_in, sgu_ln_g, sgu_ln_b, sgu_w, sgu_b, gla_gate_up, gla_gate_b, gla_norm_g,
                s5_lam_re, s5_lam_im, s5_log_dt, s5_b_re, s5_b_im, s5_c_re, s5_c_im, s5_d, s5_glu_w, s5_glu_b,
                gla_s0, s5_h0, need_out):
    proj = h @ w_in
    offsets = [int(o) for o in np.cumsum(IN_SPLITS)[:-1]]
    a_u, a_v, q, k, v, g, gl, s5_u = jnp.split(proj, offsets, axis=-1)
    gla_out, gla_state = gla_mixer(q, k, v, g, gl, gla_gate_up, gla_gate_b, gla_norm_g, gla_s0, need_out)
    s5_out, s5_state = s5_mixer(s5_u, s5_lam_re, s5_lam_im, s5_log_dt, s5_b_re, s5_b_im, s5_c_re, s5_c_im,
                                s5_d, s5_glu_w, s5_glu_b, s5_h0, need_out)
    if not need_out:
        return None, gla_state, s5_state
    a_out = chunk_spatial_gate(jax.nn.gelu(a_u), jax.nn.gelu(a_v), n_chunks, sgu_ln_g, sgu_ln_b, sgu_w, sgu_b)
    mixed = jnp.concatenate([a_out, gla_out.astype(a_out.dtype), s5_out.astype(a_out.dtype)], axis=-1)
    return mixed, gla_state, s5_state


def moe(h, router_w, router_b, w_up, b_up, w_down, b_down):
    n_tok, d = h.shape
    logits = h.astype(F32) @ router_w.astype(F32) + router_b.astype(F32)
    top_logit, top_idx = lax.top_k(logits, TOP_K)
    gates = jax.nn.softmax(top_logit, axis=-1)
    n_assign = n_tok * TOP_K
    flat_e = top_idx.reshape(-1).astype(jnp.int32)
    order = jnp.argsort(flat_e)
    sorted_e = flat_e[order]
    counts = jnp.bincount(flat_e, length=N_EXPERTS).astype(jnp.int32)
    padded = (counts + MOE_BLOCK - 1) // MOE_BLOCK * MOE_BLOCK
    padded_end = jnp.cumsum(padded)
    group_start = jnp.cumsum(counts) - counts
    dest = (padded_end - padded)[sorted_e] + jnp.arange(n_assign, dtype=jnp.int32) - group_start[sorted_e]
    n_blocks = (n_assign + N_EXPERTS * (MOE_BLOCK - 1) + MOE_BLOCK - 1) // MOE_BLOCK
    slot_token = jnp.zeros(n_blocks * MOE_BLOCK, jnp.int32).at[dest].set((order // TOP_K).astype(jnp.int32))
    block_expert = jnp.minimum(
        jnp.searchsorted(padded_end, jnp.arange(n_blocks, dtype=jnp.int32) * MOE_BLOCK, side='right'),
        N_EXPERTS - 1)

    def expert_block(args):
        tok, e = args
        up = h[tok] @ w_up[e] + b_up[e]
        x_glu = jnp.minimum(up[:, :D_EXPERT], SWIGLU_LIMIT)
        x_lin = jnp.clip(up[:, D_EXPERT:], -SWIGLU_LIMIT, SWIGLU_LIMIT)
        act = x_glu * jax.nn.sigmoid(SWIGLU_ALPHA * x_glu) * (x_lin + 1.0)
        return act @ w_down[e] + b_down[e]

    ys = lax.map(expert_block, (slot_token.reshape(n_blocks, MOE_BLOCK), block_expert))
    dest_of_assign = jnp.zeros(n_assign, jnp.int32).at[order].set(dest)
    y = ys.reshape(-1, d)[dest_of_assign].reshape(n_tok, TOP_K, d)
    return jnp.einsum('tk,tkd->td', gates.astype(y.dtype), y)


def setup_inputs(seed: int = 0) -> dict:
    key = jax.random.key(seed)
    ks = jax.random.split(key, 40)

    def nrm(k, shape, scale):
        return jax.random.normal(k, shape, F32) * scale

    n_idx = jnp.arange(S5_STATE, dtype=F32)
    return {
        'x': nrm(ks[0], (BATCH, SEQ, D_MODEL), 1.0),
        'c': nrm(ks[1], (BATCH, D_MODEL), 1.0),
        'ctx': nrm(ks[2], (BATCH, CTX_LEN, D_MODEL), 1.0),
        'c_ctx': nrm(ks[3], (D_MODEL,), 1.0),
        'w_mod': nrm(ks[4], (DEPTH, D_MODEL, 6 * D_MODEL), D_MODEL ** -0.5),
        'b_mod': nrm(ks[5], (DEPTH, 6 * D_MODEL), 0.02),
        'w_in': nrm(ks[6], (DEPTH, D_MODEL, N_IN), D_MODEL ** -0.5),
        'sgu_ln_g': 1.0 + nrm(ks[7], (DEPTH, A_WIDTH), 0.02),
        'sgu_ln_b': nrm(ks[8], (DEPTH, A_WIDTH), 0.02),
        'sgu_w': nrm(ks[9], (DEPTH, A_HEADS, CHUNK, CHUNK), CHUNK ** -0.5),
        'sgu_b': 1.0 + nrm(ks[10], (DEPTH, A_HEADS, CHUNK), 0.1),
        'gla_gate_up': nrm(ks[11], (DEPTH, 2, GATE_RANK, B_QK), GATE_RANK ** -0.5),
        'gla_gate_b': nrm(ks[12], (DEPTH, 2, B_QK), 0.1),
        'gla_norm_g': 1.0 + nrm(ks[13], (DEPTH, B_WIDTH), 0.02),
        's5_lam_re': -0.5 + nrm(ks[14], (DEPTH, 2, S5_GROUPS, S5_STATE), 0.01),
        's5_lam_im': jnp.pi * n_idx + nrm(ks[15], (DEPTH, 2, S5_GROUPS, S5_STATE), 0.01),
        's5_log_dt': jax.random.uniform(ks[16], (DEPTH, 2, S5_GROUPS), F32, float(np.log(1e-3)), float(np.log(1e-1))),
        's5_b_re': nrm(ks[17], (DEPTH, 2, S5_GROUPS, S5_STATE, S5_GROUP_CH), (2 * S5_GROUP_CH) ** -0.5),
        's5_b_im': nrm(ks[18], (DEPTH, 2, S5_GROUPS, S5_STATE, S5_GROUP_CH), (2 * S5_GROUP_CH) ** -0.5),
        's5_c_re': nrm(ks[19], (DEPTH, 2, S5_GROUPS, S5_GROUP_CH, S5_STATE), (2 * S5_STATE) ** -0.5),
        's5_c_im': nrm(ks[20], (DEPTH, 2, S5_GROUPS, S5_GROUP_CH, S5_STATE), (2 * S5_STATE) ** -0.5),
        's5_d': nrm(ks[21], (DEPTH, S5_GROUPS, S5_GROUP_CH), 1.0),
        's5_glu_w': nrm(ks[22], (DEPTH, C_WIDTH, C_WIDTH), C_WIDTH ** -0.5),
        's5_glu_b': nrm(ks[23], (DEPTH, C_WIDTH), 0.02),
        'w_out': nrm(ks[24], (DEPTH, MIX_WIDTH, D_MODEL), MIX_WIDTH ** -0.5 * DN_BETA),
        'ln_g': 1.0 + nrm(ks[25], (DEPTH, 2, D_MODEL), 0.02),
        'ln_b': nrm(ks[26], (DEPTH, 2, D_MODEL), 0.02),
        'router_w': nrm(ks[27], (DEPTH, D_MODEL, N_EXPERTS), D_MODEL ** -0.5),
        'router_b': nrm(ks[28], (DEPTH, N_EXPERTS), 0.01),
        'w_up': nrm(ks[29], (DEPTH, N_EXPERTS, D_MODEL, 2 * D_EXPERT), D_MODEL ** -0.5),
        'b_up': nrm(ks[30], (DEPTH, N_EXPERTS, 2 * D_EXPERT), 0.02),
        'w_down': nrm(ks[31], (DEPTH, N_EXPERTS, D_EXPERT, D_MODEL), D_EXPERT ** -0.5 * DN_BETA),
        'b_down': nrm(ks[32], (DEPTH, N_EXPERTS, D_MODEL), 0.02),
    }


def reference(x, c, ctx, c_ctx, w_mod, b_mod, w_in, sgu_ln_g, sgu_ln_b, sgu_w, sgu_b, gla_gate_up, gla_gate_b,
              gla_norm_g, s5_lam_re, s5_lam_im, s5_log_dt, s5_b_re, s5_b_im, s5_c_re, s5_c_im, s5_d, s5_glu_w,
              s5_glu_b, w_out, ln_g, ln_b, router_w, router_b, w_up, b_up, w_down, b_down):
    bsz, n_lat, d = x.shape
    rows = n_lat // GRID_W
    lat_chunks = rows // ROWS_PER_CHUNK
    ctx_chunks = ctx.shape[1] // CHUNK
    xc = ctx
    for l in range(DEPTH):
        last = l == DEPTH - 1
        mod = jax.nn.silu(c) @ w_mod[l] + b_mod[l]
        mod_c = jax.nn.silu(c_ctx) @ w_mod[l] + b_mod[l]
        sh1, sc1, g1, sh2, sc2, g2 = jnp.split(mod[:, None, :], 6, axis=-1)
        cmod = jnp.split(mod_c, 6)
        lp = (w_in[l], sgu_ln_g[l], sgu_ln_b[l], sgu_w[l], sgu_b[l], gla_gate_up[l], gla_gate_b[l], gla_norm_g[l],
              s5_lam_re[l], s5_lam_im[l], s5_log_dt[l], s5_b_re[l], s5_b_im[l], s5_c_re[l], s5_c_im[l], s5_d[l],
              s5_glu_w[l], s5_glu_b[l])
        gla0 = jnp.zeros((2, bsz, B_HEADS, B_DK, B_DV), F32)
        s50 = jnp.zeros((2, bsz, S5_GROUPS, S5_STATE), jnp.complex64)
        mix_c, gla_sc, s5_sc = token_mixer(xc * (1.0 + cmod[1]) + cmod[0], ctx_chunks, *lp, gla0, s50, not last)
        mix_x, _, _ = token_mixer(x * (1.0 + sc1) + sh1, lat_chunks, *lp, gla_sc, s5_sc, True)
        x = layer_norm(DN_ALPHA * x + g1 * (mix_x @ w_out[l]), ln_g[l, 0], ln_b[l, 0])
        h2 = (x * (1.0 + sc2) + sh2).reshape(-1, d)
        if not last:
            xc = layer_norm(DN_ALPHA * xc + cmod[2] * (mix_c @ w_out[l]), ln_g[l, 0], ln_b[l, 0])
            hc2 = (xc * (1.0 + cmod[4]) + cmod[3]).reshape(-1, d)
            f = moe(jnp.concatenate([h2, hc2], axis=0), router_w[l], router_b[l], w_up[l], b_up[l], w_down[l], b_down[l])
            fx = f[:bsz * n_lat].reshape(x.shape)
            xc = layer_norm(DN_ALPHA * xc + cmod[5] * f[bsz * n_lat:].reshape(xc.shape), ln_g[l, 1], ln_b[l, 1])
        else:
            fx = moe(h2, router_w[l], router_b[l], w_up[l], b_up[l], w_down[l], b_down[l]).reshape(x.shape)
        x = layer_norm(DN_ALPHA * x + g2 * fx, ln_g[l, 1], ln_b[l, 1])
    return x
```

```cpp
#include <hip/hip_runtime.h>
#include <cstdio>
#include <cstdint>

#ifndef MK_N_LAUNCHES
#define MK_N_LAUNCHES 1
#endif

#define GAS __attribute__((address_space(1)))
#define LAS __attribute__((address_space(3)))
typedef unsigned short bf16_t;
typedef short bf16x8 __attribute__((ext_vector_type(8)));
typedef float f32x4 __attribute__((ext_vector_type(4)));
typedef float f32x2 __attribute__((ext_vector_type(2)));
typedef unsigned u32x4 __attribute__((ext_vector_type(4)));
typedef unsigned u32x2 __attribute__((ext_vector_type(2)));

constexpr int D = 1024, NB = 4, SEQ = 8192, DEPTH = 4, CTXL = 256;
constexpr int TLAT = NB * SEQ, TCTX = NB * CTXL, T = TLAT + TCTX;
constexpr int NIN = 2336, NINP = 2560, PROJW = 2048;
constexpr int NCH = T / 64, NCHP = 768;
constexpr int NEXP = 32, DEXP = 1024;
constexpr int MAXTILES = 560, NSLOT = MAXTILES * 256;
constexpr int S5K = 1280;
constexpr float LN_EPS = 1e-5f;
constexpr float DN_ALPHA = 1.681792830507429f;
constexpr int NWAVES = 8, NTHR = 512;

constexpr size_t MiB = 1u << 20;
constexpr size_t WS_CTL = 0, CTL_ZERO_BYTES = 1 * MiB;
constexpr size_t WS_MODP = 1 * MiB, WS_MOD = 5 * MiB, WS_LB64 = 6 * MiB, WS_KTAB = 7 * MiB, WS_SGUW = 15 * MiB, WS_GLUT = 16 * MiB;
constexpr size_t WS_WIN = 17 * MiB, WS_WOUT = 37 * MiB, WS_S5M = 45 * MiB, WS_S5F = 205 * MiB, WS_WUP = 237 * MiB, WS_WDN = 749 * MiB;
constexpr size_t WS_X = 1005 * MiB, WS_H = 1137 * MiB, WS_PROJ = 1203 * MiB, WS_GL = 1335 * MiB, WS_UCAT = 1340 * MiB, WS_HLOC = 1370 * MiB;
constexpr size_t WS_YS5 = 1382 * MiB, WS_QS = 1399 * MiB, WS_KS = 1432 * MiB, WS_QH = 1465 * MiB, WS_VT = 1498 * MiB, WS_GLAST = 1531 * MiB;
constexpr size_t WS_SPREV = 1663 * MiB, WS_GDEC = 1729 * MiB, WS_MIXED = 1731 * MiB, WS_TMP = 1797 * MiB, WS_TOPI = 1929 * MiB, WS_GATE = 1930 * MiB;
constexpr size_t WS_WGCNT = 1931 * MiB, WS_ECNT = 1932 * MiB, WS_SLOTTOK = 1933 * MiB, WS_TOKSLOT = 1934 * MiB, WS_ACT = 1935 * MiB, WS_YV = 2215 * MiB;
constexpr size_t WS_END = 2495 * MiB;
constexpr int CW_BAR = 4096;

constexpr int RING_BYTES = 131072;
constexpr int LDS_BYTES = 163840;
constexpr int LDSCTL_OFF = LDS_BYTES - 1024;

__device__ __forceinline__ float bf2f(unsigned b) { return __uint_as_float(b << 16); }
__device__ __forceinline__ unsigned f2bf(float f) { unsigned u = __float_as_uint(f); return (u + 0x7fffu + ((u >> 16) & 1u)) >> 16; }
__device__ __forceinline__ unsigned pk2(float lo, float hi) { return f2bf(lo) | (f2bf(hi) << 16); }
__device__ __forceinline__ unsigned cvt_pk_bf16(float lo, float hi) { unsigned r; asm volatile("v_cvt_pk_bf16_f32 %0, %1, %2" : "=v"(r) : "v"(lo), "v"(hi)); return r; }
__device__ __forceinline__ float rcpf(float x) { return __builtin_amdgcn_rcpf(x); }
__device__ __forceinline__ float sigmoidf_(float x) { return rcpf(1.0f + __expf(-x)); }
__device__ __forceinline__ float siluf_(float x) { return x * sigmoidf_(x); }
__device__ __forceinline__ float gelu_tanh(float x) { const float u = 0.7978845608028654f * (x + 0.044715f * x * x * x); const float e = __expf(2.0f * u); return x * (1.0f - rcpf(1.0f + e)); }
__device__ __forceinline__ float logsigmoidf_(float x) { return fminf(x, 0.0f) - __logf(1.0f + __expf(-fabsf(x))); }
__device__ __forceinline__ float wave_sum(float v) {
#pragma unroll
    for (int o = 1; o < 64; o <<= 1) v += __shfl_xor(v, o);
    return v;
}
__device__ __forceinline__ int opq(int x) { asm volatile("" : "+v"(x)); return x; }
__device__ __forceinline__ int tok_vec(int tk) { return tk < TLAT ? (tk >> 13) : 4; }

#define XB_TMO      128
#define XB_XCNT(j)  (256  + 64 * (j))
#define XB_XSUB(j)  (1280 + 64 * (j))
#define XB_XGEN(j)  (2304 + 64 * (j))
#define XB_TOP      3328
#define XB_TOPGEN   3392
#define XCD_BAR_WORDS 3456
#define XB_SPIN_CAP (1u << 20)
__device__ __forceinline__ unsigned xb_ld(unsigned* p)              { return __hip_atomic_load(p, __ATOMIC_RELAXED, __HIP_MEMORY_SCOPE_AGENT); }
__device__ __forceinline__ unsigned xb_add(unsigned* p, unsigned v) { return __hip_atomic_fetch_add(p, v, __ATOMIC_RELAXED, __HIP_MEMORY_SCOPE_AGENT); }
__device__ __forceinline__ unsigned xb_xcc_id() { return (unsigned)__builtin_amdgcn_s_getreg((3 << 11) | 20) & 0xFu; }
#define XB_SPIN(cond, bar) do { unsigned _sp = 0; while (cond) { __builtin_amdgcn_s_sleep(1); \
    if ((++_sp & 255u) == 0u) { if (xb_ld(&(bar)[XB_TMO])) break; if (_sp > XB_SPIN_CAP) { atomicAdd(&(bar)[XB_TMO], 1u); break; } } } } while (0)
struct XcdBarrier { unsigned* bar; unsigned x; volatile LAS unsigned* st; };
__device__ __forceinline__ XcdBarrier xcd_barrier_post(unsigned* bar, volatile LAS unsigned* st) {
    XcdBarrier b; b.bar = bar; b.x = xb_xcc_id(); b.st = st;
    if (threadIdx.x == 0) (void)xb_add(&bar[XB_XCNT(b.x)], 1u);
    return b;
}
__device__ __forceinline__ void xcd_barrier_complete(unsigned* bar, unsigned x, unsigned& nloc, unsigned& nx) {
    const unsigned G = gridDim.x * gridDim.y * gridDim.z;
    unsigned sum, cnt, mine, sp = 0u;
    for (;;) {
        sum = 0u; cnt = 0u; mine = 0u;
#pragma unroll
        for (unsigned j = 0; j < 16; ++j) { const unsigned c = xb_ld(&bar[XB_XCNT(j)]); sum += c; cnt += (c > 0u) ? 1u : 0u; mine = (j == x) ? c : mine; }
        if (sum == G) break;
        __builtin_amdgcn_s_sleep(1);
        if ((++sp & 255u) == 0u) { if (xb_ld(&bar[XB_TMO])) break; if (sp > XB_SPIN_CAP) { atomicAdd(&bar[XB_TMO], 1u); break; } }
    }
    nloc = mine > 0u ? mine : 1u; nx = cnt > 0u ? cnt : 1u;
}
__device__ __forceinline__ void xcd_barrier(const XcdBarrier& b) {
    asm volatile("s_waitcnt vmcnt(0)" ::: "memory");
    __syncthreads();
    if (threadIdx.x == 0) {
        unsigned* bar = b.bar;
        __builtin_amdgcn_s_waitcnt(0);
        unsigned nloc = b.st[0], nx = b.st[1];
        if (nloc == 0u) { xcd_barrier_complete(bar, b.x, nloc, nx); b.st[0] = nloc; b.st[1] = nx; }
        const unsigned old = xb_add(&bar[XB_XSUB(b.x)], 1u);
        const unsigned gen = old / nloc;
        if (old + 1u == (gen + 1u) * nloc) {
            __builtin_amdgcn_fence(__ATOMIC_RELEASE, "agent");
            asm volatile("s_waitcnt vmcnt(0)" ::: "memory");
            const unsigned og = xb_add(&bar[XB_TOP], 1u);
            const unsigned tg = og / nx;
            if (og + 1u == (tg + 1u) * nx) xb_add(&bar[XB_TOPGEN], 1u);
            else XB_SPIN(xb_ld(&bar[XB_TOPGEN]) == tg, bar);
            __builtin_amdgcn_fence(__ATOMIC_ACQUIRE, "agent");
            xb_add(&bar[XB_XGEN(b.x)], 1u);
            asm volatile("s_waitcnt vmcnt(0)" ::: "memory");
        } else {
            XB_SPIN(xb_ld(&bar[XB_XGEN(b.x)]) == gen, bar);
            __builtin_amdgcn_fence(__ATOMIC_ACQUIRE, "agent");
            asm volatile("s_waitcnt vmcnt(0)" ::: "memory");
        }
    }
    __syncthreads();
}

namespace pg8 {
constexpr int BM = 256, BK = 64, HALF = 128, HTB = HALF * BK * 2, STAGE_BYTES = 8 * HTB, NXCD = 8, WGM = 8;
__host__ __device__ __forceinline__ int lds_byte(int r, int c) { const int st = (r >> 4) * 2 + (c >> 5), rr = r & 15, cc = c & 31, ob = rr * 64 + cc * 2; return st * 1024 + (ob ^ (((ob >> 9) & 1) << 5)); }
__host__ __device__ __forceinline__ void stage_rc(int b, int& R, int& C) { const int st = b / 1024, sb = b % 1024, swz = sb ^ (((sb >> 9) & 1) << 5); R = (st >> 1) * 16 + swz / 64; C = (st & 1) * 32 + (swz % 64) / 2; }
__host__ __device__ __forceinline__ int perm32(int rho) { const int n = rho >> 4, i = rho & 15; return 8 * (i >> 2) + 4 * n + (i & 3); }

struct GUnit { const char* a; const char* b; const int* rows; int pm, pn, grp; };

template <class Epi, class Sched, bool GATHER>
__device__ __forceinline__ void gemm_phase(LAS unsigned char* lds, const unsigned lda, const unsigned ldb, const int K, const Sched& S, const Epi& E) {
    const int tid = opq((int)threadIdx.x), wid = __builtin_amdgcn_readfirstlane(tid >> 6), lane = tid & 63, wr = wid >> 2, wc = wid & 3, fr = lane & 15, fq = lane >> 4;
    int Kq = K; asm volatile("" : "+s"(Kq)); const int nt = Kq / BK;
    int Rr[2]; unsigned Cb[2], voffB[2], cA0[2], cA1[2], nA0[2], nA1[2];
#pragma unroll
    for (int i = 0; i < 2; ++i) { int R, C; stage_rc(tid * 16 + i * 8192, R, C); const int Rb = Epi::PERM ? ((R & ~31) + perm32(R & 31)) : R;
        Rr[i] = R; Cb[i] = (unsigned)C * 2u; voffB[i] = (unsigned)Rb * ldb + (unsigned)C * 2u; }
    const size_t kstep = (size_t)(BK * 2);
    const size_t hstepB = (size_t)HALF * ldb;
    const unsigned ldsw = (unsigned)wid * 1024u;
    const int aoff = lds_byte(wr * 64 + fr, fq * 8), boff = lds_byte(wc * 32 + fr, fq * 8);
#define PG8_AOFF(u, o0, o1) do { _Pragma("unroll") for (int _i = 0; _i < 2; ++_i) { \
        if (GATHER) { o0[_i] = (unsigned)(u).rows[Rr[_i]] * lda + Cb[_i]; o1[_i] = (unsigned)(u).rows[Rr[_i] + HALF] * lda + Cb[_i]; } \
        else { o0[_i] = (unsigned)Rr[_i] * lda + Cb[_i]; o1[_i] = o0[_i] + (unsigned)HALF * lda; } } } while (0)
#define PG8_SA(b, h) (((b) * 2 + (h)) * HTB)
#define PG8_SB(b, h) ((4 + (b) * 2 + (h)) * HTB)
#define PG8_STAGE(bufoff, gbase, voff) do { _Pragma("unroll") for (int _i = 0; _i < 2; ++_i) \
        __builtin_amdgcn_global_load_lds((const unsigned*)((const char*)(gbase) + (voff)[_i]), (LAS unsigned*)(lds + (bufoff) + ldsw + _i * 8192), 16, 0, 0); } while (0)
#define PG8_LDA(dst, b, h) do { _Pragma("unroll") for (int m = 0; m < 4; ++m) _Pragma("unroll") for (int k = 0; k < 2; ++k) dst[m][k] = *(const LAS bf16x8*)(lds + PG8_SA(b, h) + aoff + m * 2048 + k * 1024); } while (0)
#define PG8_LDB(dst, b, h) do { _Pragma("unroll") for (int n = 0; n < 2; ++n) _Pragma("unroll") for (int k = 0; k < 2; ++k) dst[n][k] = *(const LAS bf16x8*)(lds + PG8_SB(b, h) + boff + n * 2048 + k * 1024); } while (0)
#define PG8_MMA(ai, bj, At, Bt) do { __builtin_amdgcn_s_setprio(1); _Pragma("unroll") for (int m = 0; m < 4; ++m) _Pragma("unroll") for (int n = 0; n < 2; ++n) _Pragma("unroll") for (int k = 0; k < 2; ++k) \
        acc[ai][bj][m][n] = __builtin_amdgcn_mfma_f32_16x16x32_bf16(Bt[n][k], At[m][k], acc[ai][bj][m][n], 0, 0, 0); __builtin_amdgcn_s_setprio(0); } while (0)
#define PG8_WAIT_V(n) asm volatile("s_waitcnt vmcnt(" #n ")" ::: "memory")
#define PG8_WAIT_L(n) asm volatile("s_waitcnt lgkmcnt(" #n ")" ::: "memory")
#define PG8_BAR __builtin_amdgcn_s_barrier()
#define PG8_SCHED __builtin_amdgcn_sched_barrier(0)
    GUnit cur, nxt; int ui = 0;
    if (!S.next(0, cur)) return;
    f32x4 acc[2][2][4][2];
#pragma unroll
    for (int a = 0; a < 2; ++a)
#pragma unroll
        for (int b = 0; b < 2; ++b)
#pragma unroll
            for (int m = 0; m < 4; ++m)
#pragma unroll
                for (int n = 0; n < 2; ++n) acc[a][b][m][n] = (f32x4){0.f, 0.f, 0.f, 0.f};
    bf16x8 At[4][2], B0[2][2], B1[2][2];
    const char* cA = cur.a; const char* cB = cur.b;
    PG8_AOFF(cur, cA0, cA1);
    PG8_STAGE(PG8_SB(0, 0), cB, voffB); PG8_STAGE(PG8_SB(0, 1), cB + hstepB, voffB); PG8_STAGE(PG8_SA(0, 0), cA, cA0); PG8_STAGE(PG8_SA(0, 1), cA, cA1);
    if (wr == 1) PG8_BAR;
    PG8_WAIT_V(2); PG8_BAR;
    PG8_STAGE(PG8_SB(1, 0), cB + kstep, voffB); PG8_STAGE(PG8_SA(1, 0), cA + kstep, cA0); PG8_STAGE(PG8_SB(1, 1), cB + hstepB + kstep, voffB);
    PG8_WAIT_V(6); PG8_BAR;
    for (;;) {
        const bool has_next = S.next(ui + 1, nxt);
        const char* nA = has_next ? nxt.a : cA; const char* nB = has_next ? nxt.b : cB;
        if constexpr (GATHER) { if (has_next) { PG8_AOFF(nxt, nA0, nA1); } else {
#pragma unroll
            for (int i = 0; i < 2; ++i) { nA0[i] = cA0[i]; nA1[i] = cA1[i]; } } }
        for (int t = 0; t < nt; t += 2) {
            const bool last = (t == nt - 2);
            const char* a1 = cA + (size_t)(t + 1) * kstep;
            const char* a2 = last ? nA : cA + (size_t)(t + 2) * kstep; const char* b2 = last ? nB : cB + (size_t)(t + 2) * kstep;
            const char* a3 = a2 + kstep; const char* b3 = b2 + kstep;
            unsigned s0[2], s1[2];
#pragma unroll
            for (int i = 0; i < 2; ++i) { if constexpr (GATHER) { s0[i] = last ? nA0[i] : cA0[i]; s1[i] = last ? nA1[i] : cA1[i]; } else { s0[i] = cA0[i]; s1[i] = cA1[i]; } }
            PG8_LDB(B0, 0, 0); PG8_LDB(B1, 0, 1); PG8_SCHED; PG8_LDA(At, 0, 0); PG8_STAGE(PG8_SA(1, 1), a1, cA1);
            PG8_WAIT_V(8); PG8_WAIT_L(0); PG8_BAR; PG8_MMA(0, 0, At, B0); PG8_MMA(0, 1, At, B1); PG8_BAR; PG8_SCHED;
            PG8_LDA(At, 0, 1); PG8_STAGE(PG8_SB(0, 0), b2, voffB); PG8_STAGE(PG8_SB(0, 1), b2 + hstepB, voffB); PG8_STAGE(PG8_SA(0, 0), a2, s0);
            PG8_WAIT_V(8); PG8_WAIT_L(0); PG8_BAR; PG8_MMA(1, 0, At, B0); PG8_MMA(1, 1, At, B1); PG8_BAR; PG8_SCHED;
            PG8_LDB(B0, 1, 0); PG8_LDB(B1, 1, 1); PG8_SCHED; PG8_LDA(At, 1, 0); PG8_STAGE(PG8_SA(0, 1), a2, s1);
            PG8_WAIT_V(8); PG8_WAIT_L(0); PG8_BAR; PG8_MMA(0, 0, At, B0); PG8_MMA(0, 1, At, B1); PG8_BAR; PG8_SCHED;
            PG8_LDA(At, 1, 1); PG8_STAGE(PG8_SB(1, 0), b3, voffB); PG8_STAGE(PG8_SB(1, 1), b3 + hstepB, voffB); PG8_STAGE(PG8_SA(1, 0), a3, s0);
            PG8_WAIT_V(8); PG8_WAIT_L(0); PG8_BAR; PG8_MMA(1, 0, At, B0); PG8_MMA(1, 1, At, B1); PG8_BAR; PG8_SCHED;
        }
        if (wr == 0) PG8_BAR;
        E(acc, cur, wr, wc, fr, fq);
        if (!has_next) break;
#pragma unroll
        for (int a = 0; a < 2; ++a)
#pragma unroll
            for (int b = 0; b < 2; ++b)
#pragma unroll
                for (int m = 0; m < 4; ++m)
#pragma unroll
                    for (int n = 0; n < 2; ++n) acc[a][b][m][n] = (f32x4){0.f, 0.f, 0.f, 0.f};
        cur = nxt; cA = nA; cB = nB; ++ui;
        if constexpr (GATHER) {
#pragma unroll
            for (int i = 0; i < 2; ++i) { cA0[i] = nA0[i]; cA1[i] = nA1[i]; } }
        if (wr == 1) PG8_BAR;
    }
    PG8_WAIT_V(0);
    PG8_BAR;
#undef PG8_AOFF
#undef PG8_SA
#undef PG8_SB
#undef PG8_STAGE
#undef PG8_LDA
#undef PG8_LDB
#undef PG8_MMA
#undef PG8_WAIT_V
#undef PG8_WAIT_L
#undef PG8_BAR
#undef PG8_SCHED
}

template <int NM, int NN> struct DenseSched {
    const char* A; const char* B; size_t tstepA, tstepB; int G, c;
    __device__ __forceinline__ bool next(int i, GUnit& u) const {
        constexpr int nwg = NM * NN, q = nwg / NXCD, r = nwg % NXCD, nig = WGM * NN, REM = (NM % WGM) ? (NM % WGM) : WGM;
        const int L = i * G + c; if (L >= nwg) return false;
        const int xcd = L % NXCD, off = L / NXCD; const int wgid = (xcd < r ? xcd * (q + 1) : r * (q + 1) + (xcd - r) * q) + off;
        const int gid = wgid / nig, w2 = wgid % nig, fm = gid * WGM;
        if (NM - fm >= WGM) { u.pm = fm + (w2 % WGM); u.pn = w2 / WGM; } else { u.pm = fm + (w2 % REM); u.pn = w2 / REM; }
        u.grp = 0; u.rows = nullptr;
        u.a = A + (size_t)u.pm * tstepA; u.b = B + (size_t)u.pn * tstepB; return true;
    }
};
template <int NM, int NN, int NGRP> struct BatchSched {
    const char* A; const char* B; size_t gstepA, gstepB, tstepA, tstepB; int G, c;
    __device__ __forceinline__ bool next(int i, GUnit& u) const {
        constexpr int per = NM * NN;
        const int L = i * G + c; if (L >= NGRP * per) return false;
        u.grp = L / per; const int r = L % per; u.pn = r % NN; u.pm = r / NN; u.rows = nullptr;
        u.a = A + (size_t)u.grp * gstepA + (size_t)u.pm * tstepA; u.b = B + (size_t)u.grp * gstepB + (size_t)u.pn * tstepB; return true;
    }
};
template <int NCT, bool GATHER> struct MoeSched {
    const char* A; const char* B; const int* slot_tok; const LAS int* pref; size_t tstepA, estepB, tstepB; int G, c;
    __device__ __forceinline__ bool next(int i, GUnit& u) const {
        const int L = i * G + c; const int TT = pref[NEXP]; if (L >= TT * NCT) return false;
        const int rt = L / NCT, ct = L % NCT; int e = 0;
        for (int j = 1; j < NEXP; ++j) e += (pref[j] <= rt) ? 1 : 0;
        u.pm = rt; u.pn = ct; u.grp = e; u.rows = slot_tok + rt * 256;
        u.a = GATHER ? A : A + (size_t)rt * tstepA; u.b = B + (size_t)e * estepB + (size_t)ct * tstepB; return true;
    }
};
}
using pg8::GUnit;

struct Args { const float* in[33]; float* out; unsigned char* ws; int ph_lo, ph_hi; };

typedef const __attribute__((address_space(4))) Args* CArgsP;
__device__ __forceinline__ CArgsP argp() { CArgsP p = (CArgsP)__builtin_amdgcn_kernarg_segment_ptr(); asm volatile("" : "+s"(p)); return p; }
__device__ __forceinline__ unsigned char* opq_p(unsigned char* p) { asm volatile("" : "+s"(p)); return p; }

struct Frame {
    LAS unsigned char* lds; volatile LAS unsigned* CTLW;
    int tid, lane, wave, G, bid;
    unsigned char* ws;
};

struct EpiInProj { static constexpr bool PERM = true; bf16_t* proj; bf16_t* ucat; float* gl;
    __device__ __forceinline__ void operator()(const f32x4 (&acc)[2][2][4][2], const GUnit& u, int wr, int wc, int fr, int fq) const {
        const int row0 = u.pm * 256 + wr * 64 + fr;
        if (u.pn < 8) {
            const bool dog = u.pn < 2;
#pragma unroll
            for (int ai = 0; ai < 2; ++ai)
#pragma unroll
                for (int m = 0; m < 4; ++m) { bf16_t* rowp = proj + (size_t)(row0 + ai * 128 + m * 16) * PROJW + u.pn * 256 + wc * 32 + 8 * fq;
#pragma unroll
                    for (int bj = 0; bj < 2; ++bj) { f32x4 v0 = acc[ai][bj][m][0], v1 = acc[ai][bj][m][1];
                        if (dog) {
#pragma unroll
                            for (int j = 0; j < 4; ++j) { v0[j] = gelu_tanh(v0[j]); v1[j] = gelu_tanh(v1[j]); } }
                        u32x4 w; w.x = cvt_pk_bf16(v0[0], v0[1]); w.y = cvt_pk_bf16(v0[2], v0[3]); w.z = cvt_pk_bf16(v1[0], v1[1]); w.w = cvt_pk_bf16(v1[2], v1[3]);
                        *(u32x4*)(rowp + bj * 128) = w; } }
        } else if (u.pn == 8) {
#pragma unroll
            for (int ai = 0; ai < 2; ++ai)
#pragma unroll
                for (int m = 0; m < 4; ++m) { const int row = row0 + ai * 128 + m * 16, chunk = row >> 6, s = row & 63;
#pragma unroll
                    for (int bj = 0; bj < 2; ++bj) { const int j0 = bj * 128 + wc * 32 + 8 * fq, g = j0 >> 4, h0 = j0 & 15;
                        const f32x4 v0 = acc[ai][bj][m][0], v1 = acc[ai][bj][m][1];
                        u32x4 w; w.x = cvt_pk_bf16(v0[0], v0[1]); w.y = cvt_pk_bf16(v0[2], v0[3]); w.z = cvt_pk_bf16(v1[0], v1[1]); w.w = cvt_pk_bf16(v1[2], v1[3]);
                        *(u32x4*)(ucat + ((size_t)(g * NCHP + chunk) * S5K + s * 16 + h0)) = w; } }
        } else {
            if (wc == 0) {
#pragma unroll
                for (int ai = 0; ai < 2; ++ai)
#pragma unroll
                    for (int m = 0; m < 4; ++m) { float* dst = gl + (size_t)(row0 + ai * 128 + m * 16) * 32 + 8 * fq;
                        *(f32x4*)dst = acc[ai][0][m][0]; *(f32x4*)(dst + 4) = acc[ai][0][m][1]; } }
        }
    }
};
struct EpiHloc { static constexpr bool PERM = false; float* hloc;
    __device__ __forceinline__ void operator()(const f32x4 (&acc)[2][2][4][2], const GUnit& u, int wr, int wc, int fr, int fq) const {
        const int row0 = u.pm * 256 + wr * 64 + fr;
#pragma unroll
        for (int ai = 0; ai < 2; ++ai)
#pragma unroll
            for (int m = 0; m < 4; ++m) { float* rowp = hloc + ((size_t)u.grp * NCHP + row0 + ai * 128 + m * 16) * 256 + wc * 32 + 4 * fq;
#pragma unroll
                for (int bj = 0; bj < 2; ++bj)
#pragma unroll
                    for (int n = 0; n < 2; ++n) *(f32x4*)(rowp + bj * 128 + n * 16) = acc[ai][bj][m][n]; }
    }
};
struct EpiS5Y { static constexpr bool PERM = true; bf16_t* ys5;
    __device__ __forceinline__ void operator()(const f32x4 (&acc)[2][2][4][2], const GUnit& u, int wr, int wc, int fr, int fq) const {
        const int row0 = u.pm * 256 + wr * 64 + fr;
#pragma unroll
        for (int ai = 0; ai < 2; ++ai)
#pragma unroll
            for (int m = 0; m < 4; ++m) { const int c = row0 + ai * 128 + m * 16;
                if (c < NCH) {
#pragma unroll
                    for (int bj = 0; bj < 2; ++bj) { const int j0 = u.pn * 256 + bj * 128 + wc * 32 + 8 * fq, t = j0 >> 4, h0 = j0 & 15;
                        f32x4 v0 = acc[ai][bj][m][0], v1 = acc[ai][bj][m][1];
#pragma unroll
                        for (int j = 0; j < 4; ++j) { v0[j] = gelu_tanh(v0[j]); v1[j] = gelu_tanh(v1[j]); }
                        u32x4 w; w.x = cvt_pk_bf16(v0[0], v0[1]); w.y = cvt_pk_bf16(v0[2], v0[3]); w.z = cvt_pk_bf16(v1[0], v1[1]); w.w = cvt_pk_bf16(v1[2], v1[3]);
                        *(u32x4*)(ys5 + (size_t)(c * 64 + t) * 256 + u.grp * 16 + h0) = w; } } }
    }
};
struct EpiGlu { static constexpr bool PERM = true; const bf16_t* ys5; bf16_t* mixed; const float* bias;
    __device__ __forceinline__ void operator()(const f32x4 (&acc)[2][2][4][2], const GUnit& u, int wr, int wc, int fr, int fq) const {
        const int row0 = u.pm * 256 + wr * 64 + fr;
#pragma unroll
        for (int bj = 0; bj < 2; ++bj) { const int n0 = bj * 128 + wc * 32 + 8 * fq;
            const f32x4 b0 = *(const f32x4*)(bias + n0), b1 = *(const f32x4*)(bias + n0 + 4);
#pragma unroll
            for (int ai = 0; ai < 2; ++ai)
#pragma unroll
                for (int m = 0; m < 4; ++m) { const int tok = row0 + ai * 128 + m * 16;
                    const u32x4 yv = *(const u32x4*)(ys5 + (size_t)tok * 256 + n0);
                    const f32x4 v0 = acc[ai][bj][m][0] + b0, v1 = acc[ai][bj][m][1] + b1;
                    float o[8];
                    o[0] = bf2f(yv.x & 0xffffu) * sigmoidf_(v0[0]); o[1] = bf2f(yv.x >> 16) * sigmoidf_(v0[1]); o[2] = bf2f(yv.y & 0xffffu) * sigmoidf_(v0[2]); o[3] = bf2f(yv.y >> 16) * sigmoidf_(v0[3]);
                    o[4] = bf2f(yv.z & 0xffffu) * sigmoidf_(v1[0]); o[5] = bf2f(yv.z >> 16) * sigmoidf_(v1[1]); o[6] = bf2f(yv.w & 0xffffu) * sigmoidf_(v1[2]); o[7] = bf2f(yv.w >> 16) * sigmoidf_(v1[3]);
                    u32x4 w; w.x = cvt_pk_bf16(o[0], o[1]); w.y = cvt_pk_bf16(o[2], o[3]); w.z = cvt_pk_bf16(o[4], o[5]); w.w = cvt_pk_bf16(o[6], o[7]);
                    *(u32x4*)(mixed + (size_t)tok * 1024 + 768 + n0) = w; asm volatile("" ::: "memory"); } }
    }
};
struct EpiF32 { static constexpr bool PERM = false; float* C; int ldc;
    __device__ __forceinline__ void operator()(const f32x4 (&acc)[2][2][4][2], const GUnit& u, int wr, int wc, int fr, int fq) const {
        const int row0 = u.pm * 256 + wr * 64 + fr, col0 = u.pn * 256 + wc * 32 + 4 * fq;
#pragma unroll
        for (int ai = 0; ai < 2; ++ai)
#pragma unroll
            for (int m = 0; m < 4; ++m) { float* rowp = C + (size_t)(row0 + ai * 128 + m * 16) * ldc + col0;
#pragma unroll
                for (int bj = 0; bj < 2; ++bj)
#pragma unroll
                    for (int n = 0; n < 2; ++n) *(f32x4*)(rowp + bj * 128 + n * 16) = acc[ai][bj][m][n]; }
    }
};
struct EpiUp { static constexpr bool PERM = true; bf16_t* act; const float* bup;
    __device__ __forceinline__ void operator()(const f32x4 (&acc)[2][2][4][2], const GUnit& u, int wr, int wc, int fr, int fq) const {
        const int row0 = u.pm * 256 + wr * 64 + fr, jj0 = wc * 32 + 8 * fq;
        const float* bg = bup + (size_t)u.grp * 2048 + u.pn * 128 + jj0;
        const f32x4 g0 = *(const f32x4*)bg, g1 = *(const f32x4*)(bg + 4), l0 = *(const f32x4*)(bg + 1024), l1 = *(const f32x4*)(bg + 1028);
#pragma unroll
        for (int ai = 0; ai < 2; ++ai)
#pragma unroll
            for (int m = 0; m < 4; ++m) { const int slot = row0 + ai * 128 + m * 16;
                const f32x4 xg0 = acc[ai][0][m][0] + g0, xg1 = acc[ai][0][m][1] + g1, xl0 = acc[ai][1][m][0] + l0, xl1 = acc[ai][1][m][1] + l1;
                float o[8];
#pragma unroll
                for (int j = 0; j < 4; ++j) { const float a = fminf(xg0[j], 7.0f), b = fminf(fmaxf(xl0[j], -7.0f), 7.0f); o[j] = a * sigmoidf_(1.702f * a) * (b + 1.0f);
                                              const float c = fminf(xg1[j], 7.0f), d = fminf(fmaxf(xl1[j], -7.0f), 7.0f); o[4 + j] = c * sigmoidf_(1.702f * c) * (d + 1.0f); }
                u32x4 w; w.x = cvt_pk_bf16(o[0], o[1]); w.y = cvt_pk_bf16(o[2], o[3]); w.z = cvt_pk_bf16(o[4], o[5]); w.w = cvt_pk_bf16(o[6], o[7]);
                *(u32x4*)(act + (size_t)slot * 1024 + u.pn * 128 + jj0) = w; }
    }
};
struct EpiDown { static constexpr bool PERM = true; bf16_t* yv; const float* bdn;
    __device__ __forceinline__ void operator()(const f32x4 (&acc)[2][2][4][2], const GUnit& u, int wr, int wc, int fr, int fq) const {
        const int row0 = u.pm * 256 + wr * 64 + fr;
#pragma unroll
        for (int bj = 0; bj < 2; ++bj) { const int col = u.pn * 256 + bj * 128 + wc * 32 + 8 * fq;
            const f32x4 b0 = *(const f32x4*)(bdn + (size_t)u.grp * 1024 + col), b1 = *(const f32x4*)(bdn + (size_t)u.grp * 1024 + col + 4);
#pragma unroll
            for (int ai = 0; ai < 2; ++ai)
#pragma unroll
                for (int m = 0; m < 4; ++m) { const int slot = row0 + ai * 128 + m * 16;
                    const f32x4 v0 = acc[ai][bj][m][0] + b0, v1 = acc[ai][bj][m][1] + b1;
                    u32x4 w; w.x = cvt_pk_bf16(v0[0], v0[1]); w.y = cvt_pk_bf16(v0[2], v0[3]); w.z = cvt_pk_bf16(v1[0], v1[1]); w.w = cvt_pk_bf16(v1[2], v1[3]);
                    *(u32x4*)(yv + (size_t)slot * 1024 + col) = w; } }
    }
};

__device__ __forceinline__ bf16x8 frag_lds(const LAS unsigned char* base, int row, int pitch_bytes, int k0, int lane) {
    return *(const LAS bf16x8*)(base + (row + (lane & 15)) * pitch_bytes + (k0 + 8 * (lane >> 4)) * 2);
}
__device__ __forceinline__ bf16x8 frag_glb(const bf16_t* base, size_t row, int pitch_elems, int k0, int lane) {
    return *(const bf16x8*)(base + (row + (lane & 15)) * (size_t)pitch_elems + k0 + 8 * (lane >> 4));
}
#define MFMA16(x, y, acc) __builtin_amdgcn_mfma_f32_16x16x32_bf16((x), (y), (acc), 0, 0, 0)

__device__ __forceinline__ void tr_item(const float* W, int ldw, int k0, int n0, bf16_t* dst, int r0, int ldd, LAS float* scr, int lane) {
#pragma unroll 8
    for (int i = 0; i < 32; ++i) { const int kk = 2 * i + (lane >> 5); scr[kk * 33 + (lane & 31)] = W[(size_t)(k0 + kk) * ldw + n0 + (lane & 31)]; }
    asm volatile("s_waitcnt lgkmcnt(0)" ::: "memory");
    const int c = lane & 7;
#pragma unroll
    for (int j = 0; j < 4; ++j) { const int n = (lane >> 3) + 8 * j; const LAS float* s = scr + (8 * c) * 33 + n;
        u32x4 o; o.x = pk2(s[0 * 33], s[1 * 33]); o.y = pk2(s[2 * 33], s[3 * 33]); o.z = pk2(s[4 * 33], s[5 * 33]); o.w = pk2(s[6 * 33], s[7 * 33]);
        *(u32x4*)(dst + (size_t)(r0 + n) * ldd + k0 + 8 * c) = o; }
    asm volatile("s_waitcnt lgkmcnt(0)" ::: "memory");
}

__device__ __forceinline__ void ph0_prologue(const Frame& F0, CArgsP A) {
    Frame F = F0; F.tid = opq(F0.tid); F.lane = F.tid & 63; F.wave = __builtin_amdgcn_readfirstlane(F.tid >> 6); F.ws = opq_p(F0.ws);
    unsigned char* ws = F.ws;
    {
        LAS float* sc = (LAS float*)F.lds;
        LAS float* part = sc + 640;
        const float* cvec = A->in[1]; const float* cctx = A->in[3]; const float* wmod = A->in[4];
        float* modp = (float*)(ws + WS_MODP);
        for (int u = F.bid; u < 768; u += F.G) {
            const int l = u / 192, r = u % 192, cb = r >> 3, ks = r & 7;
            for (int i = F.tid; i < 640; i += NTHR) { const int v = i >> 7, kk = i & 127; const float x = v < 4 ? cvec[v * 1024 + ks * 128 + kk] : cctx[ks * 128 + kk]; sc[i] = siluf_(x); }
            __syncthreads();
            const int col = cb * 256 + (F.tid & 255), kh = F.tid >> 8;
            float a0 = 0.f, a1 = 0.f, a2 = 0.f, a3 = 0.f, a4 = 0.f;
            const float* wp = wmod + ((size_t)l * 1024 + ks * 128 + kh * 64) * 6144 + col;
#pragma unroll 8
            for (int kk = 0; kk < 64; ++kk) { const float w = wp[(size_t)kk * 6144]; const int sk = kh * 64 + kk;
                a0 += sc[sk] * w; a1 += sc[128 + sk] * w; a2 += sc[256 + sk] * w; a3 += sc[384 + sk] * w; a4 += sc[512 + sk] * w; }
            if (kh == 1) { const int c = F.tid & 255; part[c] = a0; part[256 + c] = a1; part[512 + c] = a2; part[768 + c] = a3; part[1024 + c] = a4; }
            __syncthreads();
            if (kh == 0) { const int c = F.tid & 255; float* o = modp + ((size_t)(ks * 4 + l) * 5) * 6144 + col;
                o[0] = a0 + part[c]; o[6144] = a1 + part[256 + c]; o[2 * 6144] = a2 + part[512 + c]; o[3 * 6144] = a3 + part[768 + c]; o[4 * 6144] = a4 + part[1024 + c]; }
            __syncthreads();
        }
    }
    {
        LAS float* scr = (LAS float*)(F.lds + F.wave * 8704);
        const int gw = F.bid * NWAVES + F.wave, NGW = F.G * NWAVES;
        constexpr int I_IN = 4 * 16 * 73, I_OUT = 4 * 16 * 32, I_UP = 128 * 16 * 64, I_DN = 128 * 16 * 32, I_GLU = 4 * 4 * 8;
        constexpr int NITEMS = I_IN + I_OUT + I_UP + I_DN + I_GLU;
        for (int it = gw; it < NITEMS; it += NGW) {
            int r = it;
            if (r < I_IN) { const int l = r / 1168, q = r % 1168, kb = q / 73, nb = q % 73, n0 = 32 * nb;
                const int r0 = nb < 64 ? n0 : (nb == 64 ? 2304 : 2048 + (n0 - 2080));
                tr_item(A->in[6] + (size_t)l * 1024 * NIN, NIN, 64 * kb, n0, (bf16_t*)(ws + WS_WIN) + (size_t)l * NINP * 1024, r0, 1024, scr, F.lane); continue; }
            r -= I_IN;
            if (r < I_OUT) { const int l = r / 512, q = r % 512, kb = q / 32, nb = q % 32;
                tr_item(A->in[24] + (size_t)l * 1024 * 1024, 1024, 64 * kb, 32 * nb, (bf16_t*)(ws + WS_WOUT) + (size_t)l * 1024 * 1024, 32 * nb, 1024, scr, F.lane); continue; }
            r -= I_OUT;
            if (r < I_UP) { const int le = r / 1024, q = r % 1024, kb = q / 64, nb = q % 64, n0 = 32 * nb, half = n0 >> 10, within = n0 & 1023, ct = within >> 7, jj0 = within & 127;
                tr_item(A->in[29] + (size_t)le * 1024 * 2048, 2048, 64 * kb, n0, (bf16_t*)(ws + WS_WUP) + (size_t)le * 2048 * 1024, 256 * ct + 128 * half + jj0, 1024, scr, F.lane); continue; }
            r -= I_UP;
            if (r < I_DN) { const int le = r / 512, q = r % 512, kb = q / 32, nb = q % 32;
                tr_item(A->in[31] + (size_t)le * 1024 * 1024, 1024, 64 * kb, 32 * nb, (bf16_t*)(ws + WS_WDN) + (size_t)le * 1024 * 1024, 32 * nb, 1024, scr, F.lane); continue; }
            r -= I_DN;
            { const int l = r / 32, q = r % 32, kb = q / 8, nb = q % 8;
                tr_item(A->in[22] + (size_t)l * 256 * 256, 256, 64 * kb, 32 * nb, (bf16_t*)(ws + WS_GLUT) + (size_t)l * 256 * 256, 32 * nb, 256, scr, F.lane); }
        }
        const int gt = F.bid * NTHR + F.tid, NGT = F.G * NTHR;
        for (int i = gt; i < 4 * 224 * 128; i += NGT) { const int l = i / (224 * 128), q = i % (224 * 128);
            *(u32x4*)((bf16_t*)(ws + WS_WIN) + ((size_t)l * NINP + 2336) * 1024 + (size_t)q * 8) = (u32x4){0u, 0u, 0u, 0u}; }
        const float* sw = A->in[9]; bf16_t* swo = (bf16_t*)(ws + WS_SGUW);
        for (int i = gt; i < 4 * 4 * 128 * 128 / 4; i += NGT) { const f32x4 v = *(const f32x4*)(sw + (size_t)i * 4); u32x2 o; o.x = pk2(v[0], v[1]); o.y = pk2(v[2], v[3]); *(u32x2*)(swo + (size_t)i * 4) = o; }
    }
    __syncthreads();
    {
        LAS f32x2* LP = (LAS f32x2*)F.lds;
        LAS f32x2* BB = LP + 2 * 65 * 64;
        LAS f32x2* CC = BB + 2 * 64 * 16;
        const float* lam_re = A->in[14]; const float* lam_im = A->in[15]; const float* log_dt = A->in[16];
        const float* b_re = A->in[17]; const float* b_im = A->in[18]; const float* c_re = A->in[19]; const float* c_im = A->in[20]; const float* dsk = A->in[21];
        for (int u = F.bid; u < 64; u += F.G) {
            const int l = u >> 4, g = u & 15;
            for (int i = F.tid; i < 2 * 65 * 64; i += NTHR) { const int z = i / (65 * 64), n = (i / 64) % 65, p = i & 63;
                const int idx = ((l * 2 + z) * 16 + g) * 64 + p; const double dt = exp((double)log_dt[(l * 2 + z) * 16 + g]);
                const double mag = exp((double)lam_re[idx] * dt * n), ang = (double)lam_im[idx] * dt * n; double s, c; sincos(ang, &s, &c);
                LP[i] = (f32x2){(float)(mag * c), (float)(mag * s)};
                if (n == 64) *(f32x2*)((float*)(ws + WS_LB64) + (size_t)idx * 2) = (f32x2){(float)(mag * c), (float)(mag * s)}; }
            for (int i = F.tid; i < 2 * 64 * 16; i += NTHR) { const int z = i >> 10, p = (i >> 4) & 63, h = i & 15;
                const int idx = ((l * 2 + z) * 16 + g) * 64 + p; const double dt = exp((double)log_dt[(l * 2 + z) * 16 + g]);
                const double lr = lam_re[idx], li = lam_im[idx]; const double mag = exp(lr * dt), ang = li * dt; double s, c; sincos(ang, &s, &c);
                const double nr = mag * c - 1.0, ni = mag * s, den = lr * lr + li * li;
                const double qr = (nr * lr + ni * li) / den, qi = (ni * lr - nr * li) / den;
                const double br = b_re[(size_t)idx * 16 + h], bi = b_im[(size_t)idx * 16 + h];
                BB[i] = (f32x2){(float)(qr * br - qi * bi), (float)(qr * bi + qi * br)}; }
            for (int i = F.tid; i < 2 * 16 * 64; i += NTHR) { const int z = i >> 10, h = (i >> 6) & 15, p = i & 63;
                const size_t idx = ((size_t)((l * 2 + z) * 16 + g) * 16 + h) * 64 + p; CC[i] = (f32x2){c_re[idx], c_im[idx]}; }
            __syncthreads();
            float* KT = (float*)(ws + WS_KTAB) + (size_t)u * 32768;
            for (int o = F.tid; o < 32768; o += NTHR) { const int z = o >> 14, tau = (o >> 8) & 63, h = (o >> 4) & 15, h2 = o & 15; float acc = 0.f;
                for (int p = 0; p < 64; ++p) { const f32x2 c = CC[(z * 16 + h) * 64 + p], w = LP[(z * 65 + tau) * 64 + p], b = BB[(z * 64 + p) * 16 + h2];
                    const float cwr = c.x * w.x - c.y * w.y, cwi = c.x * w.y + c.y * w.x; acc += cwr * b.x - cwi * b.y; }
                KT[o] = acc; }
            __syncthreads();
            bf16_t* Mo = (bf16_t*)(ws + WS_S5M) + (size_t)u * 1024 * S5K;
            for (int it = F.tid; it < 1024 * 160; it += NTHR) { const int row = it / 160, cv = it % 160, t = row >> 4, h = row & 15; float v[8];
                if (cv < 128) { const int s = cv >> 1, h0 = (cv & 1) * 8;
                    if (s < t) { const float* k = KT + ((0 * 64 + (t - s)) * 16 + h) * 16 + h0;
#pragma unroll
                        for (int i = 0; i < 8; ++i) v[i] = k[i]; }
                    else if (s > t) { const float* k = KT + ((1 * 64 + (s - t)) * 16 + h) * 16 + h0;
#pragma unroll
                        for (int i = 0; i < 8; ++i) v[i] = k[i]; }
                    else { const float* k0 = KT + ((0 * 64 + 0) * 16 + h) * 16 + h0; const float* k1 = KT + ((1 * 64 + 0) * 16 + h) * 16 + h0; const float dd = dsk[(l * 16 + g) * 16 + h];
#pragma unroll
                        for (int i = 0; i < 8; ++i) v[i] = k0[i] + k1[i] + ((h0 + i == h) ? dd : 0.f); }
                } else { const int idx0 = (cv - 128) * 8, z = idx0 >> 7, p0 = (idx0 & 127) >> 1, n = z == 0 ? t + 1 : 64 - t;
#pragma unroll
                    for (int i = 0; i < 8; ++i) { const int p = p0 + (i >> 1); const f32x2 c = CC[(z * 16 + h) * 64 + p], w = LP[(z * 65 + n) * 64 + p];
                        v[i] = (i & 1) ? -(c.x * w.y + c.y * w.x) : (c.x * w.x - c.y * w.y); } }
                u32x4 o; o.x = pk2(v[0], v[1]); o.y = pk2(v[2], v[3]); o.z = pk2(v[4], v[5]); o.w = pk2(v[6], v[7]);
                *(u32x4*)(Mo + (size_t)row * S5K + cv * 8) = o; }
            bf16_t* Fo = (bf16_t*)(ws + WS_S5F) + (size_t)u * 256 * 1024;
            for (int it = F.tid; it < 256 * 128; it += NTHR) { const int r = it >> 7, cv = it & 127, z = r >> 7, p = (r & 127) >> 1, ri = r & 1, s = cv >> 1, h0 = (cv & 1) * 8, m = z == 0 ? 63 - s : s;
                const f32x2 w = LP[(z * 65 + m) * 64 + p]; float v[8];
#pragma unroll
                for (int i = 0; i < 8; ++i) { const f32x2 b = BB[(z * 64 + p) * 16 + h0 + i]; v[i] = ri ? (w.x * b.y + w.y * b.x) : (w.x * b.x - w.y * b.y); }
                u32x4 o; o.x = pk2(v[0], v[1]); o.y = pk2(v[2], v[3]); o.z = pk2(v[4], v[5]); o.w = pk2(v[6], v[7]);
                *(u32x4*)(Fo + (size_t)r * 1024 + cv * 8) = o; }
            __syncthreads();
        }
    }
}

__device__ __forceinline__ void ph1_mod(const Frame& F0, CArgsP A) {
    Frame F = F0; F.tid = opq(F0.tid); F.lane = F.tid & 63; F.wave = __builtin_amdgcn_readfirstlane(F.tid >> 6); F.ws = opq_p(F0.ws);
    const float* modp = (const float*)(F.ws + WS_MODP); float* mod = (float*)(F.ws + WS_MOD); const float* bmod = A->in[5];
    for (int i = F.bid * NTHR + F.tid; i < 4 * 5 * 6144; i += F.G * NTHR) { const int l = i / 30720, j = i % 6144; float s = bmod[l * 6144 + j];
#pragma unroll
        for (int ks = 0; ks < 8; ++ks) s += modp[(size_t)ks * 122880 + i];
        mod[i] = s; }
}
__device__ __forceinline__ void ph2_init(const Frame& F0, CArgsP A) {
    Frame F = F0; F.tid = opq(F0.tid); F.lane = F.tid & 63; F.wave = __builtin_amdgcn_readfirstlane(F.tid >> 6); F.ws = opq_p(F0.ws);
    const float* mod = (const float*)(F.ws + WS_MOD); float* X = (float*)(F.ws + WS_X); bf16_t* H = (bf16_t*)(F.ws + WS_H);
    for (int tk = F.bid * NWAVES + F.wave; tk < T; tk += F.G * NWAVES) {
        const float* src = tk < TLAT ? A->in[0] + (size_t)tk * D : A->in[2] + (size_t)(tk - TLAT) * D;
        const float* mv = mod + (size_t)tok_vec(tk) * 6144;
#pragma unroll
        for (int j = 0; j < 4; ++j) { const int c = 4 * F.lane + 256 * j; const f32x4 x = *(const f32x4*)(src + c), sh = *(const f32x4*)(mv + c), sc = *(const f32x4*)(mv + 1024 + c);
            *(f32x4*)(X + (size_t)tk * D + c) = x; const f32x4 h = x * (sc + 1.0f) + sh;
            u32x2 o; o.x = pk2(h[0], h[1]); o.y = pk2(h[2], h[3]); *(u32x2*)(H + (size_t)tk * D + c) = o; }
    }
}

__device__ __forceinline__ void gla_local(const Frame& F0, CArgsP A, int l) {
    Frame F = F0; F.tid = opq(F0.tid); F.lane = F.tid & 63; F.wave = __builtin_amdgcn_readfirstlane(F.tid >> 6); F.ws = opq_p(F0.ws);
    unsigned char* ws = F.ws;
    const bf16_t* proj = (const bf16_t*)(ws + WS_PROJ); const float* gl = (const float*)(ws + WS_GL);
    bf16_t* QS = (bf16_t*)(ws + WS_QS); bf16_t* KS = (bf16_t*)(ws + WS_KS); bf16_t* QH = (bf16_t*)(ws + WS_QH); bf16_t* VTg = (bf16_t*)(ws + WS_VT);
    float* glast = (float*)(ws + WS_GLAST); float* gdec = (float*)(ws + WS_GDEC);
    LAS float* GLs = (LAS float*)F.lds;
    LAS unsigned char* KTl = F.lds + 8192;
    LAS unsigned char* VTl = KTl + 512 * 144;
    const int z = F.tid >> 8, col = F.tid & 255, hh = col >> 6, dd = col & 63;
    float gu[16];
#pragma unroll
    for (int r = 0; r < 16; ++r) gu[r] = A->in[11][(((size_t)l * 2 + z) * 16 + r) * 256 + col];
    const float gb = A->in[12][((size_t)l * 2 + z) * 256 + col];
    for (int ch = F.bid; ch < NCH; ch += F.G) {
        const int tk0 = ch * 64;
        for (int i = F.tid; i < 2048; i += NTHR) GLs[i] = gl[(size_t)tk0 * 32 + i];
        __syncthreads();
        float tot = 0.f, mid = 0.f;
#define GLA_LA(t, out) do { float _s = gb; _Pragma("unroll") for (int _r = 0; _r < 16; ++_r) _s += GLs[(t) * 32 + z * 16 + _r] * gu[_r]; out = logsigmoidf_(_s) * (1.0f / 16.0f); } while (0)
#pragma unroll 4
        for (int t = 0; t < 64; ++t) { float la; GLA_LA(t, la);
            if (z == 0) { tot += la; if (t == 32) mid = tot; } else { if (t == 31) mid = tot; tot += la; } }
        if (z == 1) mid = tot - mid;
        gdec[((size_t)ch * 2 + z) * 256 + col] = __expf(tot);
        float pre = 0.f;
        for (int j = 0; j < 8; ++j) { unsigned w[4];
#pragma unroll
            for (int tt = 0; tt < 8; ++tt) { const int t = j * 8 + tt; float la; GLA_LA(t, la);
                const float kv = bf2f(proj[(size_t)(tk0 + t) * PROJW + 768 + col]), qv = bf2f(proj[(size_t)(tk0 + t) * PROJW + 512 + col]) * 0.125f;
                float bt; if (z == 0) { pre += la; bt = pre; } else { bt = tot - pre; pre += la; }
                const float kt = kv * __expf(tot - bt);
                if (tt & 1) w[tt >> 1] |= f2bf(kt) << 16; else w[tt >> 1] = f2bf(kt);
                QS[((size_t)z * T + tk0 + t) * 256 + col] = (bf16_t)f2bf(qv * __expf(bt - mid));
                KS[((size_t)z * T + tk0 + t) * 256 + col] = (bf16_t)f2bf(kv * __expf(mid - bt));
                QH[((size_t)(tk0 + t) * 4 + hh) * 128 + z * 64 + dd] = (bf16_t)f2bf(qv * __expf(bt)); }
            *(LAS u32x4*)(KTl + (z * 256 + col) * 144 + j * 16) = (u32x4){w[0], w[1], w[2], w[3]}; }
#undef GLA_LA
        for (int j = 0; j < 8; ++j) { unsigned w[4];
#pragma unroll
            for (int tt = 0; tt < 8; ++tt) { const unsigned v = proj[(size_t)(tk0 + j * 8 + tt) * PROJW + 1024 + F.tid];
                if (tt & 1) w[tt >> 1] |= v << 16; else w[tt >> 1] = v; }
            const u32x4 wv = (u32x4){w[0], w[1], w[2], w[3]};
            *(LAS u32x4*)(VTl + F.tid * 144 + j * 16) = wv; *(u32x4*)(VTg + ((size_t)ch * 512 + F.tid) * 64 + j * 8) = wv; }
        __syncthreads();
        {
            const int wz = F.wave & 1, wh = F.wave >> 1, q = F.lane >> 4, c = F.lane & 15;
#pragma unroll
            for (int eh = 0; eh < 2; ++eh) {
                f32x4 acc[4][4];
#pragma unroll
                for (int a = 0; a < 4; ++a)
#pragma unroll
                    for (int b = 0; b < 4; ++b) acc[a][b] = (f32x4){0.f, 0.f, 0.f, 0.f};
#pragma unroll
                for (int ks = 0; ks < 2; ++ks) { bf16x8 xf[4], yf[4];
#pragma unroll
                    for (int a = 0; a < 4; ++a) xf[a] = frag_lds(KTl, wz * 256 + wh * 64 + a * 16, 144, ks * 32, F.lane);
#pragma unroll
                    for (int b = 0; b < 4; ++b) yf[b] = frag_lds(VTl, wh * 128 + eh * 64 + b * 16, 144, ks * 32, F.lane);
#pragma unroll
                    for (int a = 0; a < 4; ++a)
#pragma unroll
                        for (int b = 0; b < 4; ++b) acc[a][b] = MFMA16(xf[a], yf[b], acc[a][b]); }
#pragma unroll
                for (int a = 0; a < 4; ++a)
#pragma unroll
                    for (int b = 0; b < 4; ++b) { const int e = eh * 64 + b * 16 + c, d0 = a * 16 + 4 * q;
                        *(f32x4*)(glast + (((size_t)ch * 4 + wh) * 128 + e) * 128 + wz * 64 + d0) = acc[a][b]; }
            }
        }
        __syncthreads();
    }
}

__device__ __forceinline__ void sgu_phase(const Frame& F0, CArgsP A, int l) {
    Frame F = F0; F.tid = opq(F0.tid); F.lane = F.tid & 63; F.wave = __builtin_amdgcn_readfirstlane(F.tid >> 6); F.ws = opq_p(F0.ws);
    unsigned char* ws = F.ws;
    const bf16_t* proj = (const bf16_t*)(ws + WS_PROJ); bf16_t* mixed = (bf16_t*)(ws + WS_MIXED); const bf16_t* sw = (const bf16_t*)(ws + WS_SGUW) + (size_t)l * 4 * 128 * 128;
    LAS float* stats = (LAS float*)F.lds;
    LAS unsigned char* VL = F.lds + 1024;
    const float* lng = A->in[7] + l * 256; const float* lnb = A->in[8] + l * 256; const float* bs = A->in[10] + (size_t)l * 4 * 128;
    for (int uu = F.bid; uu < T / 128; uu += F.G) {
        const int tk0 = uu * 128;
        for (int i = 0; i < 16; ++i) { const int t = F.wave * 16 + i; const u32x2 w = *(const u32x2*)(proj + (size_t)(tk0 + t) * PROJW + 256 + 4 * F.lane);
            const float a = bf2f(w.x & 0xffffu), b = bf2f(w.x >> 16), c = bf2f(w.y & 0xffffu), d = bf2f(w.y >> 16);
            const float mean = wave_sum((a + b) + (c + d)) * (1.0f / 256.0f); const float da = a - mean, db = b - mean, dc = c - mean, de = d - mean;
            const float var = wave_sum((da * da + db * db) + (dc * dc + de * de)) * (1.0f / 256.0f);
            if (F.lane == 0) { stats[2 * t] = mean; stats[2 * t + 1] = rsqrtf(var + LN_EPS); } }
        __syncthreads();
        {   const int col = F.tid & 255, shf = F.tid >> 8; const float g = lng[col], b = lnb[col];
            for (int j = 0; j < 8; ++j) { unsigned w[4];
#pragma unroll
                for (int tt = 0; tt < 8; ++tt) { const int s = shf * 64 + j * 8 + tt; const float v = (bf2f(proj[(size_t)(tk0 + s) * PROJW + 256 + col]) - stats[2 * s]) * stats[2 * s + 1] * g + b;
                    if (tt & 1) w[tt >> 1] |= f2bf(v) << 16; else w[tt >> 1] = f2bf(v); }
                *(LAS u32x4*)(VL + col * 272 + shf * 128 + j * 16) = (u32x4){w[0], w[1], w[2], w[3]}; }
        }
        __syncthreads();
        {   const int h = F.wave >> 1, th = F.wave & 1, q = F.lane >> 4, c = F.lane & 15;
            f32x4 acc[4][4];
#pragma unroll
            for (int a = 0; a < 4; ++a)
#pragma unroll
                for (int b = 0; b < 4; ++b) acc[a][b] = (f32x4){0.f, 0.f, 0.f, 0.f};
#pragma unroll
            for (int ks = 0; ks < 4; ++ks) { bf16x8 xf[4], yf[4];
#pragma unroll
                for (int a = 0; a < 4; ++a) xf[a] = frag_lds(VL, h * 64 + a * 16, 272, ks * 32, F.lane);
#pragma unroll
                for (int b = 0; b < 4; ++b) yf[b] = frag_glb(sw + (size_t)h * 128 * 128, th * 64 + b * 16, 128, ks * 32, F.lane);
#pragma unroll
                for (int a = 0; a < 4; ++a)
#pragma unroll
                    for (int b = 0; b < 4; ++b) acc[a][b] = MFMA16(xf[a], yf[b], acc[a][b]); }
#pragma unroll
            for (int b = 0; b < 4; ++b) { const int t = th * 64 + b * 16 + c; const float bias = bs[h * 128 + t];
#pragma unroll
                for (int a = 0; a < 4; ++a) { const int ch0 = h * 64 + a * 16 + 4 * q; const u32x2 uw = *(const u32x2*)(proj + (size_t)(tk0 + t) * PROJW + ch0);
                    u32x2 o; o.x = pk2(bf2f(uw.x & 0xffffu) * (acc[a][b][0] + bias), bf2f(uw.x >> 16) * (acc[a][b][1] + bias));
                    o.y = pk2(bf2f(uw.y & 0xffffu) * (acc[a][b][2] + bias), bf2f(uw.y >> 16) * (acc[a][b][3] + bias));
                    *(u32x2*)(mixed + (size_t)(tk0 + t) * 1024 + ch0) = o; } }
        }
        __syncthreads();
    }
}

__device__ __forceinline__ void scan_phase(const Frame& F0, CArgsP A, int l) {
    Frame F = F0; F.tid = opq(F0.tid); F.lane = F.tid & 63; F.wave = __builtin_amdgcn_readfirstlane(F.tid >> 6); F.ws = opq_p(F0.ws);
    unsigned char* ws = F.ws;
    const float* glast = (const float*)(ws + WS_GLAST); const float* gdec = (const float*)(ws + WS_GDEC); bf16_t* sprev = (bf16_t*)(ws + WS_SPREV);
    for (int idx = F.bid * NTHR + F.tid; idx < NB * 4 * 128 * 128; idx += F.G * NTHR) {
        const int b = idx >> 16, rem = idx & 65535, h = rem >> 14, dcat = rem & 127, z = dcat >> 6, d = dcat & 63;
        float S = 0.f;
        for (int st = 0; st < 132; ++st) {
            int ch; if (z == 0) ch = st < 4 ? 512 + b * 4 + st : b * 128 + (st - 4); else ch = st < 4 ? 512 + b * 4 + (3 - st) : b * 128 + (131 - st);
            const size_t off = (size_t)ch * 65536 + rem;
            const float ds = glast[off], dec = gdec[((size_t)ch * 2 + z) * 256 + h * 64 + d];
            sprev[off] = (bf16_t)f2bf(S); S = dec * S + ds; }
    }
    const float* hloc = (const float*)(ws + WS_HLOC); bf16_t* ucat = (bf16_t*)(ws + WS_UCAT); const float* lb64 = (const float*)(ws + WS_LB64);
    for (int idx = F.bid * NTHR + F.tid; idx < 16 * NB * 2 * 64; idx += F.G * NTHR) {
        const int p = idx & 63, z = (idx >> 6) & 1, b = (idx >> 7) & 3, g = idx >> 9;
        const f32x2 lb = *(const f32x2*)(lb64 + ((size_t)((l * 2 + z) * 16 + g) * 64 + p) * 2);
        float hr = 0.f, hi = 0.f;
        for (int st = 0; st < 132; ++st) {
            int ch; if (z == 0) ch = st < 4 ? 512 + b * 4 + st : b * 128 + (st - 4); else ch = st < 4 ? 512 + b * 4 + (3 - st) : b * 128 + (131 - st);
            const f32x2 hl = *(const f32x2*)(hloc + ((size_t)g * NCHP + ch) * 256 + z * 128 + p * 2);
            *(unsigned*)(ucat + ((size_t)g * NCHP + ch) * S5K + 1024 + z * 128 + p * 2) = pk2(hr, hi);
            const float nr = lb.x * hr - lb.y * hi + hl.x, ni = lb.x * hi + lb.y * hr + hl.y; hr = nr; hi = ni; }
    }
}

__device__ __forceinline__ void gla_out(const Frame& F0, CArgsP A, int l) {
    Frame F = F0; F.tid = opq(F0.tid); F.lane = F.tid & 63; F.wave = __builtin_amdgcn_readfirstlane(F.tid >> 6); F.ws = opq_p(F0.ws);
    unsigned char* ws = F.ws;
    const bf16_t* proj = (const bf16_t*)(ws + WS_PROJ); bf16_t* mixed = (bf16_t*)(ws + WS_MIXED);
    const bf16_t* QS = (const bf16_t*)(ws + WS_QS); const bf16_t* KS = (const bf16_t*)(ws + WS_KS); const bf16_t* QH = (const bf16_t*)(ws + WS_QH);
    const bf16_t* VTg = (const bf16_t*)(ws + WS_VT); const bf16_t* sprev = (const bf16_t*)(ws + WS_SPREV);
    const float* ng = A->in[13] + (size_t)l * 512;
    LAS unsigned char* Pl = F.lds;
    LAS float* red = (LAS float*)(F.lds + 64 * 144);
    const int tm = F.wave & 3, eh = F.wave >> 2, q = F.lane >> 4, c = F.lane & 15;
    for (int uu = F.bid; uu < NCH * 4; uu += F.G) {
        const int ch = uu >> 2, h = uu & 3, tk0 = ch * 64;
#pragma unroll
        for (int si = 0; si < 2; ++si) { const int stl = 2 * eh + si;
            f32x4 sf = (f32x4){0.f, 0.f, 0.f, 0.f}, sb = (f32x4){0.f, 0.f, 0.f, 0.f};
#pragma unroll
            for (int ks = 0; ks < 2; ++ks) {
                const bf16x8 kf = frag_glb(KS + h * 64, (size_t)0 * T + tk0 + stl * 16, 256, ks * 32, F.lane), qf = frag_glb(QS + h * 64, (size_t)0 * T + tk0 + tm * 16, 256, ks * 32, F.lane);
                const bf16x8 kb = frag_glb(KS + h * 64, (size_t)1 * T + tk0 + stl * 16, 256, ks * 32, F.lane), qb = frag_glb(QS + h * 64, (size_t)1 * T + tk0 + tm * 16, 256, ks * 32, F.lane);
                sf = MFMA16(kf, qf, sf); sb = MFMA16(kb, qb, sb); }
            const int t = tm * 16 + c, s0 = stl * 16 + 4 * q;
            u32x2 o; o.x = pk2((s0 + 0) <= t ? sf[0] : sb[0], (s0 + 1) <= t ? sf[1] : sb[1]); o.y = pk2((s0 + 2) <= t ? sf[2] : sb[2], (s0 + 3) <= t ? sf[3] : sb[3]);
            *(LAS u32x2*)(Pl + t * 144 + s0 * 2) = o; }
        __syncthreads();
        f32x4 acc[4];
#pragma unroll
        for (int a = 0; a < 4; ++a) acc[a] = (f32x4){0.f, 0.f, 0.f, 0.f};
#pragma unroll
        for (int ks = 0; ks < 2; ++ks) { const bf16x8 pf = frag_lds(Pl, tm * 16, 144, ks * 32, F.lane);
#pragma unroll
            for (int a = 0; a < 4; ++a) { const bf16x8 vf = frag_glb(VTg, ((size_t)ch * 4 + h) * 128 + eh * 64 + a * 16, 64, ks * 32, F.lane); acc[a] = MFMA16(vf, pf, acc[a]); } }
#pragma unroll
        for (int ks = 0; ks < 4; ++ks) { const bf16x8 qf = frag_glb(QH + h * 128, (size_t)tk0 + tm * 16, 512, ks * 32, F.lane);
#pragma unroll
            for (int a = 0; a < 4; ++a) { const bf16x8 sfr = frag_glb(sprev, ((size_t)ch * 4 + h) * 128 + eh * 64 + a * 16, 128, ks * 32, F.lane); acc[a] = MFMA16(sfr, qf, acc[a]); } }
        float ss = 0.f;
#pragma unroll
        for (int a = 0; a < 4; ++a) ss += (acc[a][0] * acc[a][0] + acc[a][1] * acc[a][1]) + (acc[a][2] * acc[a][2] + acc[a][3] * acc[a][3]);
        ss += __shfl_xor(ss, 16); ss += __shfl_xor(ss, 32);
        if (q == 0) red[eh * 64 + tm * 16 + c] = ss;
        __syncthreads();
        const float rinv = rsqrtf((red[tm * 16 + c] + red[64 + tm * 16 + c]) * (1.0f / 128.0f) + LN_EPS);
        const int tok = tk0 + tm * 16 + c;
#pragma unroll
        for (int a = 0; a < 4; ++a) { const int e0 = h * 128 + eh * 64 + a * 16 + 4 * q; const u32x2 gw = *(const u32x2*)(proj + (size_t)tok * PROJW + 1536 + e0); const f32x4 nv = *(const f32x4*)(ng + e0);
            u32x2 o; o.x = pk2(acc[a][0] * rinv * nv[0] * siluf_(bf2f(gw.x & 0xffffu)), acc[a][1] * rinv * nv[1] * siluf_(bf2f(gw.x >> 16)));
            o.y = pk2(acc[a][2] * rinv * nv[2] * siluf_(bf2f(gw.y & 0xffffu)), acc[a][3] * rinv * nv[3] * siluf_(bf2f(gw.y >> 16)));
            *(u32x2*)(mixed + (size_t)tok * 1024 + 256 + e0) = o; }
        __syncthreads();
    }
}

__device__ __forceinline__ void ln1_router(const Frame& F0, CArgsP A, int l, int ntok) {
    Frame F = F0; F.tid = opq(F0.tid); F.lane = F.tid & 63; F.wave = __builtin_amdgcn_readfirstlane(F.tid >> 6); F.ws = opq_p(F0.ws);
    unsigned char* ws = F.ws;
    float* X = (float*)(ws + WS_X); const float* TMP = (const float*)(ws + WS_TMP); bf16_t* H = (bf16_t*)(ws + WS_H); const float* mod = (const float*)(ws + WS_MOD) + (size_t)l * 5 * 6144;
    int* topi = (int*)(ws + WS_TOPI); float* gate = (float*)(ws + WS_GATE); int* wgcnt = (int*)(ws + WS_WGCNT);
    const float* lg = A->in[25] + (size_t)(l * 2 + 0) * D; const float* lb = A->in[26] + (size_t)(l * 2 + 0) * D;
    const float* rw = A->in[27] + (size_t)l * D * NEXP; const float* rb = A->in[28] + l * NEXP;
    LAS float* WrT = (LAS float*)F.lds;
    volatile LAS int* hist = (volatile LAS int*)(F.CTLW + 32);
    for (int i = F.tid; i < D * NEXP; i += NTHR) { const int k = i >> 5, e = i & 31; WrT[e * 1024 + k] = rw[i]; }
    if (F.tid < 32) hist[F.tid] = 0;
    __syncthreads();
    const int per = ntok / F.G, t0 = F.bid * per;
    for (int ti = F.wave; ti < per; ti += NWAVES) {
        const int tk = t0 + ti; const float* mv = mod + (size_t)tok_vec(tk) * 6144;
        f32x4 v[4]; float s = 0.f;
#pragma unroll
        for (int j = 0; j < 4; ++j) { const int c = 4 * F.lane + 256 * j; const f32x4 x = *(const f32x4*)(X + (size_t)tk * D + c), tp = *(const f32x4*)(TMP + (size_t)tk * D + c), g1 = *(const f32x4*)(mv + 2048 + c);
            v[j] = x * DN_ALPHA + g1 * tp; s += (v[j][0] + v[j][1]) + (v[j][2] + v[j][3]); }
        const float mean = wave_sum(s) * (1.0f / D); float s2 = 0.f;
#pragma unroll
        for (int j = 0; j < 4; ++j) { v[j] = v[j] - mean; s2 += (v[j][0] * v[j][0] + v[j][1] * v[j][1]) + (v[j][2] * v[j][2] + v[j][3] * v[j][3]); }
        const float rstd = rsqrtf(wave_sum(s2) * (1.0f / D) + LN_EPS);
#pragma unroll
        for (int j = 0; j < 4; ++j) { const int c = 4 * F.lane + 256 * j; const f32x4 g = *(const f32x4*)(lg + c), b = *(const f32x4*)(lb + c);
            const f32x4 xn = v[j] * rstd * g + b; *(f32x4*)(X + (size_t)tk * D + c) = xn;
            const f32x4 sh = *(const f32x4*)(mv + 3072 + c), sc = *(const f32x4*)(mv + 4096 + c); const f32x4 h = xn * (sc + 1.0f) + sh; v[j] = h;
            u32x2 o; o.x = pk2(h[0], h[1]); o.y = pk2(h[2], h[3]); *(u32x2*)(H + (size_t)tk * D + c) = o; }
        float pe[32];
#pragma unroll
        for (int e = 0; e < 32; ++e) { float a = 0.f;
#pragma unroll
            for (int j = 0; j < 4; ++j) { const f32x4 w = *(const LAS f32x4*)(WrT + e * 1024 + 4 * F.lane + 256 * j); a += (v[j][0] * w[0] + v[j][1] * w[1]) + (v[j][2] * w[2] + v[j][3] * w[3]); }
            pe[e] = a; }
        float r16[16], r8[8], r4[4], r2[2], r1;
        { const bool hi = (F.lane & 32) != 0;
#pragma unroll
            for (int i = 0; i < 16; ++i) { const float mine = hi ? pe[16 + i] : pe[i], oth = hi ? pe[i] : pe[16 + i]; r16[i] = mine + __shfl_xor(oth, 32); } }
        { const bool hi = (F.lane & 16) != 0;
#pragma unroll
            for (int i = 0; i < 8; ++i) { const float mine = hi ? r16[8 + i] : r16[i], oth = hi ? r16[i] : r16[8 + i]; r8[i] = mine + __shfl_xor(oth, 16); } }
        { const bool hi = (F.lane & 8) != 0;
#pragma unroll
            for (int i = 0; i < 4; ++i) { const float mine = hi ? r8[4 + i] : r8[i], oth = hi ? r8[i] : r8[4 + i]; r4[i] = mine + __shfl_xor(oth, 8); } }
        { const bool hi = (F.lane & 4) != 0;
#pragma unroll
            for (int i = 0; i < 2; ++i) { const float mine = hi ? r4[2 + i] : r4[i], oth = hi ? r4[i] : r4[2 + i]; r2[i] = mine + __shfl_xor(oth, 4); } }
        { const bool hi = (F.lane & 2) != 0; const float mine = hi ? r2[1] : r2[0], oth = hi ? r2[0] : r2[1]; r1 = mine + __shfl_xor(oth, 2); }
        r1 += __shfl_xor(r1, 1);
        const int mye = F.lane >> 1;
        float val = r1 + rb[mye];
        float tv[4]; int te[4];
#pragma unroll
        for (int k = 0; k < 4; ++k) { float mvv = val; int mi = mye;
#pragma unroll
            for (int o = 1; o < 64; o <<= 1) { const float ov = __shfl_xor(mvv, o); const int oi = __shfl_xor(mi, o); if (ov > mvv || (ov == mvv && oi < mi)) { mvv = ov; mi = oi; } }
            tv[k] = mvv; te[k] = mi; if (mye == mi) val = -3.0e38f; }
        const float e1 = __expf(tv[1] - tv[0]), e2 = __expf(tv[2] - tv[0]), e3 = __expf(tv[3] - tv[0]); const float inv = 1.0f / (1.0f + e1 + e2 + e3);
        if (F.lane == 0) { *(int4*)(topi + (size_t)tk * 4) = make_int4(te[0], te[1], te[2], te[3]); *(f32x4*)(gate + (size_t)tk * 4) = (f32x4){inv, e1 * inv, e2 * inv, e3 * inv}; }
        if (F.lane < 4) { const int e = F.lane == 0 ? te[0] : (F.lane == 1 ? te[1] : (F.lane == 2 ? te[2] : te[3])); __hip_atomic_fetch_add((LAS int*)&hist[e], 1, __ATOMIC_RELAXED, __HIP_MEMORY_SCOPE_WORKGROUP); }
    }
    __syncthreads();
    if (F.tid < 32) wgcnt[F.bid * 32 + F.tid] = hist[F.tid];
}

__device__ __forceinline__ void slots_phase(const Frame& F0, int ntok) {
    Frame F = F0; F.tid = opq(F0.tid); F.lane = F.tid & 63; F.wave = __builtin_amdgcn_readfirstlane(F.tid >> 6); F.ws = opq_p(F0.ws);
    unsigned char* ws = F.ws;
    const int* wgcnt = (const int*)(ws + WS_WGCNT); const int* topi = (const int*)(ws + WS_TOPI); int* slot_tok = (int*)(ws + WS_SLOTTOK); int* tok_slot = (int*)(ws + WS_TOKSLOT); int* ecnt = (int*)(ws + WS_ECNT);
    volatile LAS int* tot = (volatile LAS int*)(F.CTLW + 64); volatile LAS int* cur = (volatile LAS int*)(F.CTLW + 96); volatile LAS int* ebase = (volatile LAS int*)(F.CTLW + 128);
    if (F.tid < 32) { int t = 0, mb = 0; for (int w = 0; w < F.G; ++w) { const int c = wgcnt[w * 32 + F.tid]; t += c; if (w < F.bid) mb += c; } tot[F.tid] = t; cur[F.tid] = mb; }
    __syncthreads();
    if (F.tid == 0) { int p = 0; for (int e = 0; e < 32; ++e) { ebase[e] = p * 256; p += (tot[e] + 255) >> 8; } }
    __syncthreads();
    if (F.tid < 32) { cur[F.tid] += ebase[F.tid]; if (F.bid == 0) ecnt[F.tid] = tot[F.tid]; }
    __syncthreads();
    const int per = ntok / F.G, t0 = F.bid * per;
    for (int i = F.tid; i < per * 4; i += NTHR) { const int tk = t0 + (i >> 2); const int e = topi[(size_t)tk * 4 + (i & 3)];
        const int slot = __hip_atomic_fetch_add((LAS int*)&cur[e], 1, __ATOMIC_RELAXED, __HIP_MEMORY_SCOPE_WORKGROUP); slot_tok[slot] = tk; tok_slot[(size_t)tk * 4 + (i & 3)] = slot; }
    if (F.bid < 32) { const int e = F.bid; const int lo = ebase[e] + tot[e], hi = ebase[e] + (((tot[e] + 255) >> 8) << 8); for (int s = lo + F.tid; s < hi; s += NTHR) slot_tok[s] = 0; }
    __syncthreads();
}
__device__ __forceinline__ void moe_prefix(const Frame& F0) {
    Frame F = F0; F.tid = opq(F0.tid); F.lane = F.tid & 63; F.wave = __builtin_amdgcn_readfirstlane(F.tid >> 6); F.ws = opq_p(F0.ws);
    const int* ecnt = (const int*)(F.ws + WS_ECNT); volatile LAS int* pref = (volatile LAS int*)(F.CTLW + 160);
    __syncthreads();
    if (F.tid == 0) { int p = 0; for (int e = 0; e < 32; ++e) { pref[e] = p; p += (ecnt[e] + 255) >> 8; } pref[32] = p; }
    __syncthreads();
}

__device__ __forceinline__ void combine_ln2(const Frame& F0, CArgsP A, int l, int ntok) {
    Frame F = F0; F.tid = opq(F0.tid); F.lane = F.tid & 63; F.wave = __builtin_amdgcn_readfirstlane(F.tid >> 6); F.ws = opq_p(F0.ws);
    unsigned char* ws = F.ws;
    float* X = (float*)(ws + WS_X); bf16_t* H = (bf16_t*)(ws + WS_H); const bf16_t* YV = (const bf16_t*)(ws + WS_YV);
    const float* mod = (const float*)(ws + WS_MOD) + (size_t)l * 5 * 6144; const float* modn = (const float*)(ws + WS_MOD) + (size_t)(l + 1 < DEPTH ? l + 1 : l) * 5 * 6144;
    const int* tok_slot = (const int*)(ws + WS_TOKSLOT); const float* gate = (const float*)(ws + WS_GATE);
    const float* lg = A->in[25] + (size_t)(l * 2 + 1) * D; const float* lb = A->in[26] + (size_t)(l * 2 + 1) * D;
    const bool lastl = (l == DEPTH - 1);
    for (int tk = F.bid * NWAVES + F.wave; tk < ntok; tk += F.G * NWAVES) {
        const float* mv = mod + (size_t)tok_vec(tk) * 6144; const float* mn = modn + (size_t)tok_vec(tk) * 6144;
        const int4 sl = *(const int4*)(tok_slot + (size_t)tk * 4); const f32x4 gt = *(const f32x4*)(gate + (size_t)tk * 4);
        f32x4 v[4]; float s = 0.f;
#pragma unroll
        for (int j = 0; j < 4; ++j) { const int c = 4 * F.lane + 256 * j;
            const u32x2 y0 = *(const u32x2*)(YV + (size_t)sl.x * 1024 + c), y1 = *(const u32x2*)(YV + (size_t)sl.y * 1024 + c), y2 = *(const u32x2*)(YV + (size_t)sl.z * 1024 + c), y3 = *(const u32x2*)(YV + (size_t)sl.w * 1024 + c);
            f32x4 f;
            f[0] = gt[0] * bf2f(y0.x & 0xffffu) + gt[1] * bf2f(y1.x & 0xffffu) + gt[2] * bf2f(y2.x & 0xffffu) + gt[3] * bf2f(y3.x & 0xffffu);
            f[1] = gt[0] * bf2f(y0.x >> 16) + gt[1] * bf2f(y1.x >> 16) + gt[2] * bf2f(y2.x >> 16) + gt[3] * bf2f(y3.x >> 16);
            f[2] = gt[0] * bf2f(y0.y & 0xffffu) + gt[1] * bf2f(y1.y & 0xffffu) + gt[2] * bf2f(y2.y & 0xffffu) + gt[3] * bf2f(y3.y & 0xffffu);
            f[3] = gt[0] * bf2f(y0.y >> 16) + gt[1] * bf2f(y1.y >> 16) + gt[2] * bf2f(y2.y >> 16) + gt[3] * bf2f(y3.y >> 16);
            const f32x4 x = *(const f32x4*)(X + (size_t)tk * D + c), g2 = *(const f32x4*)(mv + 5120 + c);
            v[j] = x * DN_ALPHA + g2 * f; s += (v[j][0] + v[j][1]) + (v[j][2] + v[j][3]); }
        const float mean = wave_sum(s) * (1.0f / D); float s2 = 0.f;
#pragma unroll
        for (int j = 0; j < 4; ++j) { v[j] = v[j] - mean; s2 += (v[j][0] * v[j][0] + v[j][1] * v[j][1]) + (v[j][2] * v[j][2] + v[j][3] * v[j][3]); }
        const float rstd = rsqrtf(wave_sum(s2) * (1.0f / D) + LN_EPS);
#pragma unroll
        for (int j = 0; j < 4; ++j) { const int c = 4 * F.lane + 256 * j; const f32x4 g = *(const f32x4*)(lg + c), b = *(const f32x4*)(lb + c); const f32x4 xn = v[j] * rstd * g + b;
            if (lastl) { *(f32x4*)(A->out + (size_t)tk * D + c) = xn; }
            else { *(f32x4*)(X + (size_t)tk * D + c) = xn; const f32x4 sh = *(const f32x4*)(mn + c), sc = *(const f32x4*)(mn + 1024 + c); const f32x4 h = xn * (sc + 1.0f) + sh;
                u32x2 o; o.x = pk2(h[0], h[1]); o.y = pk2(h[2], h[3]); *(u32x2*)(H + (size_t)tk * D + c) = o; } }
    }
}

constexpr int NPL = 11, NPH = 3 + DEPTH * NPL;
__global__ void __launch_bounds__(NTHR, 2) hybrid_fwd(Args args) {
    extern __shared__ __attribute__((aligned(16))) unsigned char lds[];
    Frame F;
    F.lds = (LAS unsigned char*)lds; F.CTLW = (volatile LAS unsigned*)(F.lds + LDSCTL_OFF);
    F.tid = threadIdx.x; F.lane = F.tid & 63; F.wave = __builtin_amdgcn_readfirstlane(F.tid >> 6); F.G = gridDim.x; F.bid = blockIdx.x; F.ws = args.ws;
    unsigned char* ws = args.ws;
    for (int u = F.tid; u < 256; u += NTHR) F.CTLW[u] = 0u;
    __syncthreads();
    XcdBarrier bar; bar.bar = (unsigned*)(ws + WS_CTL) + CW_BAR; bar.x = 0; bar.st = nullptr;
    if (MK_N_LAUNCHES == 1) bar = xcd_barrier_post((unsigned*)(ws + WS_CTL) + CW_BAR, F.CTLW + 8);
    const int lo = args.ph_lo, hi = args.ph_hi;
#ifndef PHMASK
#define PHMASK 0xFFFFFFFFu
#endif
#define IN(k) (lo <= (k) && (k) < hi)
#define ON(b) ((PHMASK >> (b)) & 1u)
#define SEAM(k) do { if (IN((k) + 1)) { XcdBarrier _b = bar; _b.bar = (unsigned*)opq_p((unsigned char*)_b.bar); asm volatile("" : "+s"(_b.x)); xcd_barrier(_b); } } while (0)
    if (ON(0) && IN(0)) { ph0_prologue(F, argp()); SEAM(0); }
    if (ON(1) && IN(1)) { ph1_mod(F, argp()); SEAM(1); }
    if (ON(2) && IN(2)) { ph2_init(F, argp()); SEAM(2); }
    for (int l = 0; l < DEPTH; ++l) {
        const int pb = 3 + l * NPL;
        const int ntok = (l == DEPTH - 1) ? TLAT : T;
        if (ON(3) && IN(pb + 0)) {
            unsigned char* ws = opq_p(F.ws); CArgsP AP = argp(); (void)AP;
            typedef pg8::DenseSched<T / 256, NINP / 256> SchedT; SchedT S{(const char*)(ws + WS_H), (const char*)(ws + WS_WIN) + (size_t)l * NINP * 2048, (size_t)256 * 2048, (size_t)256 * 2048, F.G, F.bid};
            EpiInProj E{(bf16_t*)(ws + WS_PROJ), (bf16_t*)(ws + WS_UCAT), (float*)(ws + WS_GL)};
            pg8::gemm_phase<EpiInProj, SchedT, false>(F.lds, 2048u, 2048u, 1024, S, E);
            SEAM(pb + 0);
        }
        if (ON(4) && IN(pb + 1)) {
            unsigned char* ws = opq_p(F.ws); CArgsP AP = argp(); (void)AP;
            typedef pg8::BatchSched<NCHP / 256, 1, 16> SchedT; SchedT S{(const char*)(ws + WS_UCAT), (const char*)(ws + WS_S5F) + (size_t)l * 16 * 256 * 2048, (size_t)NCHP * S5K * 2, (size_t)256 * 2048, (size_t)256 * S5K * 2, (size_t)256 * 2048, F.G, (F.bid + 128) & 255};
            EpiHloc E{(float*)(ws + WS_HLOC)};
#ifndef SUBMASK
#define SUBMASK 7
#endif
            if (SUBMASK & 1) pg8::gemm_phase<EpiHloc, SchedT, false>(F.lds, (unsigned)(S5K * 2), 2048u, 1024, S, E);
            __syncthreads();
            if (SUBMASK & 2) gla_local(F, argp(), l);
            if (SUBMASK & 4) sgu_phase(F, argp(), l);
            SEAM(pb + 1);
        }
        if (ON(5) && IN(pb + 2)) { scan_phase(F, argp(), l); SEAM(pb + 2); }
        if (ON(6) && IN(pb + 3)) {
            unsigned char* ws = opq_p(F.ws); CArgsP AP = argp(); (void)AP;
            typedef pg8::BatchSched<NCHP / 256, 4, 16> SchedT; SchedT S{(const char*)(ws + WS_UCAT), (const char*)(ws + WS_S5M) + (size_t)l * 16 * 1024 * S5K * 2, (size_t)NCHP * S5K * 2, (size_t)1024 * S5K * 2, (size_t)256 * S5K * 2, (size_t)256 * S5K * 2, F.G, F.bid};
            EpiS5Y E{(bf16_t*)(ws + WS_YS5)};
            pg8::gemm_phase<EpiS5Y, SchedT, false>(F.lds, (unsigned)(S5K * 2), (unsigned)(S5K * 2), S5K, S, E);
            __syncthreads();
            gla_out(F, argp(), l);
            SEAM(pb + 3);
        }
        if (ON(7) && IN(pb + 4)) {
            unsigned char* ws = opq_p(F.ws); CArgsP AP = argp(); (void)AP;
            typedef pg8::DenseSched<T / 256, 1> SchedT; SchedT S{(const char*)(ws + WS_YS5), (const char*)(ws + WS_GLUT) + (size_t)l * 256 * 512, (size_t)256 * 512, (size_t)256 * 512, F.G, F.bid};
            EpiGlu E{(const bf16_t*)(ws + WS_YS5), (bf16_t*)(ws + WS_MIXED), AP->in[23] + l * 256};
            pg8::gemm_phase<EpiGlu, SchedT, false>(F.lds, 512u, 512u, 256, S, E);
            SEAM(pb + 4);
        }
        if (ON(8) && IN(pb + 5)) {
            unsigned char* ws = opq_p(F.ws); CArgsP AP = argp(); (void)AP;
            typedef pg8::DenseSched<T / 256, 4> SchedT; SchedT S{(const char*)(ws + WS_MIXED), (const char*)(ws + WS_WOUT) + (size_t)l * 1024 * 2048, (size_t)256 * 2048, (size_t)256 * 2048, F.G, F.bid};
            EpiF32 E{(float*)(ws + WS_TMP), 1024};
            pg8::gemm_phase<EpiF32, SchedT, false>(F.lds, 2048u, 2048u, 1024, S, E);
            SEAM(pb + 5);
        }
        if (ON(9) && IN(pb + 6)) { ln1_router(F, argp(), l, ntok); SEAM(pb + 6); }
        if (ON(10) && IN(pb + 7)) { slots_phase(F, ntok); SEAM(pb + 7); }
        if (ON(11) && IN(pb + 8)) {
            unsigned char* ws = opq_p(F.ws); CArgsP AP = argp(); (void)AP;
            moe_prefix(F);
            pg8::MoeSched<8, true> S{(const char*)(ws + WS_H), (const char*)(ws + WS_WUP) + (size_t)l * 32 * 2048 * 2048, (const int*)(ws + WS_SLOTTOK), (const LAS int*)(F.CTLW + 160), 0, (size_t)2048 * 2048, (size_t)256 * 2048, F.G, F.bid};
            EpiUp E{(bf16_t*)(ws + WS_ACT), AP->in[30] + (size_t)l * 32 * 2048};
            pg8::gemm_phase<EpiUp, pg8::MoeSched<8, true>, true>(F.lds, 2048u, 2048u, 1024, S, E);
            SEAM(pb + 8);
        }
        if (ON(12) && IN(pb + 9)) {
            unsigned char* ws = opq_p(F.ws); CArgsP AP = argp(); (void)AP;
            moe_prefix(F);
            pg8::MoeSched<4, false> S{(const char*)(ws + WS_ACT), (const char*)(ws + WS_WDN) + (size_t)l * 32 * 1024 * 2048, (const int*)(ws + WS_SLOTTOK), (const LAS int*)(F.CTLW + 160), (size_t)256 * 2048, (size_t)1024 * 2048, (size_t)256 * 2048, F.G, F.bid};
            EpiDown E{(bf16_t*)(ws + WS_YV), AP->in[32] + (size_t)l * 32 * 1024};
            pg8::gemm_phase<EpiDown, pg8::MoeSched<4, false>, false>(F.lds, 2048u, 2048u, 1024, S, E);
            SEAM(pb + 9);
        }
        if (ON(13) && IN(pb + 10)) { combine_ln2(F, argp(), l, ntok); SEAM(pb + 10); }
    }
#undef IN
#undef SEAM
}

extern "C" void kernel_launch(void* const* d_in, const int* in_sizes, int n_in, void* d_out, int out_size, void* d_ws, size_t ws_size, hipStream_t stream) {
    static int grid = 0;
    if (grid == 0) {
        if (n_in != 33 || out_size != TLAT * D || ws_size < WS_END) { fprintf(stderr, "kernel_launch: unexpected problem (n_in %d, out %d, ws %zu)\n", n_in, out_size, ws_size); grid = -1; return; }
        int dev = 0, cus = 0, per_cu = 0;
        if (hipGetDevice(&dev) != hipSuccess || hipDeviceGetAttribute(&cus, hipDeviceAttributeMultiprocessorCount, dev) != hipSuccess) { grid = -1; return; }
        if (hipFuncSetAttribute((const void*)hybrid_fwd, hipFuncAttributeMaxDynamicSharedMemorySize, LDS_BYTES) != hipSuccess) { fprintf(stderr, "kernel_launch: hipFuncSetAttribute failed\n"); grid = -1; return; }
        if (hipOccupancyMaxActiveBlocksPerMultiprocessor(&per_cu, (const void*)hybrid_fwd, NTHR, LDS_BYTES) != hipSuccess || per_cu < 1) fprintf(stderr, "kernel_launch: occupancy query says %d\n", per_cu);
        (void)hipGetLastError();
        grid = cus;
        if (grid != 256) { fprintf(stderr, "kernel_launch: built for 256 CUs, found %d\n", cus); grid = -1; return; }
    }
    if (grid < 0) return;
    if (hipMemsetAsync((char*)d_ws + WS_CTL, 0, CTL_ZERO_BYTES, stream) != hipSuccess) return;
    Args a{};
    for (int i = 0; i < 33; ++i) a.in[i] = (const float*)d_in[i];
    a.out = (float*)d_out; a.ws = (unsigned char*)d_ws;
#if MK_N_LAUNCHES == 1
    a.ph_lo = 0; a.ph_hi = NPH;
    hipLaunchKernelGGL(hybrid_fwd, dim3(grid), dim3(NTHR), LDS_BYTES, stream, a);
#else
    for (int p = 0; p < NPH; ++p) { a.ph_lo = p; a.ph_hi = p + 1; hipLaunchKernelGGL(hybrid_fwd, dim3(grid), dim3(NTHR), LDS_BYTES, stream, a); }
#endif
}
```

```cpp
#include <hip/hip_runtime.h>
#include <cstdio>
#include <cstdint>

#define REPMASK 0u
#ifndef MK_N_LAUNCHES
#define MK_N_LAUNCHES 1
#endif

#define GAS __attribute__((address_space(1)))
#define LAS __attribute__((address_space(3)))
typedef unsigned short bf16_t;
typedef short bf16x8 __attribute__((ext_vector_type(8)));
typedef float f32x4 __attribute__((ext_vector_type(4)));
typedef float f32x2 __attribute__((ext_vector_type(2)));
typedef unsigned u32x4 __attribute__((ext_vector_type(4)));
typedef unsigned u32x2 __attribute__((ext_vector_type(2)));

constexpr int D = 1024, NB = 4, SEQ = 8192, DEPTH = 4, CTXL = 256;
constexpr int TLAT = NB * SEQ, TCTX = NB * CTXL, T = TLAT + TCTX;
constexpr int NIN = 2336, NINP = 2560, PROJW = 2048;
constexpr int NCH = T / 64, NCHP = 768;
constexpr int NEXP = 32, DEXP = 1024;
constexpr int MAXTILES = 560, NSLOT = MAXTILES * 256;
constexpr int S5K = 1280;
constexpr float LN_EPS = 1e-5f;
constexpr float DN_ALPHA = 1.681792830507429f;
constexpr int NWAVES = 8, NTHR = 512;

constexpr size_t MiB = 1u << 20;
constexpr size_t WS_CTL = 0, CTL_ZERO_BYTES = 1 * MiB;
constexpr size_t WS_MODP = 1 * MiB, WS_MOD = 5 * MiB, WS_LB64 = 6 * MiB, WS_KTAB = 7 * MiB, WS_SGUW = 15 * MiB, WS_GLUT = 16 * MiB;
constexpr size_t WS_WIN = 17 * MiB, WS_WOUT = 37 * MiB, WS_S5M = 45 * MiB, WS_S5F = 205 * MiB, WS_WUP = 237 * MiB, WS_WDN = 749 * MiB;
constexpr size_t WS_X = 1005 * MiB, WS_H = 1137 * MiB, WS_PROJ = 1203 * MiB, WS_GL = 1335 * MiB, WS_UCAT = 1340 * MiB, WS_HLOC = 1370 * MiB;
constexpr size_t WS_YS5 = 1382 * MiB, WS_QS = 1399 * MiB, WS_KS = 1432 * MiB, WS_QH = 1465 * MiB, WS_VT = 1498 * MiB, WS_GLAST = 1531 * MiB;
constexpr size_t WS_SPREV = 1663 * MiB, WS_GDEC = 1729 * MiB, WS_MIXED = 1731 * MiB, WS_TMP = 1797 * MiB, WS_TOPI = 1929 * MiB, WS_GATE = 1930 * MiB;
constexpr size_t WS_WGCNT = 1931 * MiB, WS_ECNT = 1932 * MiB, WS_SLOTTOK = 1933 * MiB, WS_TOKSLOT = 1934 * MiB, WS_ACT = 1935 * MiB, WS_YV = 2215 * MiB;
constexpr size_t WS_WRT = 2495 * MiB, WS_END = 2496 * MiB;
constexpr int CW_BAR = 4096;

constexpr int RING_BYTES = 131072;
constexpr int LDS_BYTES = 163840;
constexpr int LDSCTL_OFF = LDS_BYTES - 1024;

__device__ __forceinline__ float bf2f(unsigned b) { return __uint_as_float(b << 16); }
__device__ __forceinline__ unsigned f2bf(float f) { unsigned u = __float_as_uint(f); return (u + 0x7fffu + ((u >> 16) & 1u)) >> 16; }
__device__ __forceinline__ unsigned pk2(float lo, float hi) { return f2bf(lo) | (f2bf(hi) << 16); }
__device__ __forceinline__ unsigned cvt_pk_bf16(float lo, float hi) { unsigned r; asm volatile("v_cvt_pk_bf16_f32 %0, %1, %2" : "=v"(r) : "v"(lo), "v"(hi)); return r; }
__device__ __forceinline__ float rcpf(float x) { return __builtin_amdgcn_rcpf(x); }
__device__ __forceinline__ float sigmoidf_(float x) { return rcpf(1.0f + __expf(-x)); }
__device__ __forceinline__ float siluf_(float x) { return x * sigmoidf_(x); }
__device__ __forceinline__ float gelu_tanh(float x) { const float u = 0.7978845608028654f * (x + 0.044715f * x * x * x); const float e = __expf(2.0f * u); return x * (1.0f - rcpf(1.0f + e)); }
__device__ __forceinline__ float logsigmoidf_(float x) { return fminf(x, 0.0f) - __logf(1.0f + __expf(-fabsf(x))); }
__device__ __forceinline__ float wave_sum(float v) {
#pragma unroll
    for (int o = 1; o < 64; o <<= 1) v += __shfl_xor(v, o);
    return v;
}
__device__ __forceinline__ int opq(int x) { asm volatile("" : "+v"(x)); return x; }
__device__ __forceinline__ int tok_vec(int tk) { return tk < TLAT ? (tk >> 13) : 4; }

#define XB_TMO      128
#define XB_XCNT(j)  (256  + 64 * (j))
#define XB_XSUB(j)  (1280 + 64 * (j))
#define XB_XGEN(j)  (2304 + 64 * (j))
#define XB_TOP      3328
#define XB_TOPGEN   3392
#define XCD_BAR_WORDS 3456
#define XB_SPIN_CAP (1u << 20)
__device__ __forceinline__ unsigned xb_ld(unsigned* p)              { return __hip_atomic_load(p, __ATOMIC_RELAXED, __HIP_MEMORY_SCOPE_AGENT); }
__device__ __forceinline__ unsigned xb_add(unsigned* p, unsigned v) { return __hip_atomic_fetch_add(p, v, __ATOMIC_RELAXED, __HIP_MEMORY_SCOPE_AGENT); }
__device__ __forceinline__ unsigned xb_xcc_id() { return (unsigned)__builtin_amdgcn_s_getreg((3 << 11) | 20) & 0xFu; }
#define XB_SPIN(cond, bar) do { unsigned _sp = 0; while (cond) { __builtin_amdgcn_s_sleep(1); \
    if ((++_sp & 255u) == 0u) { if (xb_ld(&(bar)[XB_TMO])) break; if (_sp > XB_SPIN_CAP) { atomicAdd(&(bar)[XB_TMO], 1u); break; } } } } while (0)
struct XcdBarrier { unsigned* bar; unsigned x; volatile LAS unsigned* st; };
__device__ __forceinline__ XcdBarrier xcd_barrier_post(unsigned* bar, volatile LAS unsigned* st) {
    XcdBarrier b; b.bar = bar; b.x = xb_xcc_id(); b.st = st;
    if (threadIdx.x == 0) (void)xb_add(&bar[XB_XCNT(b.x)], 1u);
    return b;
}
__device__ __forceinline__ void xcd_barrier_complete(unsigned* bar, unsigned x, unsigned& nloc, unsigned& nx) {
    const unsigned G = gridDim.x * gridDim.y * gridDim.z;
    unsigned sum, cnt, mine, sp = 0u;
    for (;;) {
        sum = 0u; cnt = 0u; mine = 0u;
#pragma unroll
        for (unsigned j = 0; j < 16; ++j) { const unsigned c = xb_ld(&bar[XB_XCNT(j)]); sum += c; cnt += (c > 0u) ? 1u : 0u; mine = (j == x) ? c : mine; }
        if (sum == G) break;
        __builtin_amdgcn_s_sleep(1);
        if ((++sp & 255u) == 0u) { if (xb_ld(&bar[XB_TMO])) break; if (sp > XB_SPIN_CAP) { atomicAdd(&bar[XB_TMO], 1u); break; } }
    }
    nloc = mine > 0u ? mine : 1u; nx = cnt > 0u ? cnt : 1u;
}
__device__ __forceinline__ void xcd_barrier(const XcdBarrier& b) {
    asm volatile("s_waitcnt vmcnt(0)" ::: "memory");
    __syncthreads();
    if (threadIdx.x == 0) {
        unsigned* bar = b.bar;
        __builtin_amdgcn_s_waitcnt(0);
        unsigned nloc = b.st[0], nx = b.st[1];
        if (nloc == 0u) { xcd_barrier_complete(bar, b.x, nloc, nx); b.st[0] = nloc; b.st[1] = nx; }
        const unsigned old = xb_add(&bar[XB_XSUB(b.x)], 1u);
        const unsigned gen = old / nloc;
        if (old + 1u == (gen + 1u) * nloc) {
            __builtin_amdgcn_fence(__ATOMIC_RELEASE, "agent");
            asm volatile("s_waitcnt vmcnt(0)" ::: "memory");
            const unsigned og = xb_add(&bar[XB_TOP], 1u);
            const unsigned tg = og / nx;
            if (og + 1u == (tg + 1u) * nx) xb_add(&bar[XB_TOPGEN], 1u);
            else XB_SPIN(xb_ld(&bar[XB_TOPGEN]) == tg, bar);
            __builtin_amdgcn_fence(__ATOMIC_ACQUIRE, "agent");
            xb_add(&bar[XB_XGEN(b.x)], 1u);
            asm volatile("s_waitcnt vmcnt(0)" ::: "memory");
        } else {
            XB_SPIN(xb_ld(&bar[XB_XGEN(b.x)]) == gen, bar);
            __builtin_amdgcn_fence(__ATOMIC_ACQUIRE, "agent");
            asm volatile("s_waitcnt vmcnt(0)" ::: "memory");
        }
    }
    __syncthreads();
}

namespace pg8 {
constexpr int BM = 256, BK = 64, HALF = 128, HTB = HALF * BK * 2, STAGE_BYTES = 8 * HTB, NXCD = 8, WGM = 8;
__host__ __device__ __forceinline__ int lds_byte(int r, int c) { const int st = (r >> 4) * 2 + (c >> 5), rr = r & 15, cc = c & 31, ob = rr * 64 + cc * 2; return st * 1024 + (ob ^ (((ob >> 9) & 1) << 5)); }
__host__ __device__ __forceinline__ void stage_rc(int b, int& R, int& C) { const int st = b / 1024, sb = b % 1024, swz = sb ^ (((sb >> 9) & 1) << 5); R = (st >> 1) * 16 + swz / 64; C = (st & 1) * 32 + (swz % 64) / 2; }
__host__ __device__ __forceinline__ int perm32(int rho) { const int n = rho >> 4, i = rho & 15; return 8 * (i >> 2) + 4 * n + (i & 3); }

struct GUnit { const char* a; const char* b; const int* rows; int pm, pn, grp; };

template <class Epi, class Sched, bool GATHER>
__device__ __forceinline__ void gemm_phase(LAS unsigned char* lds, const unsigned lda, const unsigned ldb, const int K, const Sched& S, const Epi& E) {
    const int tid = opq((int)threadIdx.x), wid = __builtin_amdgcn_readfirstlane(tid >> 6), lane = tid & 63, wr = wid >> 2, wc = wid & 3, fr = lane & 15, fq = lane >> 4;
    int Kq = K; asm volatile("" : "+s"(Kq)); const int nt = Kq / BK;
    unsigned voffB[2], cA0[2], cA1[2], nA0[2], nA1[2];
#pragma unroll
    for (int i = 0; i < 2; ++i) { int R, C; stage_rc(tid * 16 + i * 8192, R, C); const int Rb = Epi::PERM ? ((R & ~31) + perm32(R & 31)) : R;
        voffB[i] = (unsigned)Rb * ldb + (unsigned)C * 2u; }
    const size_t kstep = (size_t)(BK * 2);
    const size_t hstepB = (size_t)HALF * ldb;
    const unsigned ldsw = (unsigned)wid * 1024u;
    const int aoff = lds_byte(wr * 64 + fr, fq * 8), boff = lds_byte(wc * 32 + fr, fq * 8);
#define PG8_AOFF(u, o0, o1) do { const int _t = opq((int)threadIdx.x); _Pragma("unroll") for (int _i = 0; _i < 2; ++_i) { int _R, _C; stage_rc(_t * 16 + _i * 8192, _R, _C); \
        if (GATHER) { o0[_i] = (unsigned)(u).rows[_R] * lda + (unsigned)_C * 2u; o1[_i] = (unsigned)(u).rows[_R + HALF] * lda + (unsigned)_C * 2u; } \
        else { o0[_i] = (unsigned)_R * lda + (unsigned)_C * 2u; o1[_i] = o0[_i] + (unsigned)HALF * lda; } } } while (0)
#define PG8_SA(b, h) (((b) * 2 + (h)) * HTB)
#define PG8_SB(b, h) ((4 + (b) * 2 + (h)) * HTB)
#define PG8_STAGE(bufoff, gbase, voff) do { _Pragma("unroll") for (int _i = 0; _i < 2; ++_i) \
        __builtin_amdgcn_global_load_lds((const unsigned*)((const char*)(gbase) + (voff)[_i]), (LAS unsigned*)(lds + (bufoff) + ldsw + _i * 8192), 16, 0, 0); } while (0)
#define PG8_LDA(dst, b, h) do { _Pragma("unroll") for (int m = 0; m < 4; ++m) _Pragma("unroll") for (int k = 0; k < 2; ++k) dst[m][k] = *(const LAS bf16x8*)(lds + PG8_SA(b, h) + aoff + m * 2048 + k * 1024); } while (0)
#define PG8_LDB(dst, b, h) do { _Pragma("unroll") for (int n = 0; n < 2; ++n) _Pragma("unroll") for (int k = 0; k < 2; ++k) dst[n][k] = *(const LAS bf16x8*)(lds + PG8_SB(b, h) + boff + n * 2048 + k * 1024); } while (0)
#define PG8_MMA(ai, bj, At, Bt) do { __builtin_amdgcn_s_setprio(1); _Pragma("unroll") for (int m = 0; m < 4; ++m) _Pragma("unroll") for (int n = 0; n < 2; ++n) _Pragma("unroll") for (int k = 0; k < 2; ++k) \
        acc[ai][bj][m][n] = __builtin_amdgcn_mfma_f32_16x16x32_bf16(Bt[n][k], At[m][k], acc[ai][bj][m][n], 0, 0, 0); __builtin_amdgcn_s_setprio(0); } while (0)
#define PG8_WAIT_V(n) asm volatile("s_waitcnt vmcnt(" #n ")" ::: "memory")
#define PG8_WAIT_L(n) asm volatile("s_waitcnt lgkmcnt(" #n ")" ::: "memory")
#define PG8_BAR __builtin_amdgcn_s_barrier()
#define PG8_SCHED __builtin_amdgcn_sched_barrier(0)
    GUnit cur, nxt; int ui = 0;
    if (!S.next(0, cur)) return;
    f32x4 acc[2][2][4][2];
#pragma unroll
    for (int a = 0; a < 2; ++a)
#pragma unroll
        for (int b = 0; b < 2; ++b)
#pragma unroll
            for (int m = 0; m < 4; ++m)
#pragma unroll
                for (int n = 0; n < 2; ++n) acc[a][b][m][n] = (f32x4){0.f, 0.f, 0.f, 0.f};
    bf16x8 At[4][2], B0[2][2], B1[2][2];
    const char* cA = cur.a; const char* cB = cur.b;
    PG8_AOFF(cur, cA0, cA1);
    PG8_STAGE(PG8_SB(0, 0), cB, voffB); PG8_STAGE(PG8_SB(0, 1), cB + hstepB, voffB); PG8_STAGE(PG8_SA(0, 0), cA, cA0); PG8_STAGE(PG8_SA(0, 1), cA, cA1);
    if (wr == 1) PG8_BAR;
    PG8_WAIT_V(2); PG8_BAR;
    PG8_STAGE(PG8_SB(1, 0), cB + kstep, voffB); PG8_STAGE(PG8_SA(1, 0), cA + kstep, cA0); PG8_STAGE(PG8_SB(1, 1), cB + hstepB + kstep, voffB);
    PG8_WAIT_V(6); PG8_BAR;
    for (;;) {
        const bool has_next = S.next(ui + 1, nxt);
        const char* nA = has_next ? nxt.a : cA; const char* nB = has_next ? nxt.b : cB;
        if constexpr (GATHER) { if (has_next) { PG8_AOFF(nxt, nA0, nA1); } else {
#pragma unroll
            for (int i = 0; i < 2; ++i) { nA0[i] = cA0[i]; nA1[i] = cA1[i]; } } }
        for (int t = 0; t < nt; t += 2) {
            const bool last = (t == nt - 2);
            const char* a1 = cA + (size_t)(t + 1) * kstep;
            const char* a2 = last ? nA : cA + (size_t)(t + 2) * kstep; const char* b2 = last ? nB : cB + (size_t)(t + 2) * kstep;
            const char* a3 = a2 + kstep; const char* b3 = b2 + kstep;
            unsigned s0[2], s1[2];
#pragma unroll
            for (int i = 0; i < 2; ++i) { if constexpr (GATHER) { s0[i] = last ? nA0[i] : cA0[i]; s1[i] = last ? nA1[i] : cA1[i]; } else { s0[i] = cA0[i]; s1[i] = cA1[i]; } }
            PG8_LDB(B0, 0, 0); PG8_LDB(B1, 0, 1); PG8_SCHED; PG8_LDA(At, 0, 0); PG8_STAGE(PG8_SA(1, 1), a1, cA1);
            PG8_WAIT_V(8); PG8_WAIT_L(0); PG8_BAR; PG8_MMA(0, 0, At, B0); PG8_MMA(0, 1, At, B1); PG8_BAR; PG8_SCHED;
            PG8_LDA(At, 0, 1); PG8_STAGE(PG8_SB(0, 0), b2, voffB); PG8_STAGE(PG8_SB(0, 1), b2 + hstepB, voffB); PG8_STAGE(PG8_SA(0, 0), a2, s0);
            PG8_WAIT_V(8); PG8_WAIT_L(0); PG8_BAR; PG8_MMA(1, 0, At, B0); PG8_MMA(1, 1, At, B1); PG8_BAR; PG8_SCHED;
            PG8_LDB(B0, 1, 0); PG8_LDB(B1, 1, 1); PG8_SCHED; PG8_LDA(At, 1, 0); PG8_STAGE(PG8_SA(0, 1), a2, s1);
            PG8_WAIT_V(8); PG8_WAIT_L(0); PG8_BAR; PG8_MMA(0, 0, At, B0); PG8_MMA(0, 1, At, B1); PG8_BAR; PG8_SCHED;
            PG8_LDA(At, 1, 1); PG8_STAGE(PG8_SB(1, 0), b3, voffB); PG8_STAGE(PG8_SB(1, 1), b3 + hstepB, voffB); PG8_STAGE(PG8_SA(1, 0), a3, s0);
            PG8_WAIT_V(8); PG8_WAIT_L(0); PG8_BAR; PG8_MMA(1, 0, At, B0); PG8_MMA(1, 1, At, B1); PG8_BAR; PG8_SCHED;
        }
        if (wr == 0) PG8_BAR;
        { const int _t = opq((int)threadIdx.x), _w = __builtin_amdgcn_readfirstlane(_t >> 6), _l = _t & 63; E(acc, cur, _w >> 2, _w & 3, _l & 15, _l >> 4); }
        if (!has_next) break;
#pragma unroll
        for (int a = 0; a < 2; ++a)
#pragma unroll
            for (int b = 0; b < 2; ++b)
#pragma unroll
                for (int m = 0; m < 4; ++m)
#pragma unroll
                    for (int n = 0; n < 2; ++n) acc[a][b][m][n] = (f32x4){0.f, 0.f, 0.f, 0.f};
        cur = nxt; cA = nA; cB = nB; ++ui;
        if constexpr (GATHER) {
#pragma unroll
            for (int i = 0; i < 2; ++i) { cA0[i] = nA0[i]; cA1[i] = nA1[i]; } }
        if (wr == 1) PG8_BAR;
    }
    PG8_WAIT_V(0);
    PG8_BAR;
#undef PG8_AOFF
#undef PG8_SA
#undef PG8_SB
#undef PG8_STAGE
#undef PG8_LDA
#undef PG8_LDB
#undef PG8_MMA
#undef PG8_WAIT_V
#undef PG8_WAIT_L
#undef PG8_BAR
#undef PG8_SCHED
}

template <int NM, int NN> struct DenseSched {
    const char* A; const char* B; size_t tstepA, tstepB; int G, c;
    __device__ __forceinline__ bool next(int i, GUnit& u) const {
        constexpr int nwg = NM * NN, q = nwg / NXCD, r = nwg % NXCD, nig = WGM * NN, REM = (NM % WGM) ? (NM % WGM) : WGM;
        const int L = i * G + c; if (L >= nwg) return false;
        const int xcd = L % NXCD, off = L / NXCD; const int wgid = (xcd < r ? xcd * (q + 1) : r * (q + 1) + (xcd - r) * q) + off;
        const int gid = wgid / nig, w2 = wgid % nig, fm = gid * WGM;
        if (NM - fm >= WGM) { u.pm = fm + (w2 % WGM); u.pn = w2 / WGM; } else { u.pm = fm + (w2 % REM); u.pn = w2 / REM; }
        u.grp = 0; u.rows = nullptr;
        u.a = A + (size_t)u.pm * tstepA; u.b = B + (size_t)u.pn * tstepB; return true;
    }
};
template <int NM, int NN, int NGRP> struct BatchSched {
    const char* A; const char* B; size_t gstepA, gstepB, tstepA, tstepB; int G, c;
    __device__ __forceinline__ bool next(int i, GUnit& u) const {
        constexpr int per = NM * NN;
        const int L = i * G + c; if (L >= NGRP * per) return false;
        u.grp = L / per; const int r = L % per; u.pn = r % NN; u.pm = r / NN; u.rows = nullptr;
        u.a = A + (size_t)u.grp * gstepA + (size_t)u.pm * tstepA; u.b = B + (size_t)u.grp * gstepB + (size_t)u.pn * tstepB; return true;
    }
};
template <int NCT, bool GATHER> struct MoeSched {
    const char* A; const char* B; const int* slot_tok; const LAS int* pref; size_t tstepA, estepB, tstepB; int G, c;
    __device__ __forceinline__ bool next(int i, GUnit& u) const {
        const int L = i * G + c; const int TT = pref[NEXP]; if (L >= TT * NCT) return false;
        const int rt = L / NCT, ct = L % NCT; int e = 0;
        for (int j = 1; j < NEXP; ++j) e += (pref[j] <= rt) ? 1 : 0;
        u.pm = rt; u.pn = ct; u.grp = e; u.rows = slot_tok + rt * 256;
        u.a = GATHER ? A : A + (size_t)rt * tstepA; u.b = B + (size_t)e * estepB + (size_t)ct * tstepB; return true;
    }
};
}
using pg8::GUnit;

struct Args { const float* in[33]; float* out; unsigned char* ws; int ph_lo, ph_hi; };

typedef const __attribute__((address_space(4))) Args* CArgsP;
__device__ __forceinline__ CArgsP argp() { CArgsP p = (CArgsP)__builtin_amdgcn_kernarg_segment_ptr(); asm volatile("" : "+s"(p)); return p; }
__device__ __forceinline__ unsigned char* opq_p(unsigned char* p) { asm volatile("" : "+s"(p)); return p; }

struct Frame {
    LAS unsigned char* lds; volatile LAS unsigned* CTLW;
    int tid, lane, wave, G, bid;
    unsigned char* ws;
};

struct EpiInProj { static constexpr bool PERM = true; bf16_t* proj; bf16_t* ucat; float* gl; bf16_t* vt;
    __device__ __forceinline__ void operator()(const f32x4 (&acc)[2][2][4][2], const GUnit& u, int wr, int wc, int fr, int fq) const {
        const int row0 = u.pm * 256 + wr * 64 + fr;
        if (u.pn == 4 || u.pn == 5) {
#pragma unroll
            for (int ai = 0; ai < 2; ++ai) { const int chunk = u.pm * 4 + ai * 2 + wr;
#pragma unroll
                for (int bj = 0; bj < 2; ++bj) { const int ecol = (u.pn - 4) * 256 + bj * 128 + wc * 32 + 8 * fq, h = ecol >> 7, e0 = ecol & 127;
                    bf16_t* base = vt + ((size_t)(chunk * 4 + h) * 128 + e0) * 64 + fr;
#pragma unroll
                    for (int m = 0; m < 4; ++m)
#pragma unroll
                        for (int n = 0; n < 2; ++n)
#pragma unroll
                            for (int i = 0; i < 4; ++i) base[(4 * n + i) * 64 + m * 16] = (bf16_t)f2bf(acc[ai][bj][m][n][i]); } }
        } else if (u.pn < 8) {
            const bool dog = u.pn < 2;
#pragma unroll
            for (int ai = 0; ai < 2; ++ai)
#pragma unroll
                for (int m = 0; m < 4; ++m) { bf16_t* rowp = proj + (size_t)(row0 + ai * 128 + m * 16) * PROJW + u.pn * 256 + wc * 32 + 8 * fq;
#pragma unroll
                    for (int bj = 0; bj < 2; ++bj) { f32x4 v0 = acc[ai][bj][m][0], v1 = acc[ai][bj][m][1];
                        if (dog) {
#pragma unroll
                            for (int j = 0; j < 4; ++j) { v0[j] = gelu_tanh(v0[j]); v1[j] = gelu_tanh(v1[j]); } }
                        u32x4 w; w.x = cvt_pk_bf16(v0[0], v0[1]); w.y = cvt_pk_bf16(v0[2], v0[3]); w.z = cvt_pk_bf16(v1[0], v1[1]); w.w = cvt_pk_bf16(v1[2], v1[3]);
                        *(u32x4*)(rowp + bj * 128) = w; } }
        } else if (u.pn == 8) {
#pragma unroll
            for (int ai = 0; ai < 2; ++ai)
#pragma unroll
                for (int m = 0; m < 4; ++m) { const int row = row0 + ai * 128 + m * 16, chunk = row >> 6, s = row & 63;
#pragma unroll
                    for (int bj = 0; bj < 2; ++bj) { const int j0 = bj * 128 + wc * 32 + 8 * fq, g = j0 >> 4, h0 = j0 & 15;
                        const f32x4 v0 = acc[ai][bj][m][0], v1 = acc[ai][bj][m][1];
                        u32x4 w; w.x = cvt_pk_bf16(v0[0], v0[1]); w.y = cvt_pk_bf16(v0[2], v0[3]); w.z = cvt_pk_bf16(v1[0], v1[1]); w.w = cvt_pk_bf16(v1[2], v1[3]);
                        *(u32x4*)(ucat + ((size_t)(g * NCHP + chunk) * S5K + s * 16 + h0)) = w; } }
        } else {
            if (wc == 0) {
#pragma unroll
                for (int ai = 0; ai < 2; ++ai)
#pragma unroll
                    for (int m = 0; m < 4; ++m) { float* dst = gl + (size_t)(row0 + ai * 128 + m * 16) * 32 + 8 * fq;
                        *(f32x4*)dst = acc[ai][0][m][0]; *(f32x4*)(dst + 4) = acc[ai][0][m][1]; } }
        }
    }
};
struct EpiHloc { static constexpr bool PERM = false; float* hloc;
    __device__ __forceinline__ void operator()(const f32x4 (&acc)[2][2][4][2], const GUnit& u, int wr, int wc, int fr, int fq) const {
        const int row0 = u.pm * 256 + wr * 64 + fr;
#pragma unroll
        for (int ai = 0; ai < 2; ++ai)
#pragma unroll
            for (int m = 0; m < 4; ++m) { float* rowp = hloc + ((size_t)u.grp * NCHP + row0 + ai * 128 + m * 16) * 256 + wc * 32 + 4 * fq;
#pragma unroll
                for (int bj = 0; bj < 2; ++bj)
#pragma unroll
                    for (int n = 0; n < 2; ++n) *(f32x4*)(rowp + bj * 128 + n * 16) = acc[ai][bj][m][n]; }
    }
};
struct EpiS5Y { static constexpr bool PERM = true; bf16_t* ys5;
    __device__ __forceinline__ void operator()(const f32x4 (&acc)[2][2][4][2], const GUnit& u, int wr, int wc, int fr, int fq) const {
        const int row0 = u.pm * 256 + wr * 64 + fr;
#pragma unroll
        for (int ai = 0; ai < 2; ++ai)
#pragma unroll
            for (int m = 0; m < 4; ++m) { const int c = row0 + ai * 128 + m * 16;
                if (c < NCH) {
#pragma unroll
                    for (int bj = 0; bj < 2; ++bj) { const int j0 = u.pn * 256 + bj * 128 + wc * 32 + 8 * fq, t = j0 >> 4, h0 = j0 & 15;
                        f32x4 v0 = acc[ai][bj][m][0], v1 = acc[ai][bj][m][1];
#pragma unroll
                        for (int j = 0; j < 4; ++j) { v0[j] = gelu_tanh(v0[j]); v1[j] = gelu_tanh(v1[j]); }
                        u32x4 w; w.x = cvt_pk_bf16(v0[0], v0[1]); w.y = cvt_pk_bf16(v0[2], v0[3]); w.z = cvt_pk_bf16(v1[0], v1[1]); w.w = cvt_pk_bf16(v1[2], v1[3]);
                        *(u32x4*)(ys5 + (size_t)(c * 64 + t) * 256 + u.grp * 16 + h0) = w; } } }
    }
};
struct EpiGlu { static constexpr bool PERM = true; const bf16_t* ys5; bf16_t* mixed; const float* bias;
    __device__ __forceinline__ void operator()(const f32x4 (&acc)[2][2][4][2], const GUnit& u, int wr, int wc, int fr, int fq) const {
        const int row0 = u.pm * 256 + wr * 64 + fr;
#pragma unroll
        for (int bj = 0; bj < 2; ++bj) { const int n0 = bj * 128 + wc * 32 + 8 * fq;
            const f32x4 b0 = *(const f32x4*)(bias + n0), b1 = *(const f32x4*)(bias + n0 + 4);
#pragma unroll
            for (int ai = 0; ai < 2; ++ai)
#pragma unroll
                for (int m = 0; m < 4; ++m) { const int tok = row0 + ai * 128 + m * 16;
                    const u32x4 yv = *(const u32x4*)(ys5 + (size_t)tok * 256 + n0);
                    const f32x4 v0 = acc[ai][bj][m][0] + b0, v1 = acc[ai][bj][m][1] + b1;
                    float o[8];
                    o[0] = bf2f(yv.x & 0xffffu) * sigmoidf_(v0[0]); o[1] = bf2f(yv.x >> 16) * sigmoidf_(v0[1]); o[2] = bf2f(yv.y & 0xffffu) * sigmoidf_(v0[2]); o[3] = bf2f(yv.y >> 16) * sigmoidf_(v0[3]);
                    o[4] = bf2f(yv.z & 0xffffu) * sigmoidf_(v1[0]); o[5] = bf2f(yv.z >> 16) * sigmoidf_(v1[1]); o[6] = bf2f(yv.w & 0xffffu) * sigmoidf_(v1[2]); o[7] = bf2f(yv.w >> 16) * sigmoidf_(v1[3]);
                    u32x4 w; w.x = cvt_pk_bf16(o[0], o[1]); w.y = cvt_pk_bf16(o[2], o[3]); w.z = cvt_pk_bf16(o[4], o[5]); w.w = cvt_pk_bf16(o[6], o[7]);
                    *(u32x4*)(mixed + (size_t)tok * 1024 + 768 + n0) = w; asm volatile("" ::: "memory"); } }
    }
};
struct EpiF32 { static constexpr bool PERM = false; float* C; int ldc;
    __device__ __forceinline__ void operator()(const f32x4 (&acc)[2][2][4][2], const GUnit& u, int wr, int wc, int fr, int fq) const {
        const int row0 = u.pm * 256 + wr * 64 + fr, col0 = u.pn * 256 + wc * 32 + 4 * fq;
#pragma unroll
        for (int ai = 0; ai < 2; ++ai)
#pragma unroll
            for (int m = 0; m < 4; ++m) { float* rowp = C + (size_t)(row0 + ai * 128 + m * 16) * ldc + col0;
#pragma unroll
                for (int bj = 0; bj < 2; ++bj)
#pragma unroll
                    for (int n = 0; n < 2; ++n) *(f32x4*)(rowp + bj * 128 + n * 16) = acc[ai][bj][m][n]; }
    }
};
struct EpiUp { static constexpr bool PERM = true; bf16_t* act; const float* bup;
    __device__ __forceinline__ void operator()(const f32x4 (&acc)[2][2][4][2], const GUnit& u, int wr, int wc, int fr, int fq) const {
        const int row0 = u.pm * 256 + wr * 64 + fr, jj0 = wc * 32 + 8 * fq;
        const float* bg = bup + (size_t)u.grp * 2048 + u.pn * 128 + jj0;
        const f32x4 g0 = *(const f32x4*)bg, g1 = *(const f32x4*)(bg + 4), l0 = *(const f32x4*)(bg + 1024), l1 = *(const f32x4*)(bg + 1028);
#pragma unroll
        for (int ai = 0; ai < 2; ++ai)
#pragma unroll
            for (int m = 0; m < 4; ++m) { const int slot = row0 + ai * 128 + m * 16;
                const f32x4 xg0 = acc[ai][0][m][0] + g0, xg1 = acc[ai][0][m][1] + g1, xl0 = acc[ai][1][m][0] + l0, xl1 = acc[ai][1][m][1] + l1;
                float o[8];
#pragma unroll
                for (int j = 0; j < 4; ++j) { const float a = fminf(xg0[j], 7.0f), b = fminf(fmaxf(xl0[j], -7.0f), 7.0f); o[j] = a * sigmoidf_(1.702f * a) * (b + 1.0f);
                                              const float c = fminf(xg1[j], 7.0f), d = fminf(fmaxf(xl1[j], -7.0f), 7.0f); o[4 + j] = c * sigmoidf_(1.702f * c) * (d + 1.0f); }
                u32x4 w; w.x = cvt_pk_bf16(o[0], o[1]); w.y = cvt_pk_bf16(o[2], o[3]); w.z = cvt_pk_bf16(o[4], o[5]); w.w = cvt_pk_bf16(o[6], o[7]);
                *(u32x4*)(act + (size_t)slot * 1024 + u.pn * 128 + jj0) = w; }
    }
};
struct EpiDown { static constexpr bool PERM = true; bf16_t* yv; const float* bdn;
    __device__ __forceinline__ void operator()(const f32x4 (&acc)[2][2][4][2], const GUnit& u, int wr, int wc, int fr, int fq) const {
        const int row0 = u.pm * 256 + wr * 64 + fr;
#pragma unroll
        for (int bj = 0; bj < 2; ++bj) { const int col = u.pn * 256 + bj * 128 + wc * 32 + 8 * fq;
            const f32x4 b0 = *(const f32x4*)(bdn + (size_t)u.grp * 1024 + col), b1 = *(const f32x4*)(bdn + (size_t)u.grp * 1024 + col + 4);
#pragma unroll
            for (int ai = 0; ai < 2; ++ai)
#pragma unroll
                for (int m = 0; m < 4; ++m) { const int slot = row0 + ai * 128 + m * 16;
                    const f32x4 v0 = acc[ai][bj][m][0] + b0, v1 = acc[ai][bj][m][1] + b1;
                    u32x4 w; w.x = cvt_pk_bf16(v0[0], v0[1]); w.y = cvt_pk_bf16(v0[2], v0[3]); w.z = cvt_pk_bf16(v1[0], v1[1]); w.w = cvt_pk_bf16(v1[2], v1[3]);
                    *(u32x4*)(yv + (size_t)slot * 1024 + col) = w; } }
    }
};

__device__ __forceinline__ bf16x8 frag_lds(const LAS unsigned char* base, int row, int pitch_bytes, int k0, int lane) {
    return *(const LAS bf16x8*)(base + (row + (lane & 15)) * pitch_bytes + (k0 + 8 * (lane >> 4)) * 2);
}
__device__ __forceinline__ bf16x8 frag_glb(const bf16_t* base, size_t row, int pitch_elems, int k0, int lane) {
    return *(const bf16x8*)(base + (row + (lane & 15)) * (size_t)pitch_elems + k0 + 8 * (lane >> 4));
}
#define MFMA16(x, y, acc) __builtin_amdgcn_mfma_f32_16x16x32_bf16((x), (y), (acc), 0, 0, 0)

__device__ __forceinline__ void tr_item(const float* W, int ldw, int k0, int n0, bf16_t* dst, int r0, int ldd, LAS float* scr, int lane) {
#pragma unroll 8
    for (int i = 0; i < 32; ++i) { const int kk = 2 * i + (lane >> 5); scr[kk * 33 + (lane & 31)] = W[(size_t)(k0 + kk) * ldw + n0 + (lane & 31)]; }
    asm volatile("s_waitcnt lgkmcnt(0)" ::: "memory");
    const int c = lane & 7;
#pragma unroll
    for (int j = 0; j < 4; ++j) { const int n = (lane >> 3) + 8 * j; const LAS float* s = scr + (8 * c) * 33 + n;
        u32x4 o; o.x = pk2(s[0 * 33], s[1 * 33]); o.y = pk2(s[2 * 33], s[3 * 33]); o.z = pk2(s[4 * 33], s[5 * 33]); o.w = pk2(s[6 * 33], s[7 * 33]);
        *(u32x4*)(dst + (size_t)(r0 + n) * ldd + k0 + 8 * c) = o; }
    asm volatile("s_waitcnt lgkmcnt(0)" ::: "memory");
}

__device__ __forceinline__ void ph0_prologue(const Frame& F0, CArgsP A) {
    Frame F = F0; F.tid = opq(F0.tid); F.lane = F.tid & 63; F.wave = __builtin_amdgcn_readfirstlane(F.tid >> 6); F.ws = opq_p(F0.ws);
    unsigned char* ws = F.ws;
    {
        LAS float* sc = (LAS float*)F.lds;
        LAS float* part = sc + 640;
        const float* cvec = A->in[1]; const float* cctx = A->in[3]; const float* wmod = A->in[4];
        float* modp = (float*)(ws + WS_MODP);
        for (int u = F.bid; u < 768; u += F.G) {
            const int l = u / 192, r = u % 192, cb = r >> 3, ks = r & 7;
            for (int i = F.tid; i < 640; i += NTHR) { const int v = i >> 7, kk = i & 127; const float x = v < 4 ? cvec[v * 1024 + ks * 128 + kk] : cctx[ks * 128 + kk]; sc[i] = siluf_(x); }
            __syncthreads();
            const int col = cb * 256 + (F.tid & 255), kh = F.tid >> 8;
            float a0 = 0.f, a1 = 0.f, a2 = 0.f, a3 = 0.f, a4 = 0.f;
            const float* wp = wmod + ((size_t)l * 1024 + ks * 128 + kh * 64) * 6144 + col;
#pragma unroll 8
            for (int kk = 0; kk < 64; ++kk) { const float w = wp[(size_t)kk * 6144]; const int sk = kh * 64 + kk;
                a0 += sc[sk] * w; a1 += sc[128 + sk] * w; a2 += sc[256 + sk] * w; a3 += sc[384 + sk] * w; a4 += sc[512 + sk] * w; }
            if (kh == 1) { const int c = F.tid & 255; part[c] = a0; part[256 + c] = a1; part[512 + c] = a2; part[768 + c] = a3; part[1024 + c] = a4; }
            __syncthreads();
            if (kh == 0) { const int c = F.tid & 255; float* o = modp + ((size_t)(ks * 4 + l) * 5) * 6144 + col;
                o[0] = a0 + part[c]; o[6144] = a1 + part[256 + c]; o[2 * 6144] = a2 + part[512 + c]; o[3 * 6144] = a3 + part[768 + c]; o[4 * 6144] = a4 + part[1024 + c]; }
            __syncthreads();
        }
    }
    {
        LAS float* scr = (LAS float*)(F.lds + F.wave * 8704);
        const int gw = F.bid * NWAVES + F.wave, NGW = F.G * NWAVES;
        constexpr int I_IN = 4 * 16 * 73, I_OUT = 4 * 16 * 32, I_UP = 128 * 16 * 64, I_DN = 128 * 16 * 32, I_GLU = 4 * 4 * 8;
        constexpr int NITEMS = I_IN + I_OUT + I_UP + I_DN + I_GLU;
        for (int it = gw; it < NITEMS; it += NGW) {
            int r = it;
            if (r < I_IN) { const int l = r / 1168, q = r % 1168, kb = q / 73, nb = q % 73, n0 = 32 * nb;
                const int r0 = nb < 64 ? n0 : (nb == 64 ? 2304 : 2048 + (n0 - 2080));
                tr_item(A->in[6] + (size_t)l * 1024 * NIN, NIN, 64 * kb, n0, (bf16_t*)(ws + WS_WIN) + (size_t)l * NINP * 1024, r0, 1024, scr, F.lane); continue; }
            r -= I_IN;
            if (r < I_OUT) { const int l = r / 512, q = r % 512, kb = q / 32, nb = q % 32;
                tr_item(A->in[24] + (size_t)l * 1024 * 1024, 1024, 64 * kb, 32 * nb, (bf16_t*)(ws + WS_WOUT) + (size_t)l * 1024 * 1024, 32 * nb, 1024, scr, F.lane); continue; }
            r -= I_OUT;
            if (r < I_UP) { const int le = r / 1024, q = r % 1024, kb = q / 64, nb = q % 64, n0 = 32 * nb, half = n0 >> 10, within = n0 & 1023, ct = within >> 7, jj0 = within & 127;
                tr_item(A->in[29] + (size_t)le * 1024 * 2048, 2048, 64 * kb, n0, (bf16_t*)(ws + WS_WUP) + (size_t)le * 2048 * 1024, 256 * ct + 128 * half + jj0, 1024, scr, F.lane); continue; }
            r -= I_UP;
            if (r < I_DN) { const int le = r / 512, q = r % 512, kb = q / 32, nb = q % 32;
                tr_item(A->in[31] + (size_t)le * 1024 * 1024, 1024, 64 * kb, 32 * nb, (bf16_t*)(ws + WS_WDN) + (size_t)le * 1024 * 1024, 32 * nb, 1024, scr, F.lane); continue; }
            r -= I_DN;
            { const int l = r / 32, q = r % 32, kb = q / 8, nb = q % 8;
                tr_item(A->in[22] + (size_t)l * 256 * 256, 256, 64 * kb, 32 * nb, (bf16_t*)(ws + WS_GLUT) + (size_t)l * 256 * 256, 32 * nb, 256, scr, F.lane); }
        }
        const int gt = F.bid * NTHR + F.tid, NGT = F.G * NTHR;
        for (int i = gt; i < 4 * 224 * 128; i += NGT) { const int l = i / (224 * 128), q = i % (224 * 128);
            *(u32x4*)((bf16_t*)(ws + WS_WIN) + ((size_t)l * NINP + 2336) * 1024 + (size_t)q * 8) = (u32x4){0u, 0u, 0u, 0u}; }
        { const float* rw = A->in[27]; float* wrt = (float*)(ws + WS_WRT);
            for (int i = gt; i < 4 * D * NEXP; i += NGT) { const int l = i >> 15, q = i & 32767, e = q >> 10, k = q & 1023; wrt[i] = rw[(size_t)l * 32768 + k * 32 + e]; } }
        const float* sw = A->in[9]; bf16_t* swo = (bf16_t*)(ws + WS_SGUW);
        for (int i = gt; i < 4 * 4 * 128 * 128 / 4; i += NGT) { const f32x4 v = *(const f32x4*)(sw + (size_t)i * 4); u32x2 o; o.x = pk2(v[0], v[1]); o.y = pk2(v[2], v[3]); *(u32x2*)(swo + (size_t)i * 4) = o; }
    }
    __syncthreads();
    {
        LAS f32x2* LP = (LAS f32x2*)F.lds;
        LAS f32x2* BB = LP + 2 * 65 * 64;
        LAS f32x2* CC = BB + 2 * 64 * 16;
        const float* lam_re = A->in[14]; const float* lam_im = A->in[15]; const float* log_dt = A->in[16];
        const float* b_re = A->in[17]; const float* b_im = A->in[18]; const float* c_re = A->in[19]; const float* c_im = A->in[20]; const float* dsk = A->in[21];
        for (int u = F.bid; u < 64; u += F.G) {
            const int l = u >> 4, g = u & 15;
            for (int i = F.tid; i < 2 * 65 * 64; i += NTHR) { const int z = i / (65 * 64), n = (i / 64) % 65, p = i & 63;
                const int idx = ((l * 2 + z) * 16 + g) * 64 + p; const double dt = exp((double)log_dt[(l * 2 + z) * 16 + g]);
                const double mag = exp((double)lam_re[idx] * dt * n), ang = (double)lam_im[idx] * dt * n; double s, c; sincos(ang, &s, &c);
                LP[i] = (f32x2){(float)(mag * c), (float)(mag * s)};
                if (n == 64) *(f32x2*)((float*)(ws + WS_LB64) + (size_t)idx * 2) = (f32x2){(float)(mag * c), (float)(mag * s)}; }
            for (int i = F.tid; i < 2 * 64 * 16; i += NTHR) { const int z = i >> 10, p = (i >> 4) & 63, h = i & 15;
                const int idx = ((l * 2 + z) * 16 + g) * 64 + p; const double dt = exp((double)log_dt[(l * 2 + z) * 16 + g]);
                const double lr = lam_re[idx], li = lam_im[idx]; const double mag = exp(lr * dt), ang = li * dt; double s, c; sincos(ang, &s, &c);
                const double nr = mag * c - 1.0, ni = mag * s, den = lr * lr + li * li;
                const double qr = (nr * lr + ni * li) / den, qi = (ni * lr - nr * li) / den;
                const double br = b_re[(size_t)idx * 16 + h], bi = b_im[(size_t)idx * 16 + h];
                BB[i] = (f32x2){(float)(qr * br - qi * bi), (float)(qr * bi + qi * br)}; }
            for (int i = F.tid; i < 2 * 16 * 64; i += NTHR) { const int z = i >> 10, h = (i >> 6) & 15, p = i & 63;
                const size_t idx = ((size_t)((l * 2 + z) * 16 + g) * 16 + h) * 64 + p; CC[i] = (f32x2){c_re[idx], c_im[idx]}; }
            __syncthreads();
            float* KT = (float*)(ws + WS_KTAB) + (size_t)u * 32768;
            for (int o = F.tid; o < 32768; o += NTHR) { const int z = o >> 14, tau = (o >> 8) & 63, h = (o >> 4) & 15, h2 = o & 15; float acc = 0.f;
                for (int p = 0; p < 64; ++p) { const f32x2 c = CC[(z * 16 + h) * 64 + p], w = LP[(z * 65 + tau) * 64 + p], b = BB[(z * 64 + p) * 16 + h2];
                    const float cwr = c.x * w.x - c.y * w.y, cwi = c.x * w.y + c.y * w.x; acc += cwr * b.x - cwi * b.y; }
                KT[o] = acc; }
            __syncthreads();
            bf16_t* Mo = (bf16_t*)(ws + WS_S5M) + (size_t)u * 1024 * S5K;
            for (int it = F.tid; it < 1024 * 160; it += NTHR) { const int row = it / 160, cv = it % 160, t = row >> 4, h = row & 15; float v[8];
                if (cv < 128) { const int s = cv >> 1, h0 = (cv & 1) * 8;
                    if (s < t) { const float* k = KT + ((0 * 64 + (t - s)) * 16 + h) * 16 + h0;
#pragma unroll
                        for (int i = 0; i < 8; ++i) v[i] = k[i]; }
                    else if (s > t) { const float* k = KT + ((1 * 64 + (s - t)) * 16 + h) * 16 + h0;
#pragma unroll
                        for (int i = 0; i < 8; ++i) v[i] = k[i]; }
                    else { const float* k0 = KT + ((0 * 64 + 0) * 16 + h) * 16 + h0; const float* k1 = KT + ((1 * 64 + 0) * 16 + h) * 16 + h0; const float dd = dsk[(l * 16 + g) * 16 + h];
#pragma unroll
                        for (int i = 0; i < 8; ++i) v[i] = k0[i] + k1[i] + ((h0 + i == h) ? dd : 0.f); }
                } else { const int idx0 = (cv - 128) * 8, z = idx0 >> 7, p0 = (idx0 & 127) >> 1, n = z == 0 ? t + 1 : 64 - t;
#pragma unroll
                    for (int i = 0; i < 8; ++i) { const int p = p0 + (i >> 1); const f32x2 c = CC[(z * 16 + h) * 64 + p], w = LP[(z * 65 + n) * 64 + p];
                        v[i] = (i & 1) ? -(c.x * w.y + c.y * w.x) : (c.x * w.x - c.y * w.y); } }
                u32x4 o; o.x = pk2(v[0], v[1]); o.y = pk2(v[2], v[3]); o.z = pk2(v[4], v[5]); o.w = pk2(v[6], v[7]);
                *(u32x4*)(Mo + (size_t)row * S5K + cv * 8) = o; }
            bf16_t* Fo = (bf16_t*)(ws + WS_S5F) + (size_t)u * 256 * 1024;
            for (int it = F.tid; it < 256 * 128; it += NTHR) { const int r = it >> 7, cv = it & 127, z = r >> 7, p = (r & 127) >> 1, ri = r & 1, s = cv >> 1, h0 = (cv & 1) * 8, m = z == 0 ? 63 - s : s;
                const f32x2 w = LP[(z * 65 + m) * 64 + p]; float v[8];
#pragma unroll
                for (int i = 0; i < 8; ++i) { const f32x2 b = BB[(z * 64 + p) * 16 + h0 + i]; v[i] = ri ? (w.x * b.y + w.y * b.x) : (w.x * b.x - w.y * b.y); }
                u32x4 o; o.x = pk2(v[0], v[1]); o.y = pk2(v[2], v[3]); o.z = pk2(v[4], v[5]); o.w = pk2(v[6], v[7]);
                *(u32x4*)(Fo + (size_t)r * 1024 + cv * 8) = o; }
            __syncthreads();
        }
    }
}

__device__ __forceinline__ void ph1_mod(const Frame& F0, CArgsP A) {
    Frame F = F0; F.tid = opq(F0.tid); F.lane = F.tid & 63; F.wave = __builtin_amdgcn_readfirstlane(F.tid >> 6); F.ws = opq_p(F0.ws);
    const float* modp = (const float*)(F.ws + WS_MODP); float* mod = (float*)(F.ws + WS_MOD); const float* bmod = A->in[5];
    for (int i = F.bid * NTHR + F.tid; i < 4 * 5 * 6144; i += F.G * NTHR) { const int l = i / 30720, j = i % 6144; float s = bmod[l * 6144 + j];
#pragma unroll
        for (int ks = 0; ks < 8; ++ks) s += modp[(size_t)ks * 122880 + i];
        mod[i] = s; }
}
__device__ __forceinline__ void ph2_init(const Frame& F0, CArgsP A) {
    Frame F = F0; F.tid = opq(F0.tid); F.lane = F.tid & 63; F.wave = __builtin_amdgcn_readfirstlane(F.tid >> 6); F.ws = opq_p(F0.ws);
    const float* mod = (const float*)(F.ws + WS_MOD); float* X = (float*)(F.ws + WS_X); bf16_t* H = (bf16_t*)(F.ws + WS_H);
    for (int tk = F.bid * NWAVES + F.wave; tk < T; tk += F.G * NWAVES) {
        const float* src = tk < TLAT ? A->in[0] + (size_t)tk * D : A->in[2] + (size_t)(tk - TLAT) * D;
        const float* mv = mod + (size_t)tok_vec(tk) * 6144;
#pragma unroll
        for (int j = 0; j < 4; ++j) { const int c = 4 * F.lane + 256 * j; const f32x4 x = *(const f32x4*)(src + c), sh = *(const f32x4*)(mv + c), sc = *(const f32x4*)(mv + 1024 + c);
            *(f32x4*)(X + (size_t)tk * D + c) = x; const f32x4 h = x * (sc + 1.0f) + sh;
            u32x2 o; o.x = pk2(h[0], h[1]); o.y = pk2(h[2], h[3]); *(u32x2*)(H + (size_t)tk * D + c) = o; }
    }
}

template <int Z> __device__ __forceinline__ void gla_cols(const LAS float* GLs, const LAS unsigned char* Qs, const LAS unsigned char* Ks, LAS unsigned char* KTrow, const float (&gu)[16], float gb,
                                                          bf16_t* QHp, bf16_t* KNp, float& tot) {
    float b = 0.f;
    for (int j = 0; j < 8; ++j) { const int tg = Z ? 7 - j : j; unsigned w[4] = {0u, 0u, 0u, 0u};
#pragma unroll
        for (int tt = 0; tt < 8; ++tt) { const int ti = Z ? 7 - tt : tt, t = tg * 8 + ti;
            float s = gb;
#pragma unroll
            for (int r = 0; r < 16; ++r) s += GLs[t * 32 + Z * 16 + r] * gu[r];
            b += logsigmoidf_(s) * (1.0f / 16.0f);
            const float e = __expf(b), ri = rcpf(e);
            const float qv = bf2f(*(const LAS unsigned short*)(Qs + t * 528)) * 0.125f, kv = bf2f(*(const LAS unsigned short*)(Ks + t * 528));
            const unsigned kn = f2bf(kv * ri);
            QHp[(size_t)t * 512] = (bf16_t)f2bf(qv * e); KNp[(size_t)t * 256] = (bf16_t)kn;
            w[ti >> 1] |= (ti & 1) ? (kn << 16) : kn; }
        *(LAS u32x4*)(KTrow + tg * 16) = (u32x4){w[0], w[1], w[2], w[3]}; }
    tot = b;
}
__device__ __forceinline__ void gla_local(const Frame& F0, CArgsP A, int l) {
    Frame F = F0; F.tid = opq(F0.tid); F.lane = F.tid & 63; F.wave = __builtin_amdgcn_readfirstlane(F.tid >> 6); F.ws = opq_p(F0.ws);
    unsigned char* ws = F.ws;
    const bf16_t* proj = (const bf16_t*)(ws + WS_PROJ); const float* gl = (const float*)(ws + WS_GL);
    bf16_t* KN = (bf16_t*)(ws + WS_KS); bf16_t* QH = (bf16_t*)(ws + WS_QH); const bf16_t* VTg = (const bf16_t*)(ws + WS_VT);
    float* glast = (float*)(ws + WS_GLAST); float* gdec = (float*)(ws + WS_GDEC);
    LAS float* GLs = (LAS float*)F.lds;
    LAS unsigned char* KTl = F.lds + 8192;
    LAS unsigned char* Qs = F.lds + 81920;
    LAS unsigned char* Ks = Qs + 64 * 528;
    LAS float* DEC = (LAS float*)(Ks + 64 * 528);
    const int z = F.tid >> 8, col = F.tid & 255, hh = col >> 6, dd = col & 63;
    float gu[16];
#pragma unroll
    for (int r = 0; r < 16; ++r) gu[r] = A->in[11][(((size_t)l * 2 + z) * 16 + r) * 256 + col];
    const float gb = A->in[12][((size_t)l * 2 + z) * 256 + col];
    for (int ch = F.bid; ch < NCH; ch += F.G) {
        const int tk0 = ch * 64;
        *(LAS f32x4*)(GLs + 4 * F.tid) = *(const f32x4*)(gl + (size_t)tk0 * 32 + 4 * F.tid);
#pragma unroll
        for (int i = 0; i < 4; ++i) { const int idx = F.tid + NTHR * i, row = idx >> 5, c16 = idx & 31;
            *(LAS u32x4*)(Qs + row * 528 + c16 * 16) = *(const u32x4*)(proj + (size_t)(tk0 + row) * PROJW + 512 + c16 * 8);
            *(LAS u32x4*)(Ks + row * 528 + c16 * 16) = *(const u32x4*)(proj + (size_t)(tk0 + row) * PROJW + 768 + c16 * 8); }
        __syncthreads();
        float tot;
        bf16_t* QHp = QH + ((size_t)tk0 * 4 + hh) * 128 + z * 64 + dd; bf16_t* KNp = KN + ((size_t)z * T + tk0) * 256 + col;
        if (z == 0) gla_cols<0>(GLs, Qs + col * 2, Ks + col * 2, KTl + (0 * 256 + col) * 144, gu, gb, QHp, KNp, tot);
        else        gla_cols<1>(GLs, Qs + col * 2, Ks + col * 2, KTl + (1 * 256 + col) * 144, gu, gb, QHp, KNp, tot);
        const float dec = __expf(tot);
        DEC[z * 256 + col] = dec; gdec[((size_t)ch * 2 + z) * 256 + col] = dec;
        __syncthreads();
        {
            const int wz = F.wave & 1, wh = F.wave >> 1, q = F.lane >> 4, c = F.lane & 15;
#pragma unroll
            for (int eh = 0; eh < 2; ++eh) {
                f32x4 acc[4][4];
#pragma unroll
                for (int a = 0; a < 4; ++a)
#pragma unroll
                    for (int b = 0; b < 4; ++b) acc[a][b] = (f32x4){0.f, 0.f, 0.f, 0.f};
#pragma unroll
                for (int ks = 0; ks < 2; ++ks) { bf16x8 xf[4], yf[4];
#pragma unroll
                    for (int a = 0; a < 4; ++a) xf[a] = frag_lds(KTl, wz * 256 + wh * 64 + a * 16, 144, ks * 32, F.lane);
#pragma unroll
                    for (int b = 0; b < 4; ++b) yf[b] = frag_glb(VTg, ((size_t)ch * 4 + wh) * 128 + eh * 64 + b * 16, 64, ks * 32, F.lane);
#pragma unroll
                    for (int a = 0; a < 4; ++a)
#pragma unroll
                        for (int b = 0; b < 4; ++b) acc[a][b] = MFMA16(xf[a], yf[b], acc[a][b]); }
#pragma unroll
                for (int a = 0; a < 4; ++a) { const int d0 = a * 16 + 4 * q; const f32x4 dv = *(const LAS f32x4*)(DEC + wz * 256 + wh * 64 + d0);
#pragma unroll
                    for (int b = 0; b < 4; ++b) { const int e = eh * 64 + b * 16 + c;
                        *(f32x4*)(glast + (((size_t)ch * 4 + wh) * 128 + e) * 128 + wz * 64 + d0) = acc[a][b] * dv; } }
            }
        }
        __syncthreads();
    }
}

__device__ __forceinline__ void sgu_phase(const Frame& F0, CArgsP A, int l) {
    Frame F = F0; F.tid = opq(F0.tid); F.lane = F.tid & 63; F.wave = __builtin_amdgcn_readfirstlane(F.tid >> 6); F.ws = opq_p(F0.ws);
    unsigned char* ws = F.ws;
    const bf16_t* proj = (const bf16_t*)(ws + WS_PROJ); bf16_t* mixed = (bf16_t*)(ws + WS_MIXED); const bf16_t* sw = (const bf16_t*)(ws + WS_SGUW) + (size_t)l * 4 * 128 * 128;
    LAS float* stats = (LAS float*)F.lds;
    LAS unsigned char* VL = F.lds + 1024;
    const float* lng = A->in[7] + l * 256; const float* lnb = A->in[8] + l * 256; const float* bs = A->in[10] + (size_t)l * 4 * 128;
    for (int uu = (F.G - 1 - F.bid); uu < (T / 128) * 4; uu += F.G) {
        const int tk0 = (uu >> 2) * 128, h = uu & 3;
        u32x2 wv[16];
#pragma unroll
        for (int i = 0; i < 16; ++i) wv[i] = *(const u32x2*)(proj + (size_t)(tk0 + F.wave * 16 + i) * PROJW + 256 + 4 * F.lane);
#pragma unroll
        for (int i = 0; i < 16; ++i) { const int t = F.wave * 16 + i; const u32x2 w = wv[i];
            const float a = bf2f(w.x & 0xffffu), b = bf2f(w.x >> 16), c = bf2f(w.y & 0xffffu), d = bf2f(w.y >> 16);
            const float mean = wave_sum((a + b) + (c + d)) * (1.0f / 256.0f); const float da = a - mean, db = b - mean, dc = c - mean, de = d - mean;
            const float var = wave_sum((da * da + db * db) + (dc * dc + de * de)) * (1.0f / 256.0f);
            if (F.lane == 0) { stats[2 * t] = mean; stats[2 * t + 1] = rsqrtf(var + LN_EPS); } }
        __syncthreads();
        {   const int chn = F.tid & 63, sq = F.tid >> 6; const float g = lng[h * 64 + chn], b = lnb[h * 64 + chn];
            for (int j = 0; j < 2; ++j) { unsigned w[4];
#pragma unroll
                for (int tt = 0; tt < 8; ++tt) { const int s = sq * 16 + j * 8 + tt; const float v = (bf2f(proj[(size_t)(tk0 + s) * PROJW + 256 + h * 64 + chn]) - stats[2 * s]) * stats[2 * s + 1] * g + b;
                    if (tt & 1) w[tt >> 1] |= f2bf(v) << 16; else w[tt >> 1] = f2bf(v); }
                *(LAS u32x4*)(VL + chn * 272 + sq * 32 + j * 16) = (u32x4){w[0], w[1], w[2], w[3]}; }
        }
        __syncthreads();
        {   const int ct = F.wave & 3, th = F.wave >> 2, q = F.lane >> 4, c = F.lane & 15;
            f32x4 acc[4];
#pragma unroll
            for (int b = 0; b < 4; ++b) acc[b] = (f32x4){0.f, 0.f, 0.f, 0.f};
#pragma unroll
            for (int ks = 0; ks < 4; ++ks) { const bf16x8 xf = frag_lds(VL, ct * 16, 272, ks * 32, F.lane);
#pragma unroll
                for (int b = 0; b < 4; ++b) { const bf16x8 yf = frag_glb(sw + (size_t)h * 128 * 128, th * 64 + b * 16, 128, ks * 32, F.lane); acc[b] = MFMA16(xf, yf, acc[b]); } }
#pragma unroll
            for (int b = 0; b < 4; ++b) { const int t = th * 64 + b * 16 + c; const float bias = bs[h * 128 + t];
                const int ch0 = h * 64 + ct * 16 + 4 * q; const u32x2 uw = *(const u32x2*)(proj + (size_t)(tk0 + t) * PROJW + ch0);
                u32x2 o; o.x = pk2(bf2f(uw.x & 0xffffu) * (acc[b][0] + bias), bf2f(uw.x >> 16) * (acc[b][1] + bias));
                o.y = pk2(bf2f(uw.y & 0xffffu) * (acc[b][2] + bias), bf2f(uw.y >> 16) * (acc[b][3] + bias));
                *(u32x2*)(mixed + (size_t)(tk0 + t) * 1024 + ch0) = o; }
        }
        __syncthreads();
    }
}

__device__ __forceinline__ int scan_chunk(int z, int b, int st) {
    return z == 0 ? (st < 4 ? 512 + b * 4 + st : b * 128 + (st - 4)) : (st < 4 ? 512 + b * 4 + (3 - st) : b * 128 + (131 - st));
}
__device__ __forceinline__ void scan_phase(const Frame& F0, CArgsP A, int l) {
    Frame F = F0; F.tid = opq(F0.tid); F.lane = F.tid & 63; F.wave = __builtin_amdgcn_readfirstlane(F.tid >> 6); F.ws = opq_p(F0.ws);
    unsigned char* ws = F.ws;
    const float* glast = (const float*)(ws + WS_GLAST); const float* gdec = (const float*)(ws + WS_GDEC); bf16_t* sprev = (bf16_t*)(ws + WS_SPREV);
    {   const int idx = F.bid * NTHR + F.tid;
        const int b0 = idx >> 16, rem = idx & 65535, h = rem >> 14, dcat = rem & 127, z = dcat >> 6, d = dcat & 63;
        float S0 = 0.f, S1 = 0.f;
        for (int sb = 0; sb < 132; sb += 12) { float ds0[12], dc0[12], ds1[12], dc1[12];
#pragma unroll
            for (int j = 0; j < 12; ++j) { const int c0 = scan_chunk(z, b0, sb + j), c1 = scan_chunk(z, b0 + 2, sb + j);
                ds0[j] = glast[(size_t)c0 * 65536 + rem]; dc0[j] = gdec[((size_t)c0 * 2 + z) * 256 + h * 64 + d];
                ds1[j] = glast[(size_t)c1 * 65536 + rem]; dc1[j] = gdec[((size_t)c1 * 2 + z) * 256 + h * 64 + d]; }
#pragma unroll
            for (int j = 0; j < 12; ++j) { const int c0 = scan_chunk(z, b0, sb + j), c1 = scan_chunk(z, b0 + 2, sb + j);
                sprev[(size_t)c0 * 65536 + rem] = (bf16_t)f2bf(S0); S0 = dc0[j] * S0 + ds0[j];
                sprev[(size_t)c1 * 65536 + rem] = (bf16_t)f2bf(S1); S1 = dc1[j] * S1 + ds1[j]; }
        }
    }
    const float* hloc = (const float*)(ws + WS_HLOC); bf16_t* ucat = (bf16_t*)(ws + WS_UCAT); const float* lb64 = (const float*)(ws + WS_LB64);
    if (F.bid >= F.G - 16) { const int idx = (F.bid - (F.G - 16)) * NTHR + F.tid;
        const int p = idx & 63, z = (idx >> 6) & 1, b = (idx >> 7) & 3, g = idx >> 9;
        const f32x2 lb = *(const f32x2*)(lb64 + ((size_t)((l * 2 + z) * 16 + g) * 64 + p) * 2);
        float hr = 0.f, hi = 0.f;
        for (int sb = 0; sb < 132; sb += 12) { f32x2 hl[12];
#pragma unroll
            for (int j = 0; j < 12; ++j) { const int ch = scan_chunk(z, b, sb + j); hl[j] = *(const f32x2*)(hloc + ((size_t)g * NCHP + ch) * 256 + z * 128 + p * 2); }
#pragma unroll
            for (int j = 0; j < 12; ++j) { const int ch = scan_chunk(z, b, sb + j);
                *(unsigned*)(ucat + ((size_t)g * NCHP + ch) * S5K + 1024 + z * 128 + p * 2) = pk2(hr, hi);
                const float nr = lb.x * hr - lb.y * hi + hl[j].x, ni = lb.x * hi + lb.y * hr + hl[j].y; hr = nr; hi = ni; }
        }
    }
}

__device__ __forceinline__ void gla_out(const Frame& F0, CArgsP A, int l) {
    Frame F = F0; F.tid = opq(F0.tid); F.lane = F.tid & 63; F.wave = __builtin_amdgcn_readfirstlane(F.tid >> 6); F.ws = opq_p(F0.ws);
    unsigned char* ws = F.ws;
    const bf16_t* proj = (const bf16_t*)(ws + WS_PROJ); bf16_t* mixed = (bf16_t*)(ws + WS_MIXED);
    const bf16_t* KN = (const bf16_t*)(ws + WS_KS); const bf16_t* QH = (const bf16_t*)(ws + WS_QH);
    const bf16_t* VTg = (const bf16_t*)(ws + WS_VT); const bf16_t* sprev = (const bf16_t*)(ws + WS_SPREV);
    const float* ng = A->in[13] + (size_t)l * 512;
    LAS unsigned char* Pw = F.lds + F.wave * 2304;
    const int q = F.lane >> 4, c = F.lane & 15;
    for (int wu = F.bid * NWAVES + F.wave; wu < NCH * 16; wu += F.G * NWAVES) {
        const int ch = wu >> 4, h = (wu >> 2) & 3, tm = wu & 3, tk0 = ch * 64;
        bf16x8 qh[4];
#pragma unroll
        for (int j = 0; j < 4; ++j) qh[j] = frag_glb(QH + h * 128, (size_t)tk0 + tm * 16, 512, j * 32, F.lane);
#pragma unroll
        for (int st = 0; st < 4; ++st) {
            f32x4 sf = (f32x4){0.f, 0.f, 0.f, 0.f}, sb = (f32x4){0.f, 0.f, 0.f, 0.f};
            if (st <= tm) {
#pragma unroll
                for (int ks = 0; ks < 2; ++ks) { const bf16x8 kf = frag_glb(KN + h * 64, (size_t)tk0 + st * 16, 256, ks * 32, F.lane); sf = MFMA16(kf, qh[ks], sf); } }
            if (st >= tm) {
#pragma unroll
                for (int ks = 0; ks < 2; ++ks) { const bf16x8 kb = frag_glb(KN + h * 64, (size_t)T + tk0 + st * 16, 256, ks * 32, F.lane); sb = MFMA16(kb, qh[2 + ks], sb); } }
            const int t = tm * 16 + c, s0 = st * 16 + 4 * q;
            u32x2 o; o.x = pk2((s0 + 0) <= t ? sf[0] : sb[0], (s0 + 1) <= t ? sf[1] : sb[1]); o.y = pk2((s0 + 2) <= t ? sf[2] : sb[2], (s0 + 3) <= t ? sf[3] : sb[3]);
            *(LAS u32x2*)(Pw + c * 144 + s0 * 2) = o; }
        asm volatile("s_waitcnt lgkmcnt(0)" ::: "memory");
        bf16x8 pf[2];
#pragma unroll
        for (int ks = 0; ks < 2; ++ks) pf[ks] = frag_lds(Pw, 0, 144, ks * 32, F.lane);
        f32x4 acc[8];
#pragma unroll
        for (int a = 0; a < 8; ++a) { acc[a] = (f32x4){0.f, 0.f, 0.f, 0.f};
            const size_t erow = ((size_t)ch * 4 + h) * 128 + a * 16;
#pragma unroll
            for (int ks = 0; ks < 2; ++ks) { const bf16x8 vf = frag_glb(VTg, erow, 64, ks * 32, F.lane); acc[a] = MFMA16(vf, pf[ks], acc[a]); }
#pragma unroll
            for (int j = 0; j < 4; ++j) { const bf16x8 sfr = frag_glb(sprev, erow, 128, j * 32, F.lane); acc[a] = MFMA16(sfr, qh[j], acc[a]); } }
        float ss = 0.f;
#pragma unroll
        for (int a = 0; a < 8; ++a) ss += (acc[a][0] * acc[a][0] + acc[a][1] * acc[a][1]) + (acc[a][2] * acc[a][2] + acc[a][3] * acc[a][3]);
        ss += __shfl_xor(ss, 16); ss += __shfl_xor(ss, 32);
        const float rinv = rsqrtf(ss * (1.0f / 128.0f) + LN_EPS);
        const int tok = tk0 + tm * 16 + c;
#pragma unroll
        for (int a = 0; a < 8; ++a) { const int e0 = h * 128 + a * 16 + 4 * q; const u32x2 gw = *(const u32x2*)(proj + (size_t)tok * PROJW + 1536 + e0); const f32x4 nv = *(const f32x4*)(ng + e0);
            u32x2 o; o.x = pk2(acc[a][0] * rinv * nv[0] * siluf_(bf2f(gw.x & 0xffffu)), acc[a][1] * rinv * nv[1] * siluf_(bf2f(gw.x >> 16)));
            o.y = pk2(acc[a][2] * rinv * nv[2] * siluf_(bf2f(gw.y & 0xffffu)), acc[a][3] * rinv * nv[3] * siluf_(bf2f(gw.y >> 16)));
            *(u32x2*)(mixed + (size_t)tok * 1024 + 256 + e0) = o; }
        asm volatile("s_waitcnt lgkmcnt(0)" ::: "memory");
    }
    __syncthreads();
}

__device__ __forceinline__ float rs32(const float (&pe)[32], int lane) {
    float r16[16], r8[8], r4[4], r2[2], r1;
    { const bool hi = (lane & 32) != 0;
#pragma unroll
        for (int i = 0; i < 16; ++i) { const float mine = hi ? pe[16 + i] : pe[i], oth = hi ? pe[i] : pe[16 + i]; r16[i] = mine + __shfl_xor(oth, 32); } }
    { const bool hi = (lane & 16) != 0;
#pragma unroll
        for (int i = 0; i < 8; ++i) { const float mine = hi ? r16[8 + i] : r16[i], oth = hi ? r16[i] : r16[8 + i]; r8[i] = mine + __shfl_xor(oth, 16); } }
    { const bool hi = (lane & 8) != 0;
#pragma unroll
        for (int i = 0; i < 4; ++i) { const float mine = hi ? r8[4 + i] : r8[i], oth = hi ? r8[i] : r8[4 + i]; r4[i] = mine + __shfl_xor(oth, 8); } }
    { const bool hi = (lane & 4) != 0;
#pragma unroll
        for (int i = 0; i < 2; ++i) { const float mine = hi ? r4[2 + i] : r4[i], oth = hi ? r4[i] : r4[2 + i]; r2[i] = mine + __shfl_xor(oth, 4); } }
    { const bool hi = (lane & 2) != 0; const float mine = hi ? r2[1] : r2[0], oth = hi ? r2[0] : r2[1]; r1 = mine + __shfl_xor(oth, 2); }
    r1 += __shfl_xor(r1, 1);
    return r1;
}
__device__ __forceinline__ void top4_store(float val, int lane, int* topi_row, float* gate_row, volatile LAS int* hist, bool valid) {
    const int mye = lane >> 1; float tv[4]; int te[4];
#pragma unroll
    for (int k = 0; k < 4; ++k) { float mvv = val; int mi = mye;
#pragma unroll
        for (int o = 1; o < 64; o <<= 1) { const float ov = __shfl_xor(mvv, o); const int oi = __shfl_xor(mi, o); if (ov > mvv || (ov == mvv && oi < mi)) { mvv = ov; mi = oi; } }
        tv[k] = mvv; te[k] = mi; if (mye == mi) val = -3.0e38f; }
    const float e1 = __expf(tv[1] - tv[0]), e2 = __expf(tv[2] - tv[0]), e3 = __expf(tv[3] - tv[0]); const float inv = 1.0f / (1.0f + e1 + e2 + e3);
    if (valid) {
        if (lane == 0) { *(int4*)topi_row = make_int4(te[0], te[1], te[2], te[3]); *(f32x4*)gate_row = (f32x4){inv, e1 * inv, e2 * inv, e3 * inv}; }
        if (lane < 4) { const int e = lane == 0 ? te[0] : (lane == 1 ? te[1] : (lane == 2 ? te[2] : te[3])); __hip_atomic_fetch_add((LAS int*)&hist[e], 1, __ATOMIC_RELAXED, __HIP_MEMORY_SCOPE_WORKGROUP); } }
}
__device__ __forceinline__ void ln1_router(const Frame& F0, CArgsP A, int l, int ntok) {
    Frame F = F0; F.tid = opq(F0.tid); F.lane = F.tid & 63; F.wave = __builtin_amdgcn_readfirstlane(F.tid >> 6); F.ws = opq_p(F0.ws);
    unsigned char* ws = F.ws;
    float* X = (float*)(ws + WS_X); const float* TMP = (const float*)(ws + WS_TMP); bf16_t* H = (bf16_t*)(ws + WS_H); const float* mod = (const float*)(ws + WS_MOD) + (size_t)l * 5 * 6144;
    int* topi = (int*)(ws + WS_TOPI); float* gate = (float*)(ws + WS_GATE); int* wgcnt = (int*)(ws + WS_WGCNT);
    const float* lg = A->in[25] + (size_t)(l * 2 + 0) * D; const float* lb = A->in[26] + (size_t)(l * 2 + 0) * D;
    const float* wrt = (const float*)(ws + WS_WRT) + (size_t)l * D * NEXP; const float* rb = A->in[28] + l * NEXP;
    LAS float* WrT = (LAS float*)F.lds;
    volatile LAS int* hist = (volatile LAS int*)(F.CTLW + 32);
    for (int i = F.tid; i < D * NEXP / 4; i += NTHR) *(LAS f32x4*)(WrT + 4 * i) = *(const f32x4*)(wrt + 4 * i);
    if (F.tid < 32) hist[F.tid] = 0;
    __syncthreads();
    const int per = ntok / F.G, t0 = F.bid * per;
    for (int it = 0; it * 16 < per; ++it) {
        int tk[2]; bool valid[2];
#pragma unroll
        for (int k = 0; k < 2; ++k) { const int ti = it * 16 + F.wave * 2 + k; valid[k] = ti < per; tk[k] = t0 + (valid[k] ? ti : per - 1); }
        f32x4 v[2][4]; float s[2] = {0.f, 0.f};
#pragma unroll
        for (int k = 0; k < 2; ++k) { const float* mv = mod + (size_t)tok_vec(tk[k]) * 6144;
#pragma unroll
            for (int j = 0; j < 4; ++j) { const int c = 4 * F.lane + 256 * j; const f32x4 x = *(const f32x4*)(X + (size_t)tk[k] * D + c), tp = *(const f32x4*)(TMP + (size_t)tk[k] * D + c), g1 = *(const f32x4*)(mv + 2048 + c);
                v[k][j] = x * DN_ALPHA + g1 * tp; s[k] += (v[k][j][0] + v[k][j][1]) + (v[k][j][2] + v[k][j][3]); } }
        float mean[2], s2[2] = {0.f, 0.f}, rstd[2];
#pragma unroll
        for (int k = 0; k < 2; ++k) mean[k] = wave_sum(s[k]) * (1.0f / D);
#pragma unroll
        for (int k = 0; k < 2; ++k)
#pragma unroll
            for (int j = 0; j < 4; ++j) { v[k][j] = v[k][j] - mean[k]; s2[k] += (v[k][j][0] * v[k][j][0] + v[k][j][1] * v[k][j][1]) + (v[k][j][2] * v[k][j][2] + v[k][j][3] * v[k][j][3]); }
#pragma unroll
        for (int k = 0; k < 2; ++k) rstd[k] = rsqrtf(wave_sum(s2[k]) * (1.0f / D) + LN_EPS);
#pragma unroll
        for (int k = 0; k < 2; ++k) { const float* mv = mod + (size_t)tok_vec(tk[k]) * 6144;
#pragma unroll
            for (int j = 0; j < 4; ++j) { const int c = 4 * F.lane + 256 * j; const f32x4 g = *(const f32x4*)(lg + c), b = *(const f32x4*)(lb + c);
                const f32x4 xn = v[k][j] * rstd[k] * g + b;
                const f32x4 sh = *(const f32x4*)(mv + 3072 + c), sc = *(const f32x4*)(mv + 4096 + c); const f32x4 h = xn * (sc + 1.0f) + sh; v[k][j] = h;
                if (valid[k]) { *(f32x4*)(X + (size_t)tk[k] * D + c) = xn; u32x2 o; o.x = pk2(h[0], h[1]); o.y = pk2(h[2], h[3]); *(u32x2*)(H + (size_t)tk[k] * D + c) = o; } } }
        float pe0[32], pe1[32];
#pragma unroll
        for (int e = 0; e < 32; ++e) { float a0 = 0.f, a1 = 0.f;
#pragma unroll
            for (int j = 0; j < 4; ++j) { const f32x4 w = *(const LAS f32x4*)(WrT + e * 1024 + 4 * F.lane + 256 * j);
                a0 += (v[0][j][0] * w[0] + v[0][j][1] * w[1]) + (v[0][j][2] * w[2] + v[0][j][3] * w[3]);
                a1 += (v[1][j][0] * w[0] + v[1][j][1] * w[1]) + (v[1][j][2] * w[2] + v[1][j][3] * w[3]); }
            pe0[e] = a0; pe1[e] = a1; }
        const float bias = rb[F.lane >> 1];
        const float l0 = rs32(pe0, F.lane) + bias, l1 = rs32(pe1, F.lane) + bias;
        top4_store(l0, F.lane, topi + (size_t)tk[0] * 4, gate + (size_t)tk[0] * 4, hist, valid[0]);
        top4_store(l1, F.lane, topi + (size_t)tk[1] * 4, gate + (size_t)tk[1] * 4, hist, valid[1]);
    }
    __syncthreads();
    if (F.tid < 32) wgcnt[F.bid * 32 + F.tid] = hist[F.tid];
}

__device__ __forceinline__ void slots_phase(const Frame& F0, int ntok) {
    Frame F = F0; F.tid = opq(F0.tid); F.lane = F.tid & 63; F.wave = __builtin_amdgcn_readfirstlane(F.tid >> 6); F.ws = opq_p(F0.ws);
    unsigned char* ws = F.ws;
    const int* wgcnt = (const int*)(ws + WS_WGCNT); const int* topi = (const int*)(ws + WS_TOPI); int* slot_tok = (int*)(ws + WS_SLOTTOK); int* tok_slot = (int*)(ws + WS_TOKSLOT); int* ecnt = (int*)(ws + WS_ECNT);
    volatile LAS int* tot = (volatile LAS int*)(F.CTLW + 64); volatile LAS int* cur = (volatile LAS int*)(F.CTLW + 96); volatile LAS int* ebase = (volatile LAS int*)(F.CTLW + 128);
    volatile LAS int* ptot = (volatile LAS int*)F.lds; volatile LAS int* pmb = ptot + 512;
    {   const int e = F.tid & 31, part = F.tid >> 5; int t = 0, mb = 0;
#pragma unroll
        for (int j = 0; j < 16; ++j) { const int w = part * 16 + j; const int c = wgcnt[w * 32 + e]; t += c; mb += (w < F.bid) ? c : 0; }
        ptot[F.tid] = t; pmb[F.tid] = mb; }
    __syncthreads();
    if (F.tid < 32) { int t = 0, mb = 0;
#pragma unroll
        for (int j = 0; j < 16; ++j) { t += ptot[j * 32 + F.tid]; mb += pmb[j * 32 + F.tid]; }
        tot[F.tid] = t; cur[F.tid] = mb; }
    __syncthreads();
    if (F.tid == 0) { int p = 0; for (int e = 0; e < 32; ++e) { ebase[e] = p * 256; p += (tot[e] + 255) >> 8; } }
    __syncthreads();
    if (F.tid < 32) { cur[F.tid] += ebase[F.tid]; if (F.bid == 0) ecnt[F.tid] = tot[F.tid]; }
    __syncthreads();
    const int per = ntok / F.G, t0 = F.bid * per;
    for (int i = F.tid; i < per * 4; i += NTHR) { const int tk = t0 + (i >> 2); const int e = topi[(size_t)tk * 4 + (i & 3)];
        const int slot = __hip_atomic_fetch_add((LAS int*)&cur[e], 1, __ATOMIC_RELAXED, __HIP_MEMORY_SCOPE_WORKGROUP); slot_tok[slot] = tk; tok_slot[(size_t)tk * 4 + (i & 3)] = slot; }
    if (F.bid < 32) { const int e = F.bid; const int lo = ebase[e] + tot[e], hi = ebase[e] + (((tot[e] + 255) >> 8) << 8); for (int s = lo + F.tid; s < hi; s += NTHR) slot_tok[s] = 0; }
    __syncthreads();
}
__device__ __forceinline__ void moe_prefix(const Frame& F0) {
    Frame F = F0; F.tid = opq(F0.tid); F.lane = F.tid & 63; F.wave = __builtin_amdgcn_readfirstlane(F.tid >> 6); F.ws = opq_p(F0.ws);
    const int* ecnt = (const int*)(F.ws + WS_ECNT); volatile LAS int* pref = (volatile LAS int*)(F.CTLW + 160);
    __syncthreads();
    if (F.tid == 0) { int p = 0; for (int e = 0; e < 32; ++e) { pref[e] = p; p += (ecnt[e] + 255) >> 8; } pref[32] = p; }
    __syncthreads();
}

__device__ __forceinline__ void combine_ln2(const Frame& F0, CArgsP A, int l, int ntok) {
    Frame F = F0; F.tid = opq(F0.tid); F.lane = F.tid & 63; F.wave = __builtin_amdgcn_readfirstlane(F.tid >> 6); F.ws = opq_p(F0.ws);
    unsigned char* ws = F.ws;
    float* X = (float*)(ws + WS_X); bf16_t* H = (bf16_t*)(ws + WS_H); const bf16_t* YV = (const bf16_t*)(ws + WS_YV);
    const float* mod = (const float*)(ws + WS_MOD) + (size_t)l * 5 * 6144; const float* modn = (const float*)(ws + WS_MOD) + (size_t)(l + 1 < DEPTH ? l + 1 : l) * 5 * 6144;
    const int* tok_slot = (const int*)(ws + WS_TOKSLOT); const float* gate = (const float*)(ws + WS_GATE);
    const float* lg = A->in[25] + (size_t)(l * 2 + 1) * D; const float* lb = A->in[26] + (size_t)(l * 2 + 1) * D;
    const bool lastl = (l == DEPTH - 1);
    const int stride = F.G * NWAVES;
    for (int tb = F.bid * NWAVES + F.wave; tb < ntok; tb += 2 * stride) {
        int tk[2]; bool valid[2];
#pragma unroll
        for (int k = 0; k < 2; ++k) { const int t = tb + k * stride; valid[k] = t < ntok; tk[k] = valid[k] ? t : tb; }
        f32x4 v[2][4]; float s[2] = {0.f, 0.f};
#pragma unroll
        for (int k = 0; k < 2; ++k) { const float* mv = mod + (size_t)tok_vec(tk[k]) * 6144;
            const int4 sl = *(const int4*)(tok_slot + (size_t)tk[k] * 4); const f32x4 gt = *(const f32x4*)(gate + (size_t)tk[k] * 4);
#pragma unroll
            for (int j = 0; j < 4; ++j) { const int c = 4 * F.lane + 256 * j;
                const u32x2 y0 = *(const u32x2*)(YV + (size_t)sl.x * 1024 + c), y1 = *(const u32x2*)(YV + (size_t)sl.y * 1024 + c), y2 = *(const u32x2*)(YV + (size_t)sl.z * 1024 + c), y3 = *(const u32x2*)(YV + (size_t)sl.w * 1024 + c);
                f32x4 f;
                f[0] = gt[0] * bf2f(y0.x & 0xffffu) + gt[1] * bf2f(y1.x & 0xffffu) + gt[2] * bf2f(y2.x & 0xffffu) + gt[3] * bf2f(y3.x & 0xffffu);
                f[1] = gt[0] * bf2f(y0.x >> 16) + gt[1] * bf2f(y1.x >> 16) + gt[2] * bf2f(y2.x >> 16) + gt[3] * bf2f(y3.x >> 16);
                f[2] = gt[0] * bf2f(y0.y & 0xffffu) + gt[1] * bf2f(y1.y & 0xffffu) + gt[2] * bf2f(y2.y & 0xffffu) + gt[3] * bf2f(y3.y & 0xffffu);
                f[3] = gt[0] * bf2f(y0.y >> 16) + gt[1] * bf2f(y1.y >> 16) + gt[2] * bf2f(y2.y >> 16) + gt[3] * bf2f(y3.y >> 16);
                const f32x4 x = *(const f32x4*)(X + (size_t)tk[k] * D + c), g2 = *(const f32x4*)(mv + 5120 + c);
                v[k][j] = x * DN_ALPHA + g2 * f; s[k] += (v[k][j][0] + v[k][j][1]) + (v[k][j][2] + v[k][j][3]); } }
        float mean[2], s2[2] = {0.f, 0.f}, rstd[2];
#pragma unroll
        for (int k = 0; k < 2; ++k) mean[k] = wave_sum(s[k]) * (1.0f / D);
#pragma unroll
        for (int k = 0; k < 2; ++k)
#pragma unroll
            for (int j = 0; j < 4; ++j) { v[k][j] = v[k][j] - mean[k]; s2[k] += (v[k][j][0] * v[k][j][0] + v[k][j][1] * v[k][j][1]) + (v[k][j][2] * v[k][j][2] + v[k][j][3] * v[k][j][3]); }
#pragma unroll
        for (int k = 0; k < 2; ++k) rstd[k] = rsqrtf(wave_sum(s2[k]) * (1.0f / D) + LN_EPS);
#pragma unroll
        for (int k = 0; k < 2; ++k) { if (!valid[k]) continue; const float* mn = modn + (size_t)tok_vec(tk[k]) * 6144;
#pragma unroll
            for (int j = 0; j < 4; ++j) { const int c = 4 * F.lane + 256 * j; const f32x4 g = *(const f32x4*)(lg + c), b = *(const f32x4*)(lb + c); const f32x4 xn = v[k][j] * rstd[k] * g + b;
                if (lastl) { *(f32x4*)(A->out + (size_t)tk[k] * D + c) = xn; }
                else { *(f32x4*)(X + (size_t)tk[k] * D + c) = xn; const f32x4 sh = *(const f32x4*)(mn + c), sc = *(const f32x4*)(mn + 1024 + c); const f32x4 h = xn * (sc + 1.0f) + sh;
                    u32x2 o; o.x = pk2(h[0], h[1]); o.y = pk2(h[2], h[3]); *(u32x2*)(H + (size_t)tk[k] * D + c) = o; } } }
    }
}

constexpr int NPL = 11, NPH = 3 + DEPTH * NPL;
#ifndef REPMASK
#define REPMASK 0u
#endif
__device__ __forceinline__ int reps_of(int b) { int r = 1 + (int)((REPMASK >> b) & 1u); if (REPMASK != 0u) asm volatile("" : "+s"(r)); return r; }

__global__ void __launch_bounds__(NTHR, 2) hybrid_fwd(Args args) {
    extern __shared__ __attribute__((aligned(16))) unsigned char lds[];
    Frame F;
    F.lds = (LAS unsigned char*)lds; F.CTLW = (volatile LAS unsigned*)(F.lds + LDSCTL_OFF);
    F.tid = threadIdx.x; F.lane = F.tid & 63; F.wave = __builtin_amdgcn_readfirstlane(F.tid >> 6); F.G = gridDim.x; F.bid = blockIdx.x; F.ws = args.ws;
    unsigned char* ws = args.ws;
    for (int u = F.tid; u < 256; u += NTHR) F.CTLW[u] = 0u;
    __syncthreads();
    XcdBarrier bar; bar.bar = (unsigned*)(ws + WS_CTL) + CW_BAR; bar.x = 0; bar.st = nullptr;
    if (MK_N_LAUNCHES == 1) bar = xcd_barrier_post((unsigned*)(ws + WS_CTL) + CW_BAR, F.CTLW + 8);
    const int lo = args.ph_lo, hi = args.ph_hi;
#ifndef PHMASK
#define PHMASK 0xFFFFFFFFu
#endif
#define IN(k) (lo <= (k) && (k) < hi)
#define ON(b) ((PHMASK >> (b)) & 1u)
#define REPS(b) reps_of(b)
#define REPBAR(b) do { if (rep + 1 < REPS(b)) { XcdBarrier _b = bar; _b.bar = (unsigned*)opq_p((unsigned char*)_b.bar); asm volatile("" : "+s"(_b.x)); xcd_barrier(_b); } } while (0)
#define SEAM(k) do { if (IN((k) + 1)) { XcdBarrier _b = bar; _b.bar = (unsigned*)opq_p((unsigned char*)_b.bar); asm volatile("" : "+s"(_b.x)); xcd_barrier(_b); } } while (0)
    if (ON(0) && IN(0)) { for (int rep = 0; rep < REPS(0); ++rep) { ph0_prologue(F, argp()); REPBAR(0); } SEAM(0); }
    if (ON(1) && IN(1)) { ph1_mod(F, argp()); SEAM(1); }
    if (ON(2) && IN(2)) { ph2_init(F, argp()); SEAM(2); }
    for (int l = 0; l < DEPTH; ++l) {
        const int pb = 3 + l * NPL;
        const int ntok = (l == DEPTH - 1) ? TLAT : T;
        if (ON(3) && IN(pb + 0)) { for (int rep = 0; rep < REPS(3); ++rep) {
            unsigned char* ws = opq_p(F.ws); CArgsP AP = argp(); (void)AP;
            typedef pg8::DenseSched<T / 256, NINP / 256> SchedT; SchedT S{(const char*)(ws + WS_H), (const char*)(ws + WS_WIN) + (size_t)l * NINP * 2048, (size_t)256 * 2048, (size_t)256 * 2048, F.G, F.bid};
            EpiInProj E{(bf16_t*)(ws + WS_PROJ), (bf16_t*)(ws + WS_UCAT), (float*)(ws + WS_GL), (bf16_t*)(ws + WS_VT)};
            pg8::gemm_phase<EpiInProj, SchedT, false>(F.lds, 2048u, 2048u, 1024, S, E);
            REPBAR(3); } SEAM(pb + 0);
        }
        if (ON(4) && IN(pb + 1)) { for (int rep = 0; rep < REPS(4); ++rep) {
            unsigned char* ws = opq_p(F.ws); CArgsP AP = argp(); (void)AP;
            typedef pg8::BatchSched<NCHP / 256, 1, 16> SchedT; SchedT S{(const char*)(ws + WS_UCAT), (const char*)(ws + WS_S5F) + (size_t)l * 16 * 256 * 2048, (size_t)NCHP * S5K * 2, (size_t)256 * 2048, (size_t)256 * S5K * 2, (size_t)256 * 2048, F.G, (F.bid + 128) & 255};
            EpiHloc E{(float*)(ws + WS_HLOC)};
#ifndef SUBMASK
#define SUBMASK 7
#endif
            if (SUBMASK & 1) pg8::gemm_phase<EpiHloc, SchedT, false>(F.lds, (unsigned)(S5K * 2), 2048u, 1024, S, E);
            __syncthreads();
            if (SUBMASK & 2) gla_local(F, argp(), l);
            if (SUBMASK & 4) sgu_phase(F, argp(), l);
            REPBAR(4); } SEAM(pb + 1);
        }
        if (ON(5) && IN(pb + 2)) { for (int rep = 0; rep < REPS(5); ++rep) { scan_phase(F, argp(), l); REPBAR(5); } SEAM(pb + 2); }
        if (ON(6) && IN(pb + 3)) { for (int rep = 0; rep < REPS(6); ++rep) {
            unsigned char* ws = opq_p(F.ws); CArgsP AP = argp(); (void)AP;
            typedef pg8::BatchSched<NCHP / 256, 4, 16> SchedT; SchedT S{(const char*)(ws + WS_UCAT), (const char*)(ws + WS_S5M) + (size_t)l * 16 * 1024 * S5K * 2, (size_t)NCHP * S5K * 2, (size_t)1024 * S5K * 2, (size_t)256 * S5K * 2, (size_t)256 * S5K * 2, F.G, F.bid};
            EpiS5Y E{(bf16_t*)(ws + WS_YS5)};
            pg8::gemm_phase<EpiS5Y, SchedT, false>(F.lds, (unsigned)(S5K * 2), (unsigned)(S5K * 2), S5K, S, E);
            __syncthreads();
            gla_out(F, argp(), l);
            REPBAR(6); } SEAM(pb + 3);
        }
        if (ON(7) && IN(pb + 4)) { for (int rep = 0; rep < REPS(7); ++rep) {
            unsigned char* ws = opq_p(F.ws); CArgsP AP = argp(); (void)AP;
            typedef pg8::DenseSched<T / 256, 1> SchedT; SchedT S{(const char*)(ws + WS_YS5), (const char*)(ws + WS_GLUT) + (size_t)l * 256 * 512, (size_t)256 * 512, (size_t)256 * 512, F.G, F.bid};
            EpiGlu E{(const bf16_t*)(ws + WS_YS5), (bf16_t*)(ws + WS_MIXED), AP->in[23] + l * 256};
            pg8::gemm_phase<EpiGlu, SchedT, false>(F.lds, 512u, 512u, 256, S, E);
            REPBAR(7); } SEAM(pb + 4);
        }
        if (ON(8) && IN(pb + 5)) { for (int rep = 0; rep < REPS(8); ++rep) {
            unsigned char* ws = opq_p(F.ws); CArgsP AP = argp(); (void)AP;
            typedef pg8::DenseSched<T / 256, 4> SchedT; SchedT S{(const char*)(ws + WS_MIXED), (const char*)(ws + WS_WOUT) + (size_t)l * 1024 * 2048, (size_t)256 * 2048, (size_t)256 * 2048, F.G, F.bid};
            EpiF32 E{(float*)(ws + WS_TMP), 1024};
            pg8::gemm_phase<EpiF32, SchedT, false>(F.lds, 2048u, 2048u, 1024, S, E);
            REPBAR(8); } SEAM(pb + 5);
        }
        if (ON(9) && IN(pb + 6)) { ln1_router(F, argp(), l, ntok); SEAM(pb + 6); }
        if (ON(10) && IN(pb + 7)) { for (int rep = 0; rep < REPS(10); ++rep) { slots_phase(F, ntok); REPBAR(10); } SEAM(pb + 7); }
        if (ON(11) && IN(pb + 8)) { for (int rep = 0; rep < REPS(11); ++rep) {
            unsigned char* ws = opq_p(F.ws); CArgsP AP = argp(); (void)AP;
            moe_prefix(F);
            pg8::MoeSched<8, true> S{(const char*)(ws + WS_H), (const char*)(ws + WS_WUP) + (size_t)l * 32 * 2048 * 2048, (const int*)(ws + WS_SLOTTOK), (const LAS int*)(F.CTLW + 160), 0, (size_t)2048 * 2048, (size_t)256 * 2048, F.G, F.bid};
            EpiUp E{(bf16_t*)(ws + WS_ACT), AP->in[30] + (size_t)l * 32 * 2048};
            pg8::gemm_phase<EpiUp, pg8::MoeSched<8, true>, true>(F.lds, 2048u, 2048u, 1024, S, E);
            REPBAR(11); } SEAM(pb + 8);
        }
        if (ON(12) && IN(pb + 9)) { for (int rep = 0; rep < REPS(12); ++rep) {
            unsigned char* ws = opq_p(F.ws); CArgsP AP = argp(); (void)AP;
            moe_prefix(F);
            pg8::MoeSched<4, false> S{(const char*)(ws + WS_ACT), (const char*)(ws + WS_WDN) + (size_t)l * 32 * 1024 * 2048, (const int*)(ws + WS_SLOTTOK), (const LAS int*)(F.CTLW + 160), (size_t)256 * 2048, (size_t)1024 * 2048, (size_t)256 * 2048, F.G, F.bid};
            EpiDown E{(bf16_t*)(ws + WS_YV), AP->in[32] + (size_t)l * 32 * 1024};
            pg8::gemm_phase<EpiDown, pg8::MoeSched<4, false>, false>(F.lds, 2048u, 2048u, 1024, S, E);
            REPBAR(12); } SEAM(pb + 9);
        }
        if (ON(13) && IN(pb + 10)) { combine_ln2(F, argp(), l, ntok); SEAM(pb + 10); }
    }
#undef IN
#undef SEAM
}

extern "C" void kernel_launch(void* const* d_in, const int* in_sizes, int n_in, void* d_out, int out_size, void* d_ws, size_t ws_size, hipStream_t stream) {
    static int grid = 0;
    if (grid == 0) {
        if (n_in != 33 || out_size != TLAT * D || ws_size < WS_END) { fprintf(stderr, "kernel_launch: unexpected problem (n_in %d, out %d, ws %zu)\n", n_in, out_size, ws_size); grid = -1; return; }
        int dev = 0, cus = 0, per_cu = 0;
        if (hipGetDevice(&dev) != hipSuccess || hipDeviceGetAttribute(&cus, hipDeviceAttributeMultiprocessorCount, dev) != hipSuccess) { grid = -1; return; }
        if (hipFuncSetAttribute((const void*)hybrid_fwd, hipFuncAttributeMaxDynamicSharedMemorySize, LDS_BYTES) != hipSuccess) { fprintf(stderr, "kernel_launch: hipFuncSetAttribute failed\n"); grid = -1; return; }
        if (hipOccupancyMaxActiveBlocksPerMultiprocessor(&per_cu, (const void*)hybrid_fwd, NTHR, LDS_BYTES) != hipSuccess || per_cu < 1) fprintf(stderr, "kernel_launch: occupancy query says %d\n", per_cu);
        (void)hipGetLastError();
        grid = cus;
        if (grid != 256) { fprintf(stderr, "kernel_launch: built for 256 CUs, found %d\n", cus); grid = -1; return; }
    }
    if (grid < 0) return;
    if (hipMemsetAsync((char*)d_ws + WS_CTL, 0, CTL_ZERO_BYTES, stream) != hipSuccess) return;
    Args a{};
    for (int i = 0; i < 33; ++i) a.in[i] = (const float*)d_in[i];
    a.out = (float*)d_out; a.ws = (unsigned char*)d_ws;
#if MK_N_LAUNCHES == 1
    a.ph_lo = 0; a.ph_hi = NPH;
    hipLaunchKernelGGL(hybrid_fwd, dim3(grid), dim3(NTHR), LDS_BYTES, stream, a);
#else
    for (int p = 0; p < NPH; ++p) { a.ph_lo = p; a.ph_hi = p + 1; hipLaunchKernelGGL(hybrid_fwd, dim3(grid), dim3(NTHR), LDS_BYTES, stream, a); }
#endif
}
```

```cpp
#include <hip/hip_runtime.h>
#include <cstdio>
#include <cstdint>

#define REPMASK 0u
#ifndef MK_N_LAUNCHES
#define MK_N_LAUNCHES 1
#endif

#define GAS __attribute__((address_space(1)))
#define LAS __attribute__((address_space(3)))
typedef unsigned short bf16_t;
typedef short bf16x8 __attribute__((ext_vector_type(8)));
typedef float f32x4 __attribute__((ext_vector_type(4)));
typedef float f32x2 __attribute__((ext_vector_type(2)));
typedef unsigned u32x4 __attribute__((ext_vector_type(4)));
typedef unsigned u32x2 __attribute__((ext_vector_type(2)));

constexpr int D = 1024, NB = 4, SEQ = 8192, DEPTH = 4, CTXL = 256;
constexpr int TLAT = NB * SEQ, TCTX = NB * CTXL, T = TLAT + TCTX;
constexpr int NIN = 2336, NINP = 2560, PROJW = 2048;
constexpr int NCH = T / 64, NCHP = 768;
constexpr int NEXP = 32, DEXP = 1024;
constexpr int MAXTILES = 560, NSLOT = MAXTILES * 256;
constexpr int S5K = 1280;
constexpr float LN_EPS = 1e-5f;
constexpr float DN_ALPHA = 1.681792830507429f;
constexpr int NWAVES = 8, NTHR = 512;

constexpr size_t MiB = 1u << 20;
constexpr size_t WS_CTL = 0, CTL_ZERO_BYTES = 1 * MiB;
constexpr size_t WS_MODP = 1 * MiB, WS_MOD = 5 * MiB, WS_LB64 = 6 * MiB, WS_KTAB = 7 * MiB, WS_SGUW = 15 * MiB, WS_GLUT = 16 * MiB;
constexpr size_t WS_WIN = 17 * MiB, WS_WOUT = 37 * MiB, WS_S5M = 45 * MiB, WS_S5F = 205 * MiB, WS_WUP = 237 * MiB, WS_WDN = 749 * MiB;
constexpr size_t WS_X = 1005 * MiB, WS_H = 1137 * MiB, WS_PROJ = 1203 * MiB, WS_GL = 1335 * MiB, WS_UCAT = 1340 * MiB, WS_HLOC = 1370 * MiB;
constexpr size_t WS_YS5 = 1382 * MiB, WS_QS = 1399 * MiB, WS_KS = 1432 * MiB, WS_QH = 1465 * MiB, WS_VT = 1498 * MiB, WS_GLAST = 1531 * MiB;
constexpr size_t WS_SPREV = 1663 * MiB, WS_GDEC = 1729 * MiB, WS_MIXED = 1731 * MiB, WS_TMP = 1797 * MiB, WS_TOPI = 1929 * MiB, WS_GATE = 1930 * MiB;
constexpr size_t WS_WGCNT = 1931 * MiB, WS_ECNT = 1932 * MiB, WS_SLOTTOK = 1933 * MiB, WS_TOKSLOT = 1934 * MiB, WS_ACT = 1935 * MiB, WS_YV = 2215 * MiB;
constexpr size_t WS_WRT = 2495 * MiB, WS_END = 2496 * MiB;
constexpr int CW_BAR = 4096;

constexpr int RING_BYTES = 131072;
constexpr int LDS_BYTES = 163840;
constexpr int LDSCTL_OFF = LDS_BYTES - 1024;

__device__ __forceinline__ float bf2f(unsigned b) { return __uint_as_float(b << 16); }
__device__ __forceinline__ unsigned f2bf(float f) { unsigned u = __float_as_uint(f); return (u + 0x7fffu + ((u >> 16) & 1u)) >> 16; }
__device__ __forceinline__ unsigned pk2(float lo, float hi) { return f2bf(lo) | (f2bf(hi) << 16); }
__device__ __forceinline__ unsigned cvt_pk_bf16(float lo, float hi) { unsigned r; asm volatile("v_cvt_pk_bf16_f32 %0, %1, %2" : "=v"(r) : "v"(lo), "v"(hi)); return r; }
__device__ __forceinline__ unsigned pk4_fp8(float a, float b, float c, float d) { int w = 0; w = __builtin_amdgcn_cvt_pk_fp8_f32(a, b, w, false); w = __builtin_amdgcn_cvt_pk_fp8_f32(c, d, w, true); return (unsigned)w; }
__device__ __forceinline__ float rcpf(float x) { return __builtin_amdgcn_rcpf(x); }
__device__ __forceinline__ float sigmoidf_(float x) { return rcpf(1.0f + __expf(-x)); }
__device__ __forceinline__ float siluf_(float x) { return x * sigmoidf_(x); }
__device__ __forceinline__ float gelu_tanh(float x) { const float u = 0.7978845608028654f * (x + 0.044715f * x * x * x); const float e = __expf(2.0f * u); return x * (1.0f - rcpf(1.0f + e)); }
__device__ __forceinline__ float logsigmoidf_(float x) { return fminf(x, 0.0f) - __logf(1.0f + __expf(-fabsf(x))); }
__device__ __forceinline__ float wave_sum(float v) {
#pragma unroll
    for (int o = 1; o < 64; o <<= 1) v += __shfl_xor(v, o);
    return v;
}
__device__ __forceinline__ int opq(int x) { asm volatile("" : "+v"(x)); return x; }
__device__ __forceinline__ int tok_vec(int tk) { return tk < TLAT ? (tk >> 13) : 4; }

#define XB_TMO      128
#define XB_XCNT(j)  (256  + 64 * (j))
#define XB_XSUB(j)  (1280 + 64 * (j))
#define XB_XGEN(j)  (2304 + 64 * (j))
#define XB_TOP      3328
#define XB_TOPGEN   3392
#define XCD_BAR_WORDS 3456
#define XB_SPIN_CAP (1u << 20)
__device__ __forceinline__ unsigned xb_ld(unsigned* p)              { return __hip_atomic_load(p, __ATOMIC_RELAXED, __HIP_MEMORY_SCOPE_AGENT); }
__device__ __forceinline__ unsigned xb_add(unsigned* p, unsigned v) { return __hip_atomic_fetch_add(p, v, __ATOMIC_RELAXED, __HIP_MEMORY_SCOPE_AGENT); }
__device__ __forceinline__ unsigned xb_xcc_id() { return (unsigned)__builtin_amdgcn_s_getreg((3 << 11) | 20) & 0xFu; }
#define XB_SPIN(cond, bar) do { unsigned _sp = 0; while (cond) { __builtin_amdgcn_s_sleep(1); \
    if ((++_sp & 255u) == 0u) { if (xb_ld(&(bar)[XB_TMO])) break; if (_sp > XB_SPIN_CAP) { atomicAdd(&(bar)[XB_TMO], 1u); break; } } } } while (0)
struct XcdBarrier { unsigned* bar; unsigned x; volatile LAS unsigned* st; };
__device__ __forceinline__ XcdBarrier xcd_barrier_post(unsigned* bar, volatile LAS unsigned* st) {
    XcdBarrier b; b.bar = bar; b.x = xb_xcc_id(); b.st = st;
    if (threadIdx.x == 0) (void)xb_add(&bar[XB_XCNT(b.x)], 1u);
    return b;
}
__device__ __forceinline__ void xcd_barrier_complete(unsigned* bar, unsigned x, unsigned& nloc, unsigned& nx) {
    const unsigned G = gridDim.x * gridDim.y * gridDim.z;
    unsigned sum, cnt, mine, sp = 0u;
    for (;;) {
        sum = 0u; cnt = 0u; mine = 0u;
#pragma unroll
        for (unsigned j = 0; j < 16; ++j) { const unsigned c = xb_ld(&bar[XB_XCNT(j)]); sum += c; cnt += (c > 0u) ? 1u : 0u; mine = (j == x) ? c : mine; }
        if (sum == G) break;
        __builtin_amdgcn_s_sleep(1);
        if ((++sp & 255u) == 0u) { if (xb_ld(&bar[XB_TMO])) break; if (sp > XB_SPIN_CAP) { atomicAdd(&bar[XB_TMO], 1u); break; } }
    }
    nloc = mine > 0u ? mine : 1u; nx = cnt > 0u ? cnt : 1u;
}
__device__ __forceinline__ void xcd_barrier(const XcdBarrier& b) {
    asm volatile("s_waitcnt vmcnt(0)" ::: "memory");
    __syncthreads();
    if (threadIdx.x == 0) {
        unsigned* bar = b.bar;
        __builtin_amdgcn_s_waitcnt(0);
        unsigned nloc = b.st[0], nx = b.st[1];
        if (nloc == 0u) { xcd_barrier_complete(bar, b.x, nloc, nx); b.st[0] = nloc; b.st[1] = nx; }
        const unsigned old = xb_add(&bar[XB_XSUB(b.x)], 1u);
        const unsigned gen = old / nloc;
        if (old + 1u == (gen + 1u) * nloc) {
            __builtin_amdgcn_fence(__ATOMIC_RELEASE, "agent");
            asm volatile("s_waitcnt vmcnt(0)" ::: "memory");
            const unsigned og = xb_add(&bar[XB_TOP], 1u);
            const unsigned tg = og / nx;
            if (og + 1u == (tg + 1u) * nx) xb_add(&bar[XB_TOPGEN], 1u);
            else XB_SPIN(xb_ld(&bar[XB_TOPGEN]) == tg, bar);
            __builtin_amdgcn_fence(__ATOMIC_ACQUIRE, "agent");
            xb_add(&bar[XB_XGEN(b.x)], 1u);
            asm volatile("s_waitcnt vmcnt(0)" ::: "memory");
        } else {
            XB_SPIN(xb_ld(&bar[XB_XGEN(b.x)]) == gen, bar);
            __builtin_amdgcn_fence(__ATOMIC_ACQUIRE, "agent");
            asm volatile("s_waitcnt vmcnt(0)" ::: "memory");
        }
    }
    __syncthreads();
}

namespace pg8 {
constexpr int BM = 256, BK = 64, HALF = 128, HTB = HALF * BK * 2, STAGE_BYTES = 8 * HTB, NXCD = 8, WGM = 8;
__host__ __device__ __forceinline__ int lds_byte(int r, int c) { const int st = (r >> 4) * 2 + (c >> 5), rr = r & 15, cc = c & 31, ob = rr * 64 + cc * 2; return st * 1024 + (ob ^ (((ob >> 9) & 1) << 5)); }
__host__ __device__ __forceinline__ void stage_rc(int b, int& R, int& C) { const int st = b / 1024, sb = b % 1024, swz = sb ^ (((sb >> 9) & 1) << 5); R = (st >> 1) * 16 + swz / 64; C = (st & 1) * 32 + (swz % 64) / 2; }
__host__ __device__ __forceinline__ int perm32(int rho) { const int n = rho >> 4, i = rho & 15; return 8 * (i >> 2) + 4 * n + (i & 3); }

struct GUnit { const char* a; const char* b; const int* rows; int pm, pn, grp; };

typedef int i32x4 __attribute__((ext_vector_type(4)));
typedef int i32x8 __attribute__((ext_vector_type(8)));
__device__ __forceinline__ i32x8 cat8(bf16x8 lo, bf16x8 hi) { const i32x4 a = __builtin_bit_cast(i32x4, lo), b = __builtin_bit_cast(i32x4, hi); return __builtin_shufflevector(a, b, 0, 1, 2, 3, 4, 5, 6, 7); }
template <class Epi, class Sched, bool GATHER, bool FP8 = false>
__device__ __forceinline__ void gemm_phase(LAS unsigned char* lds, const unsigned lda, const unsigned ldb, const int K, const Sched& S, const Epi& E) {
    const int tid = opq((int)threadIdx.x), wid = __builtin_amdgcn_readfirstlane(tid >> 6), lane = tid & 63, wr = wid >> 2, wc = wid & 3, fr = lane & 15, fq = lane >> 4;
    int Kq = K; asm volatile("" : "+s"(Kq)); const int nt = FP8 ? Kq / 128 : Kq / BK;
    unsigned voffB[2], cA0[2], cA1[2], nA0[2], nA1[2];
#pragma unroll
    for (int i = 0; i < 2; ++i) { int R, C; stage_rc(tid * 16 + i * 8192, R, C); const int Rb = Epi::PERM ? ((R & ~31) + perm32(R & 31)) : R;
        voffB[i] = (unsigned)Rb * ldb + (unsigned)C * 2u; }
    const size_t kstep = (size_t)(BK * 2);
    const size_t hstepB = (size_t)HALF * ldb;
    const unsigned ldsw = (unsigned)wid * 1024u;
    const int aoff = lds_byte(wr * 64 + fr, fq * 8), boff = lds_byte(wc * 32 + fr, fq * 8);
#define PG8_AOFF(u, o0, o1) do { const int _t = opq((int)threadIdx.x); _Pragma("unroll") for (int _i = 0; _i < 2; ++_i) { int _R, _C; stage_rc(_t * 16 + _i * 8192, _R, _C); \
        if (GATHER) { o0[_i] = (unsigned)(u).rows[_R] * lda + (unsigned)_C * 2u; o1[_i] = (unsigned)(u).rows[_R + HALF] * lda + (unsigned)_C * 2u; } \
        else { o0[_i] = (unsigned)_R * lda + (unsigned)_C * 2u; o1[_i] = o0[_i] + (unsigned)HALF * lda; } } } while (0)
#define PG8_SA(b, h) (((b) * 2 + (h)) * HTB)
#define PG8_SB(b, h) ((4 + (b) * 2 + (h)) * HTB)
#define PG8_STAGE(bufoff, gbase, voff) do { _Pragma("unroll") for (int _i = 0; _i < 2; ++_i) \
        __builtin_amdgcn_global_load_lds((const unsigned*)((const char*)(gbase) + (voff)[_i]), (LAS unsigned*)(lds + (bufoff) + ldsw + _i * 8192), 16, 0, 0); } while (0)
#define PG8_LDA(dst, b, h) do { _Pragma("unroll") for (int m = 0; m < 4; ++m) { dst[m].lo = *(const LAS i32x4*)(lds + PG8_SA(b, h) + aoff + m * 2048); dst[m].hi = *(const LAS i32x4*)(lds + PG8_SA(b, h) + aoff + m * 2048 + 1024); } } while (0)
#define PG8_LDB(dst, b, h) do { _Pragma("unroll") for (int n = 0; n < 2; ++n) { dst[n].lo = *(const LAS i32x4*)(lds + PG8_SB(b, h) + boff + n * 2048); dst[n].hi = *(const LAS i32x4*)(lds + PG8_SB(b, h) + boff + n * 2048 + 1024); } } while (0)
#define PG8_MMA(ai, bj, At, Bt) do { __builtin_amdgcn_s_setprio(1); if constexpr (FP8) asm volatile("s_nop 4"); _Pragma("unroll") for (int m = 0; m < 4; ++m) _Pragma("unroll") for (int n = 0; n < 2; ++n) { \
        if constexpr (FP8) asm volatile("v_mfma_scale_f32_16x16x128_f8f6f4 %0, %1, %2, %0, %3, %3 op_sel_hi:[0,0,0]" : "+v"(acc[ai][bj][m][n]) : "v"(Bt[n]), "v"(At[m]), "v"(sc1)); \
        else { acc[ai][bj][m][n] = __builtin_amdgcn_mfma_f32_16x16x32_bf16(__builtin_bit_cast(bf16x8, (i32x4)Bt[n].lo), __builtin_bit_cast(bf16x8, (i32x4)At[m].lo), acc[ai][bj][m][n], 0, 0, 0); \
               acc[ai][bj][m][n] = __builtin_amdgcn_mfma_f32_16x16x32_bf16(__builtin_bit_cast(bf16x8, (i32x4)Bt[n].hi), __builtin_bit_cast(bf16x8, (i32x4)At[m].hi), acc[ai][bj][m][n], 0, 0, 0); } } \
        __builtin_amdgcn_s_setprio(0); } while (0)
#define PG8_WAIT_V(n) asm volatile("s_waitcnt vmcnt(" #n ")" ::: "memory")
#define PG8_WAIT_L(n) asm volatile("s_waitcnt lgkmcnt(" #n ")" ::: "memory")
#define PG8_BAR __builtin_amdgcn_s_barrier()
#define PG8_SCHED __builtin_amdgcn_sched_barrier(0)
    GUnit cur, nxt; int ui = 0;
    if (!S.next(0, cur)) return;
    f32x4 acc[2][2][4][2];
#pragma unroll
    for (int a = 0; a < 2; ++a)
#pragma unroll
        for (int b = 0; b < 2; ++b)
#pragma unroll
            for (int m = 0; m < 4; ++m)
#pragma unroll
                for (int n = 0; n < 2; ++n) acc[a][b][m][n] = (f32x4){0.f, 0.f, 0.f, 0.f};
    const int sc1 = 0x7f7f7f7f;
    i32x8 At[4], B0[2], B1[2];
    const char* cA = cur.a; const char* cB = cur.b;
    PG8_AOFF(cur, cA0, cA1);
    PG8_STAGE(PG8_SB(0, 0), cB, voffB); PG8_STAGE(PG8_SB(0, 1), cB + hstepB, voffB); PG8_STAGE(PG8_SA(0, 0), cA, cA0); PG8_STAGE(PG8_SA(0, 1), cA, cA1);
    if (wr == 1) PG8_BAR;
    PG8_WAIT_V(2); PG8_BAR;
    PG8_STAGE(PG8_SB(1, 0), cB + kstep, voffB); PG8_STAGE(PG8_SA(1, 0), cA + kstep, cA0); PG8_STAGE(PG8_SB(1, 1), cB + hstepB + kstep, voffB);
    PG8_WAIT_V(6); PG8_BAR;
    for (;;) {
        const bool has_next = S.next(ui + 1, nxt);
        const char* nA = has_next ? nxt.a : cA; const char* nB = has_next ? nxt.b : cB;
        if constexpr (GATHER) { if (has_next) { PG8_AOFF(nxt, nA0, nA1); } else {
#pragma unroll
            for (int i = 0; i < 2; ++i) { nA0[i] = cA0[i]; nA1[i] = cA1[i]; } } }
        for (int t = 0; t < nt; t += 2) {
            const bool last = (t == nt - 2);
            const char* a1 = cA + (size_t)(t + 1) * kstep;
            const char* a2 = last ? nA : cA + (size_t)(t + 2) * kstep; const char* b2 = last ? nB : cB + (size_t)(t + 2) * kstep;
            const char* a3 = a2 + kstep; const char* b3 = b2 + kstep;
            unsigned s0[2], s1[2];
#pragma unroll
            for (int i = 0; i < 2; ++i) { if constexpr (GATHER) { s0[i] = last ? nA0[i] : cA0[i]; s1[i] = last ? nA1[i] : cA1[i]; } else { s0[i] = cA0[i]; s1[i] = cA1[i]; } }
            PG8_LDB(B0, 0, 0); PG8_LDB(B1, 0, 1); PG8_SCHED; PG8_LDA(At, 0, 0); PG8_STAGE(PG8_SA(1, 1), a1, cA1);
            PG8_WAIT_V(8); PG8_WAIT_L(0); PG8_BAR; PG8_MMA(0, 0, At, B0); PG8_MMA(0, 1, At, B1); PG8_BAR; PG8_SCHED;
            PG8_LDA(At, 0, 1); PG8_STAGE(PG8_SB(0, 0), b2, voffB); PG8_STAGE(PG8_SB(0, 1), b2 + hstepB, voffB); PG8_STAGE(PG8_SA(0, 0), a2, s0);
            PG8_WAIT_V(8); PG8_WAIT_L(0); PG8_BAR; PG8_MMA(1, 0, At, B0); PG8_MMA(1, 1, At, B1); PG8_BAR; PG8_SCHED;
            PG8_LDB(B0, 1, 0); PG8_LDB(B1, 1, 1); PG8_SCHED; PG8_LDA(At, 1, 0); PG8_STAGE(PG8_SA(0, 1), a2, s1);
            PG8_WAIT_V(8); PG8_WAIT_L(0); PG8_BAR; PG8_MMA(0, 0, At, B0); PG8_MMA(0, 1, At, B1); PG8_BAR; PG8_SCHED;
            PG8_LDA(At, 1, 1); PG8_STAGE(PG8_SB(1, 0), b3, voffB); PG8_STAGE(PG8_SB(1, 1), b3 + hstepB, voffB); PG8_STAGE(PG8_SA(1, 0), a3, s0);
            PG8_WAIT_V(8); PG8_WAIT_L(0); PG8_BAR; PG8_MMA(1, 0, At, B0); PG8_MMA(1, 1, At, B1); PG8_BAR; PG8_SCHED;
        }
        if constexpr (FP8) asm volatile("s_nop 15\n\ts_nop 15");
        if (wr == 0) PG8_BAR;
        { const int _t = opq((int)threadIdx.x), _w = __builtin_amdgcn_readfirstlane(_t >> 6), _l = _t & 63; E(acc, cur, _w >> 2, _w & 3, _l & 15, _l >> 4); }
        if (!has_next) break;
#pragma unroll
        for (int a = 0; a < 2; ++a)
#pragma unroll
            for (int b = 0; b < 2; ++b)
#pragma unroll
                for (int m = 0; m < 4; ++m)
#pragma unroll
                    for (int n = 0; n < 2; ++n) acc[a][b][m][n] = (f32x4){0.f, 0.f, 0.f, 0.f};
        cur = nxt; cA = nA; cB = nB; ++ui;
        if constexpr (GATHER) {
#pragma unroll
            for (int i = 0; i < 2; ++i) { cA0[i] = nA0[i]; cA1[i] = nA1[i]; } }
        if (wr == 1) PG8_BAR;
    }
    PG8_WAIT_V(0);
    PG8_BAR;
#undef PG8_AOFF
#undef PG8_SA
#undef PG8_SB
#undef PG8_STAGE
#undef PG8_LDA
#undef PG8_LDB
#undef PG8_MMA
#undef PG8_WAIT_V
#undef PG8_WAIT_L
#undef PG8_BAR
#undef PG8_SCHED
}

template <int NM, int NN> struct DenseSched {
    const char* A; const char* B; size_t tstepA, tstepB; int G, c;
    __device__ __forceinline__ bool next(int i, GUnit& u) const {
        constexpr int nwg = NM * NN, q = nwg / NXCD, r = nwg % NXCD, nig = WGM * NN, REM = (NM % WGM) ? (NM % WGM) : WGM;
        const int L = i * G + c; if (L >= nwg) return false;
        const int xcd = L % NXCD, off = L / NXCD; const int wgid = (xcd < r ? xcd * (q + 1) : r * (q + 1) + (xcd - r) * q) + off;
        const int gid = wgid / nig, w2 = wgid % nig, fm = gid * WGM;
        if (NM - fm >= WGM) { u.pm = fm + (w2 % WGM); u.pn = w2 / WGM; } else { u.pm = fm + (w2 % REM); u.pn = w2 / REM; }
        u.grp = 0; u.rows = nullptr;
        u.a = A + (size_t)u.pm * tstepA; u.b = B + (size_t)u.pn * tstepB; return true;
    }
};
template <int NM, int NN, int NGRP> struct BatchSched {
    const char* A; const char* B; size_t gstepA, gstepB, tstepA, tstepB; int G, c;
    __device__ __forceinline__ bool next(int i, GUnit& u) const {
        constexpr int per = NM * NN;
        const int L = i * G + c; if (L >= NGRP * per) return false;
        u.grp = L / per; const int r = L % per; u.pn = r % NN; u.pm = r / NN; u.rows = nullptr;
        u.a = A + (size_t)u.grp * gstepA + (size_t)u.pm * tstepA; u.b = B + (size_t)u.grp * gstepB + (size_t)u.pn * tstepB; return true;
    }
};
template <int NCT, bool GATHER> struct MoeSched {
    const char* A; const char* B; const int* slot_tok; const LAS int* pref; size_t tstepA, estepB, tstepB; int G, c;
    __device__ __forceinline__ bool next(int i, GUnit& u) const {
        const int L = i * G + c; const int TT = pref[NEXP]; if (L >= TT * NCT) return false;
        const int rt = L / NCT, ct = L % NCT; int e = 0;
        for (int j = 1; j < NEXP; ++j) e += (pref[j] <= rt) ? 1 : 0;
        u.pm = rt; u.pn = ct; u.grp = e; u.rows = slot_tok + rt * 256;
        u.a = GATHER ? A : A + (size_t)rt * tstepA; u.b = B + (size_t)e * estepB + (size_t)ct * tstepB; return true;
    }
};
}
using pg8::GUnit;

struct Args { const float* in[33]; float* out; unsigned char* ws; int ph_lo, ph_hi; };

typedef const __attribute__((address_space(4))) Args* CArgsP;
__device__ __forceinline__ CArgsP argp() { CArgsP p = (CArgsP)__builtin_amdgcn_kernarg_segment_ptr(); asm volatile("" : "+s"(p)); return p; }
__device__ __forceinline__ unsigned char* opq_p(unsigned char* p) { asm volatile("" : "+s"(p)); return p; }

struct Frame {
    LAS unsigned char* lds; volatile LAS unsigned* CTLW;
    int tid, lane, wave, G, bid;
    unsigned char* ws;
};

struct EpiInProj { static constexpr bool PERM = true; bf16_t* proj; bf16_t* ucat; float* gl; bf16_t* vt;
    __device__ __forceinline__ void operator()(const f32x4 (&acc)[2][2][4][2], const GUnit& u, int wr, int wc, int fr, int fq) const {
        const int row0 = u.pm * 256 + wr * 64 + fr;
        if (u.pn == 4 || u.pn == 5) {
#pragma unroll
            for (int ai = 0; ai < 2; ++ai) { const int chunk = u.pm * 4 + ai * 2 + wr;
#pragma unroll
                for (int bj = 0; bj < 2; ++bj) { const int ecol = (u.pn - 4) * 256 + bj * 128 + wc * 32 + 8 * fq, h = ecol >> 7, e0 = ecol & 127;
                    bf16_t* base = vt + ((size_t)(chunk * 4 + h) * 128 + e0) * 64 + fr;
#pragma unroll
                    for (int m = 0; m < 4; ++m)
#pragma unroll
                        for (int n = 0; n < 2; ++n)
#pragma unroll
                            for (int i = 0; i < 4; ++i) base[(4 * n + i) * 64 + m * 16] = (bf16_t)f2bf(acc[ai][bj][m][n][i]); } }
        } else if (u.pn < 8) {
            const bool dog = u.pn < 2;
#pragma unroll
            for (int ai = 0; ai < 2; ++ai)
#pragma unroll
                for (int m = 0; m < 4; ++m) { bf16_t* rowp = proj + (size_t)(row0 + ai * 128 + m * 16) * PROJW + u.pn * 256 + wc * 32 + 8 * fq;
#pragma unroll
                    for (int bj = 0; bj < 2; ++bj) { f32x4 v0 = acc[ai][bj][m][0], v1 = acc[ai][bj][m][1];
                        if (dog) {
#pragma unroll
                            for (int j = 0; j < 4; ++j) { v0[j] = gelu_tanh(v0[j]); v1[j] = gelu_tanh(v1[j]); } }
                        u32x4 w; w.x = cvt_pk_bf16(v0[0], v0[1]); w.y = cvt_pk_bf16(v0[2], v0[3]); w.z = cvt_pk_bf16(v1[0], v1[1]); w.w = cvt_pk_bf16(v1[2], v1[3]);
                        *(u32x4*)(rowp + bj * 128) = w; } }
        } else if (u.pn == 8) {
#pragma unroll
            for (int ai = 0; ai < 2; ++ai)
#pragma unroll
                for (int m = 0; m < 4; ++m) { const int row = row0 + ai * 128 + m * 16, chunk = row >> 6, s = row & 63;
#pragma unroll
                    for (int bj = 0; bj < 2; ++bj) { const int j0 = bj * 128 + wc * 32 + 8 * fq, g = j0 >> 4, h0 = j0 & 15;
                        const f32x4 v0 = acc[ai][bj][m][0], v1 = acc[ai][bj][m][1];
                        u32x4 w; w.x = cvt_pk_bf16(v0[0], v0[1]); w.y = cvt_pk_bf16(v0[2], v0[3]); w.z = cvt_pk_bf16(v1[0], v1[1]); w.w = cvt_pk_bf16(v1[2], v1[3]);
                        *(u32x4*)(ucat + ((size_t)(g * NCHP + chunk) * S5K + s * 16 + h0)) = w; } }
        } else {
            if (wc == 0) {
#pragma unroll
                for (int ai = 0; ai < 2; ++ai)
#pragma unroll
                    for (int m = 0; m < 4; ++m) { float* dst = gl + (size_t)(row0 + ai * 128 + m * 16) * 32 + 8 * fq;
                        *(f32x4*)dst = acc[ai][0][m][0]; *(f32x4*)(dst + 4) = acc[ai][0][m][1]; } }
        }
    }
};
struct EpiHloc { static constexpr bool PERM = false; float* hloc;
    __device__ __forceinline__ void operator()(const f32x4 (&acc)[2][2][4][2], const GUnit& u, int wr, int wc, int fr, int fq) const {
        const int row0 = u.pm * 256 + wr * 64 + fr;
#pragma unroll
        for (int ai = 0; ai < 2; ++ai)
#pragma unroll
            for (int m = 0; m < 4; ++m) { float* rowp = hloc + ((size_t)u.grp * NCHP + row0 + ai * 128 + m * 16) * 256 + wc * 32 + 4 * fq;
#pragma unroll
                for (int bj = 0; bj < 2; ++bj)
#pragma unroll
                    for (int n = 0; n < 2; ++n) *(f32x4*)(rowp + bj * 128 + n * 16) = acc[ai][bj][m][n]; }
    }
};
struct EpiS5Y { static constexpr bool PERM = true; bf16_t* ys5;
    __device__ __forceinline__ void operator()(const f32x4 (&acc)[2][2][4][2], const GUnit& u, int wr, int wc, int fr, int fq) const {
        const int row0 = u.pm * 256 + wr * 64 + fr;
#pragma unroll
        for (int ai = 0; ai < 2; ++ai)
#pragma unroll
            for (int m = 0; m < 4; ++m) { const int c = row0 + ai * 128 + m * 16;
                if (c < NCH) {
#pragma unroll
                    for (int bj = 0; bj < 2; ++bj) { const int j0 = u.pn * 256 + bj * 128 + wc * 32 + 8 * fq, t = j0 >> 4, h0 = j0 & 15;
                        f32x4 v0 = acc[ai][bj][m][0], v1 = acc[ai][bj][m][1];
#pragma unroll
                        for (int j = 0; j < 4; ++j) { v0[j] = gelu_tanh(v0[j]); v1[j] = gelu_tanh(v1[j]); }
                        u32x4 w; w.x = cvt_pk_bf16(v0[0], v0[1]); w.y = cvt_pk_bf16(v0[2], v0[3]); w.z = cvt_pk_bf16(v1[0], v1[1]); w.w = cvt_pk_bf16(v1[2], v1[3]);
                        *(u32x4*)(ys5 + (size_t)(c * 64 + t) * 256 + u.grp * 16 + h0) = w; } } }
    }
};
struct EpiGlu { static constexpr bool PERM = true; const bf16_t* ys5; bf16_t* mixed; const float* bias;
    __device__ __forceinline__ void operator()(const f32x4 (&acc)[2][2][4][2], const GUnit& u, int wr, int wc, int fr, int fq) const {
        const int row0 = u.pm * 256 + wr * 64 + fr;
#pragma unroll
        for (int bj = 0; bj < 2; ++bj) { const int n0 = bj * 128 + wc * 32 + 8 * fq;
            const f32x4 b0 = *(const f32x4*)(bias + n0), b1 = *(const f32x4*)(bias + n0 + 4);
#pragma unroll
            for (int ai = 0; ai < 2; ++ai)
#pragma unroll
                for (int m = 0; m < 4; ++m) { const int tok = row0 + ai * 128 + m * 16;
                    const u32x4 yv = *(const u32x4*)(ys5 + (size_t)tok * 256 + n0);
                    const f32x4 v0 = acc[ai][bj][m][0] + b0, v1 = acc[ai][bj][m][1] + b1;
                    float o[8];
                    o[0] = bf2f(yv.x & 0xffffu) * sigmoidf_(v0[0]); o[1] = bf2f(yv.x >> 16) * sigmoidf_(v0[1]); o[2] = bf2f(yv.y & 0xffffu) * sigmoidf_(v0[2]); o[3] = bf2f(yv.y >> 16) * sigmoidf_(v0[3]);
                    o[4] = bf2f(yv.z & 0xffffu) * sigmoidf_(v1[0]); o[5] = bf2f(yv.z >> 16) * sigmoidf_(v1[1]); o[6] = bf2f(yv.w & 0xffffu) * sigmoidf_(v1[2]); o[7] = bf2f(yv.w >> 16) * sigmoidf_(v1[3]);
                    u32x4 w; w.x = cvt_pk_bf16(o[0], o[1]); w.y = cvt_pk_bf16(o[2], o[3]); w.z = cvt_pk_bf16(o[4], o[5]); w.w = cvt_pk_bf16(o[6], o[7]);
                    *(u32x4*)(mixed + (size_t)tok * 1024 + 768 + n0) = w; asm volatile("" ::: "memory"); } }
    }
};
struct EpiF32 { static constexpr bool PERM = false; float* C; int ldc;
    __device__ __forceinline__ void operator()(const f32x4 (&acc)[2][2][4][2], const GUnit& u, int wr, int wc, int fr, int fq) const {
        const int row0 = u.pm * 256 + wr * 64 + fr, col0 = u.pn * 256 + wc * 32 + 4 * fq;
#pragma unroll
        for (int ai = 0; ai < 2; ++ai)
#pragma unroll
            for (int m = 0; m < 4; ++m) { float* rowp = C + (size_t)(row0 + ai * 128 + m * 16) * ldc + col0;
#pragma unroll
                for (int bj = 0; bj < 2; ++bj)
#pragma unroll
                    for (int n = 0; n < 2; ++n) *(f32x4*)(rowp + bj * 128 + n * 16) = acc[ai][bj][m][n]; }
    }
};
struct EpiBf16 { static constexpr bool PERM = true; bf16_t* C; int ldc;
    __device__ __forceinline__ void operator()(const f32x4 (&acc)[2][2][4][2], const GUnit& u, int wr, int wc, int fr, int fq) const {
        const int row0 = u.pm * 256 + wr * 64 + fr, col0 = u.pn * 256 + wc * 32 + 8 * fq;
#pragma unroll
        for (int ai = 0; ai < 2; ++ai)
#pragma unroll
            for (int m = 0; m < 4; ++m) { bf16_t* rowp = C + (size_t)(row0 + ai * 128 + m * 16) * ldc + col0;
#pragma unroll
                for (int bj = 0; bj < 2; ++bj) { const f32x4 v0 = acc[ai][bj][m][0], v1 = acc[ai][bj][m][1];
                    u32x4 w; w.x = cvt_pk_bf16(v0[0], v0[1]); w.y = cvt_pk_bf16(v0[2], v0[3]); w.z = cvt_pk_bf16(v1[0], v1[1]); w.w = cvt_pk_bf16(v1[2], v1[3]);
                    *(u32x4*)(rowp + bj * 128) = w; } }
    }
};
constexpr float WUP_SCALE = 32.0f, WDN_SCALE = 64.0f;
struct EpiUp { static constexpr bool PERM = true; unsigned char* act; const float* bup;
    __device__ __forceinline__ void operator()(const f32x4 (&acc)[2][2][4][2], const GUnit& u, int wr, int wc, int fr, int fq) const {
        const int row0 = u.pm * 256 + wr * 64 + fr, jj0 = wc * 32 + 8 * fq;
        const float* bg = bup + (size_t)u.grp * 2048 + u.pn * 128 + jj0;
        const f32x4 g0 = *(const f32x4*)bg, g1 = *(const f32x4*)(bg + 4), l0 = *(const f32x4*)(bg + 1024), l1 = *(const f32x4*)(bg + 1028);
#pragma unroll
        for (int ai = 0; ai < 2; ++ai)
#pragma unroll
            for (int m = 0; m < 4; ++m) { const int slot = row0 + ai * 128 + m * 16;
                const f32x4 xg0 = acc[ai][0][m][0] * (1.0f / WUP_SCALE) + g0, xg1 = acc[ai][0][m][1] * (1.0f / WUP_SCALE) + g1, xl0 = acc[ai][1][m][0] * (1.0f / WUP_SCALE) + l0, xl1 = acc[ai][1][m][1] * (1.0f / WUP_SCALE) + l1;
                float o[8];
#pragma unroll
                for (int j = 0; j < 4; ++j) { const float a = fminf(xg0[j], 7.0f), b = fminf(fmaxf(xl0[j], -7.0f), 7.0f); o[j] = a * sigmoidf_(1.702f * a) * (b + 1.0f);
                                              const float c = fminf(xg1[j], 7.0f), d = fminf(fmaxf(xl1[j], -7.0f), 7.0f); o[4 + j] = c * sigmoidf_(1.702f * c) * (d + 1.0f); }
                u32x2 w; w.x = pk4_fp8(o[0], o[1], o[2], o[3]); w.y = pk4_fp8(o[4], o[5], o[6], o[7]);
                *(u32x2*)(act + (size_t)slot * 1024 + u.pn * 128 + jj0) = w; }
    }
};
struct EpiDown { static constexpr bool PERM = true; bf16_t* yv; const float* bdn;
    __device__ __forceinline__ void operator()(const f32x4 (&acc)[2][2][4][2], const GUnit& u, int wr, int wc, int fr, int fq) const {
        const int row0 = u.pm * 256 + wr * 64 + fr;
#pragma unroll
        for (int bj = 0; bj < 2; ++bj) { const int col = u.pn * 256 + bj * 128 + wc * 32 + 8 * fq;
            const f32x4 b0 = *(const f32x4*)(bdn + (size_t)u.grp * 1024 + col), b1 = *(const f32x4*)(bdn + (size_t)u.grp * 1024 + col + 4);
#pragma unroll
            for (int ai = 0; ai < 2; ++ai)
#pragma unroll
                for (int m = 0; m < 4; ++m) { const int slot = row0 + ai * 128 + m * 16;
                    const f32x4 v0 = acc[ai][bj][m][0] * (1.0f / WDN_SCALE) + b0, v1 = acc[ai][bj][m][1] * (1.0f / WDN_SCALE) + b1;
                    u32x4 w; w.x = cvt_pk_bf16(v0[0], v0[1]); w.y = cvt_pk_bf16(v0[2], v0[3]); w.z = cvt_pk_bf16(v1[0], v1[1]); w.w = cvt_pk_bf16(v1[2], v1[3]);
                    *(u32x4*)(yv + (size_t)slot * 1024 + col) = w; } }
    }
};

__device__ __forceinline__ bf16x8 frag_lds(const LAS unsigned char* base, int row, int pitch_bytes, int k0, int lane) {
    return *(const LAS bf16x8*)(base + (row + (lane & 15)) * pitch_bytes + (k0 + 8 * (lane >> 4)) * 2);
}
__device__ __forceinline__ bf16x8 frag_glb(const bf16_t* base, size_t row, int pitch_elems, int k0, int lane) {
    return *(const bf16x8*)(base + (row + (lane & 15)) * (size_t)pitch_elems + k0 + 8 * (lane >> 4));
}
#define MFMA16(x, y, acc) __builtin_amdgcn_mfma_f32_16x16x32_bf16((x), (y), (acc), 0, 0, 0)

__device__ __forceinline__ void tr_item(const float* W, int ldw, int k0, int n0, bf16_t* dst, int r0, int ldd, LAS float* scr, int lane) {
    float wv[32];
#pragma unroll
    for (int i = 0; i < 32; ++i) wv[i] = W[(size_t)(k0 + 2 * i + (lane >> 5)) * ldw + n0 + (lane & 31)];
#pragma unroll
    for (int i = 0; i < 32; ++i) scr[(2 * i + (lane >> 5)) * 33 + (lane & 31)] = wv[i];
    asm volatile("s_waitcnt lgkmcnt(0)" ::: "memory");
    const int c = lane & 7;
#pragma unroll
    for (int j = 0; j < 4; ++j) { const int n = (lane >> 3) + 8 * j; const LAS float* s = scr + (8 * c) * 33 + n;
        u32x4 o; o.x = pk2(s[0 * 33], s[1 * 33]); o.y = pk2(s[2 * 33], s[3 * 33]); o.z = pk2(s[4 * 33], s[5 * 33]); o.w = pk2(s[6 * 33], s[7 * 33]);
        *(u32x4*)(dst + (size_t)(r0 + n) * ldd + k0 + 8 * c) = o; }
    asm volatile("s_waitcnt lgkmcnt(0)" ::: "memory");
}

__device__ __forceinline__ void tr_item_fp8(const float* W, int ldw, int k0, int n0, unsigned char* dst, int r0, int ldd, float scale, LAS float* scr, int lane) {
    float wv[32];
#pragma unroll
    for (int i = 0; i < 32; ++i) wv[i] = W[(size_t)(k0 + 2 * i + (lane >> 5)) * ldw + n0 + (lane & 31)];
#pragma unroll
    for (int i = 0; i < 32; ++i) scr[(2 * i + (lane >> 5)) * 33 + (lane & 31)] = wv[i] * scale;
    asm volatile("s_waitcnt lgkmcnt(0)" ::: "memory");
#pragma unroll
    for (int j = 0; j < 2; ++j) { const int idx = lane + 64 * j, n = idx >> 2, c = idx & 3; const LAS float* s = scr + (16 * c) * 33 + n;
        u32x4 o; o.x = pk4_fp8(s[0 * 33], s[1 * 33], s[2 * 33], s[3 * 33]); o.y = pk4_fp8(s[4 * 33], s[5 * 33], s[6 * 33], s[7 * 33]);
        o.z = pk4_fp8(s[8 * 33], s[9 * 33], s[10 * 33], s[11 * 33]); o.w = pk4_fp8(s[12 * 33], s[13 * 33], s[14 * 33], s[15 * 33]);
        *(u32x4*)(dst + (size_t)(r0 + n) * ldd + k0 + 16 * c) = o; }
    asm volatile("s_waitcnt lgkmcnt(0)" ::: "memory");
}
__device__ __forceinline__ void ph0_prologue(const Frame& F0, CArgsP A) {
    Frame F = F0; F.tid = opq(F0.tid); F.lane = F.tid & 63; F.wave = __builtin_amdgcn_readfirstlane(F.tid >> 6); F.ws = opq_p(F0.ws);
    unsigned char* ws = F.ws;
    {
        LAS float* sc = (LAS float*)F.lds;
        LAS float* part = sc + 640;
        const float* cvec = A->in[1]; const float* cctx = A->in[3]; const float* wmod = A->in[4];
        float* modp = (float*)(ws + WS_MODP);
        for (int u = F.bid; u < 768; u += F.G) {
            const int l = u / 192, r = u % 192, cb = r >> 3, ks = r & 7;
            for (int i = F.tid; i < 640; i += NTHR) { const int v = i >> 7, kk = i & 127; const float x = v < 4 ? cvec[v * 1024 + ks * 128 + kk] : cctx[ks * 128 + kk]; sc[i] = siluf_(x); }
            __syncthreads();
            const int col = cb * 256 + (F.tid & 255), kh = F.tid >> 8;
            float a0 = 0.f, a1 = 0.f, a2 = 0.f, a3 = 0.f, a4 = 0.f;
            const float* wp = wmod + ((size_t)l * 1024 + ks * 128 + kh * 64) * 6144 + col;
#pragma unroll 8
            for (int kk = 0; kk < 64; ++kk) { const float w = wp[(size_t)kk * 6144]; const int sk = kh * 64 + kk;
                a0 += sc[sk] * w; a1 += sc[128 + sk] * w; a2 += sc[256 + sk] * w; a3 += sc[384 + sk] * w; a4 += sc[512 + sk] * w; }
            if (kh == 1) { const int c = F.tid & 255; part[c] = a0; part[256 + c] = a1; part[512 + c] = a2; part[768 + c] = a3; part[1024 + c] = a4; }
            __syncthreads();
            if (kh == 0) { const int c = F.tid & 255; float* o = modp + ((size_t)(ks * 4 + l) * 5) * 6144 + col;
                o[0] = a0 + part[c]; o[6144] = a1 + part[256 + c]; o[2 * 6144] = a2 + part[512 + c]; o[3 * 6144] = a3 + part[768 + c]; o[4 * 6144] = a4 + part[1024 + c]; }
            __syncthreads();
        }
    }
    {
        LAS float* scr = (LAS float*)(F.lds + F.wave * 8704);
        const int gw = F.bid * NWAVES + F.wave, NGW = F.G * NWAVES;
        constexpr int I_IN = 4 * 16 * 73, I_OUT = 4 * 16 * 32, I_UP = 128 * 16 * 64, I_DN = 128 * 16 * 32, I_GLU = 4 * 4 * 8;
        constexpr int NITEMS = I_IN + I_OUT + I_UP + I_DN + I_GLU;
        for (int it = gw; it < NITEMS; it += NGW) {
            int r = it;
            if (r < I_IN) { const int l = r / 1168, q = r % 1168, kb = q / 73, nb = q % 73, n0 = 32 * nb;
                const int r0 = nb < 64 ? n0 : (nb == 64 ? 2304 : 2048 + (n0 - 2080));
                tr_item(A->in[6] + (size_t)l * 1024 * NIN, NIN, 64 * kb, n0, (bf16_t*)(ws + WS_WIN) + (size_t)l * NINP * 1024, r0, 1024, scr, F.lane); continue; }
            r -= I_IN;
            if (r < I_OUT) { const int l = r / 512, q = r % 512, kb = q / 32, nb = q % 32;
                tr_item(A->in[24] + (size_t)l * 1024 * 1024, 1024, 64 * kb, 32 * nb, (bf16_t*)(ws + WS_WOUT) + (size_t)l * 1024 * 1024, 32 * nb, 1024, scr, F.lane); continue; }
            r -= I_OUT;
            if (r < I_UP) { const int le = r / 1024, q = r % 1024, kb = q / 64, nb = q % 64, n0 = 32 * nb, half = n0 >> 10, within = n0 & 1023, ct = within >> 7, jj0 = within & 127;
                tr_item_fp8(A->in[29] + (size_t)le * 1024 * 2048, 2048, 64 * kb, n0, (unsigned char*)(ws + WS_WUP) + (size_t)le * 2048 * 1024, 256 * ct + 128 * half + jj0, 1024, WUP_SCALE, scr, F.lane); continue; }
            r -= I_UP;
            if (r < I_DN) { const int le = r / 512, q = r % 512, kb = q / 32, nb = q % 32;
                tr_item_fp8(A->in[31] + (size_t)le * 1024 * 1024, 1024, 64 * kb, 32 * nb, (unsigned char*)(ws + WS_WDN) + (size_t)le * 1024 * 1024, 32 * nb, 1024, WDN_SCALE, scr, F.lane); continue; }
            r -= I_DN;
            { const int l = r / 32, q = r % 32, kb = q / 8, nb = q % 8;
                tr_item(A->in[22] + (size_t)l * 256 * 256, 256, 64 * kb, 32 * nb, (bf16_t*)(ws + WS_GLUT) + (size_t)l * 256 * 256, 32 * nb, 256, scr, F.lane); }
        }
        const int gt = F.bid * NTHR + F.tid, NGT = F.G * NTHR;
        for (int i = gt; i < 4 * 224 * 128; i += NGT) { const int l = i / (224 * 128), q = i % (224 * 128);
            *(u32x4*)((bf16_t*)(ws + WS_WIN) + ((size_t)l * NINP + 2336) * 1024 + (size_t)q * 8) = (u32x4){0u, 0u, 0u, 0u}; }
        { const float* rw = A->in[27]; float* wrt = (float*)(ws + WS_WRT);
            for (int i = gt; i < 4 * D * NEXP; i += NGT) { const int l = i >> 15, q = i & 32767, e = q >> 10, k = q & 1023; wrt[i] = rw[(size_t)l * 32768 + k * 32 + e]; } }
        const float* sw = A->in[9]; bf16_t* swo = (bf16_t*)(ws + WS_SGUW);
        for (int i = gt; i < 4 * 4 * 128 * 128 / 4; i += NGT) { const f32x4 v = *(const f32x4*)(sw + (size_t)i * 4); u32x2 o; o.x = pk2(v[0], v[1]); o.y = pk2(v[2], v[3]); *(u32x2*)(swo + (size_t)i * 4) = o; }
    }
    __syncthreads();
    {
        LAS f32x2* LP = (LAS f32x2*)F.lds;
        LAS f32x2* BB = LP + 2 * 65 * 64;
        LAS f32x2* CC = BB + 2 * 64 * 16;
        const float* lam_re = A->in[14]; const float* lam_im = A->in[15]; const float* log_dt = A->in[16];
        const float* b_re = A->in[17]; const float* b_im = A->in[18]; const float* c_re = A->in[19]; const float* c_im = A->in[20];
        for (int uq = F.bid; uq < 256; uq += F.G) {
            const int u = uq >> 2, qd = uq & 3, l = u >> 4, g = u & 15;
            for (int i = F.tid; i < 2 * 65 * 64; i += NTHR) { const int z = i / (65 * 64), n = (i / 64) % 65, p = i & 63;
                const int idx = ((l * 2 + z) * 16 + g) * 64 + p; const double dt = exp((double)log_dt[(l * 2 + z) * 16 + g]);
                const double mag = exp((double)lam_re[idx] * dt * n), ang = (double)lam_im[idx] * dt * n; double s, c; sincos(ang, &s, &c);
                LP[i] = (f32x2){(float)(mag * c), (float)(mag * s)};
                if (n == 64 && qd == 0) *(f32x2*)((float*)(ws + WS_LB64) + (size_t)idx * 2) = (f32x2){(float)(mag * c), (float)(mag * s)}; }
            for (int i = F.tid; i < 2 * 64 * 16; i += NTHR) { const int z = i >> 10, p = (i >> 4) & 63, h = i & 15;
                const int idx = ((l * 2 + z) * 16 + g) * 64 + p; const double dt = exp((double)log_dt[(l * 2 + z) * 16 + g]);
                const double lr = lam_re[idx], li = lam_im[idx]; const double mag = exp(lr * dt), ang = li * dt; double s, c; sincos(ang, &s, &c);
                const double nr = mag * c - 1.0, ni = mag * s, den = lr * lr + li * li;
                const double qr = (nr * lr + ni * li) / den, qi = (ni * lr - nr * li) / den;
                const double br = b_re[(size_t)idx * 16 + h], bi = b_im[(size_t)idx * 16 + h];
                BB[i] = (f32x2){(float)(qr * br - qi * bi), (float)(qr * bi + qi * br)}; }
            for (int i = F.tid; i < 2 * 16 * 64; i += NTHR) { const int z = i >> 10, h = (i >> 6) & 15, p = i & 63;
                const size_t idx = ((size_t)((l * 2 + z) * 16 + g) * 16 + h) * 64 + p; CC[i] = (f32x2){c_re[idx], c_im[idx]}; }
            __syncthreads();
            float* KT = (float*)(ws + WS_KTAB) + (size_t)u * 32768;
            for (int oo = F.tid; oo < 8192; oo += NTHR) { const int z = oo >> 12, tau = qd * 16 + ((oo >> 8) & 15), h = (oo >> 4) & 15, h2 = oo & 15; float acc = 0.f;
                for (int p = 0; p < 64; ++p) { const f32x2 c = CC[(z * 16 + h) * 64 + p], w = LP[(z * 65 + tau) * 64 + p], b = BB[(z * 64 + p) * 16 + h2];
                    const float cwr = c.x * w.x - c.y * w.y, cwi = c.x * w.y + c.y * w.x; acc += cwr * b.x - cwi * b.y; }
                KT[((z * 64 + tau) * 16 + h) * 16 + h2] = acc; }
            bf16_t* Mo = (bf16_t*)(ws + WS_S5M) + (size_t)u * 1024 * S5K;
            for (int it = F.tid; it < 256 * 32; it += NTHR) { const int row = qd * 256 + (it >> 5), cv = 128 + (it & 31), t = row >> 4, h = row & 15; float v[8];
                const int idx0 = (cv - 128) * 8, z = idx0 >> 7, p0 = (idx0 & 127) >> 1, n = z == 0 ? t + 1 : 64 - t;
#pragma unroll
                for (int i = 0; i < 8; ++i) { const int p = p0 + (i >> 1); const f32x2 c = CC[(z * 16 + h) * 64 + p], w = LP[(z * 65 + n) * 64 + p];
                    v[i] = (i & 1) ? -(c.x * w.y + c.y * w.x) : (c.x * w.x - c.y * w.y); }
                u32x4 o; o.x = pk2(v[0], v[1]); o.y = pk2(v[2], v[3]); o.z = pk2(v[4], v[5]); o.w = pk2(v[6], v[7]);
                *(u32x4*)(Mo + (size_t)row * S5K + cv * 8) = o; }
            bf16_t* Fo = (bf16_t*)(ws + WS_S5F) + (size_t)u * 256 * 1024;
            for (int it = F.tid; it < 64 * 128; it += NTHR) { const int r = qd * 64 + (it >> 7), cv = it & 127, z = r >> 7, p = (r & 127) >> 1, ri = r & 1, s = cv >> 1, h0 = (cv & 1) * 8, m = z == 0 ? 63 - s : s;
                const f32x2 w = LP[(z * 65 + m) * 64 + p]; float v[8];
#pragma unroll
                for (int i = 0; i < 8; ++i) { const f32x2 b = BB[(z * 64 + p) * 16 + h0 + i]; v[i] = ri ? (w.x * b.y + w.y * b.x) : (w.x * b.x - w.y * b.y); }
                u32x4 o; o.x = pk2(v[0], v[1]); o.y = pk2(v[2], v[3]); o.z = pk2(v[4], v[5]); o.w = pk2(v[6], v[7]);
                *(u32x4*)(Fo + (size_t)r * 1024 + cv * 8) = o; }
            __syncthreads();
        }
    }
}

__device__ __forceinline__ void ph1_mod(const Frame& F0, CArgsP A) {
    Frame F = F0; F.tid = opq(F0.tid); F.lane = F.tid & 63; F.wave = __builtin_amdgcn_readfirstlane(F.tid >> 6); F.ws = opq_p(F0.ws);
    const float* modp = (const float*)(F.ws + WS_MODP); float* mod = (float*)(F.ws + WS_MOD); const float* bmod = A->in[5];
    for (int i = F.bid * NTHR + F.tid; i < 4 * 5 * 6144; i += F.G * NTHR) { const int l = i / 30720, j = i % 6144; float s = bmod[l * 6144 + j];
#pragma unroll
        for (int ks = 0; ks < 8; ++ks) s += modp[(size_t)ks * 122880 + i];
        mod[i] = s; }
    const float* dsk = A->in[21];
    for (int it = F.bid * NTHR + F.tid; it < 64 * 1024 * 128; it += F.G * NTHR) { const int u = it >> 17, r = it & 131071, row = r >> 7, cv = r & 127, t = row >> 4, h = row & 15, s = cv >> 1, h0 = (cv & 1) * 8;
        const float* KT = (const float*)(F.ws + WS_KTAB) + (size_t)u * 32768; float v[8];
        if (s < t) { const f32x4 a = *(const f32x4*)(KT + ((0 * 64 + (t - s)) * 16 + h) * 16 + h0), b = *(const f32x4*)(KT + ((0 * 64 + (t - s)) * 16 + h) * 16 + h0 + 4);
            v[0] = a[0]; v[1] = a[1]; v[2] = a[2]; v[3] = a[3]; v[4] = b[0]; v[5] = b[1]; v[6] = b[2]; v[7] = b[3]; }
        else if (s > t) { const f32x4 a = *(const f32x4*)(KT + ((1 * 64 + (s - t)) * 16 + h) * 16 + h0), b = *(const f32x4*)(KT + ((1 * 64 + (s - t)) * 16 + h) * 16 + h0 + 4);
            v[0] = a[0]; v[1] = a[1]; v[2] = a[2]; v[3] = a[3]; v[4] = b[0]; v[5] = b[1]; v[6] = b[2]; v[7] = b[3]; }
        else { const float* k0 = KT + ((0 * 64 + 0) * 16 + h) * 16 + h0; const float* k1 = KT + ((1 * 64 + 0) * 16 + h) * 16 + h0; const float dd = dsk[u * 16 + h];
#pragma unroll
            for (int i = 0; i < 8; ++i) v[i] = k0[i] + k1[i] + ((h0 + i == h) ? dd : 0.f); }
        u32x4 o; o.x = pk2(v[0], v[1]); o.y = pk2(v[2], v[3]); o.z = pk2(v[4], v[5]); o.w = pk2(v[6], v[7]);
        *(u32x4*)((bf16_t*)(F.ws + WS_S5M) + ((size_t)u * 1024 + row) * S5K + cv * 8) = o; }
}
__device__ __forceinline__ void ph2_init(const Frame& F0, CArgsP A) {
    Frame F = F0; F.tid = opq(F0.tid); F.lane = F.tid & 63; F.wave = __builtin_amdgcn_readfirstlane(F.tid >> 6); F.ws = opq_p(F0.ws);
    const float* mod = (const float*)(F.ws + WS_MOD); float* X = (float*)(F.ws + WS_X); bf16_t* H = (bf16_t*)(F.ws + WS_H);
    for (int tk = F.bid * NWAVES + F.wave; tk < T; tk += F.G * NWAVES) {
        const float* src = tk < TLAT ? A->in[0] + (size_t)tk * D : A->in[2] + (size_t)(tk - TLAT) * D;
        const float* mv = mod + (size_t)tok_vec(tk) * 6144;
#pragma unroll
        for (int j = 0; j < 4; ++j) { const int c = 4 * F.lane + 256 * j; const f32x4 x = *(const f32x4*)(src + c), sh = *(const f32x4*)(mv + c), sc = *(const f32x4*)(mv + 1024 + c);
            *(f32x4*)(X + (size_t)tk * D + c) = x; const f32x4 h = x * (sc + 1.0f) + sh;
            u32x2 o; o.x = pk2(h[0], h[1]); o.y = pk2(h[2], h[3]); *(u32x2*)(H + (size_t)tk * D + c) = o; }
    }
}

template <int Z> __device__ __forceinline__ void gla_cols(const LAS float* GLs, const LAS unsigned char* Qs, const LAS unsigned char* Ks, LAS unsigned char* KTrow, const float (&gu)[16], float gb,
                                                          bf16_t* QHp, bf16_t* KNp, float& tot) {
    float b = 0.f;
    for (int j = 0; j < 8; ++j) { const int tg = Z ? 7 - j : j; unsigned w[4] = {0u, 0u, 0u, 0u};
#pragma unroll
        for (int tt = 0; tt < 8; ++tt) { const int ti = Z ? 7 - tt : tt, t = tg * 8 + ti;
            float s = gb;
#pragma unroll
            for (int r = 0; r < 16; ++r) s += GLs[t * 32 + Z * 16 + r] * gu[r];
            b += logsigmoidf_(s) * (1.0f / 16.0f);
            const float e = __expf(b), ri = rcpf(e);
            const float qv = bf2f(*(const LAS unsigned short*)(Qs + t * 528)) * 0.125f, kv = bf2f(*(const LAS unsigned short*)(Ks + t * 528));
            const unsigned kn = f2bf(kv * ri);
            QHp[(size_t)t * 512] = (bf16_t)f2bf(qv * e); KNp[(size_t)t * 256] = (bf16_t)kn;
            w[ti >> 1] |= (ti & 1) ? (kn << 16) : kn; }
        *(LAS u32x4*)(KTrow + tg * 16) = (u32x4){w[0], w[1], w[2], w[3]}; }
    tot = b;
}
__device__ __forceinline__ void gla_local(const Frame& F0, CArgsP A, int l) {
    Frame F = F0; F.tid = opq(F0.tid); F.lane = F.tid & 63; F.wave = __builtin_amdgcn_readfirstlane(F.tid >> 6); F.ws = opq_p(F0.ws);
    unsigned char* ws = F.ws;
    const bf16_t* proj = (const bf16_t*)(ws + WS_PROJ); const float* gl = (const float*)(ws + WS_GL);
    bf16_t* KN = (bf16_t*)(ws + WS_KS); bf16_t* QH = (bf16_t*)(ws + WS_QH); const bf16_t* VTg = (const bf16_t*)(ws + WS_VT);
    float* glast = (float*)(ws + WS_GLAST); float* gdec = (float*)(ws + WS_GDEC);
    LAS float* GLs = (LAS float*)F.lds;
    LAS unsigned char* KTl = F.lds + 8192;
    LAS unsigned char* Qs = F.lds + 81920;
    LAS unsigned char* Ks = Qs + 64 * 528;
    LAS float* DEC = (LAS float*)(Ks + 64 * 528);
    const int z = F.tid >> 8, col = F.tid & 255, hh = col >> 6, dd = col & 63;
    float gu[16];
#pragma unroll
    for (int r = 0; r < 16; ++r) gu[r] = A->in[11][(((size_t)l * 2 + z) * 16 + r) * 256 + col];
    const float gb = A->in[12][((size_t)l * 2 + z) * 256 + col];
    for (int ch = F.bid; ch < NCH; ch += F.G) {
        const int tk0 = ch * 64;
        bf16x8 yfp[2][2][4];
#pragma unroll
        for (int eh = 0; eh < 2; ++eh)
#pragma unroll
            for (int ks = 0; ks < 2; ++ks)
#pragma unroll
                for (int b = 0; b < 4; ++b) yfp[eh][ks][b] = frag_glb(VTg, ((size_t)ch * 4 + (F.wave >> 1)) * 128 + eh * 64 + b * 16, 64, ks * 32, F.lane);
        *(LAS f32x4*)(GLs + 4 * F.tid) = *(const f32x4*)(gl + (size_t)tk0 * 32 + 4 * F.tid);
#pragma unroll
        for (int i = 0; i < 4; ++i) { const int idx = F.tid + NTHR * i, row = idx >> 5, c16 = idx & 31;
            *(LAS u32x4*)(Qs + row * 528 + c16 * 16) = *(const u32x4*)(proj + (size_t)(tk0 + row) * PROJW + 512 + c16 * 8);
            *(LAS u32x4*)(Ks + row * 528 + c16 * 16) = *(const u32x4*)(proj + (size_t)(tk0 + row) * PROJW + 768 + c16 * 8); }
        __syncthreads();
        float tot;
        bf16_t* QHp = QH + ((size_t)tk0 * 4 + hh) * 128 + z * 64 + dd; bf16_t* KNp = KN + ((size_t)z * T + tk0) * 256 + col;
        if (z == 0) gla_cols<0>(GLs, Qs + col * 2, Ks + col * 2, KTl + (0 * 256 + col) * 144, gu, gb, QHp, KNp, tot);
        else        gla_cols<1>(GLs, Qs + col * 2, Ks + col * 2, KTl + (1 * 256 + col) * 144, gu, gb, QHp, KNp, tot);
        const float dec = __expf(tot);
        DEC[z * 256 + col] = dec; gdec[((size_t)ch * 2 + z) * 256 + col] = dec;
        __syncthreads();
        {
            const int wz = F.wave & 1, wh = F.wave >> 1, q = F.lane >> 4, c = F.lane & 15;
#pragma unroll
            for (int eh = 0; eh < 2; ++eh) {
                f32x4 acc[4][4];
#pragma unroll
                for (int a = 0; a < 4; ++a)
#pragma unroll
                    for (int b = 0; b < 4; ++b) acc[a][b] = (f32x4){0.f, 0.f, 0.f, 0.f};
#pragma unroll
                for (int ks = 0; ks < 2; ++ks) { bf16x8 xf[4];
#pragma unroll
                    for (int a = 0; a < 4; ++a) xf[a] = frag_lds(KTl, wz * 256 + wh * 64 + a * 16, 144, ks * 32, F.lane);
#pragma unroll
                    for (int a = 0; a < 4; ++a)
#pragma unroll
                        for (int b = 0; b < 4; ++b) acc[a][b] = MFMA16(xf[a], yfp[eh][ks][b], acc[a][b]); }
#pragma unroll
                for (int a = 0; a < 4; ++a) { const int d0 = a * 16 + 4 * q; const f32x4 dv = *(const LAS f32x4*)(DEC + wz * 256 + wh * 64 + d0);
#pragma unroll
                    for (int b = 0; b < 4; ++b) { const int e = eh * 64 + b * 16 + c;
                        *(f32x4*)(glast + (((size_t)ch * 4 + wh) * 128 + e) * 128 + wz * 64 + d0) = acc[a][b] * dv; } }
            }
        }
        __syncthreads();
    }
}

__device__ __forceinline__ void sgu_phase(const Frame& F0, CArgsP A, int l) {
    Frame F = F0; F.tid = opq(F0.tid); F.lane = F.tid & 63; F.wave = __builtin_amdgcn_readfirstlane(F.tid >> 6); F.ws = opq_p(F0.ws);
    unsigned char* ws = F.ws;
    const bf16_t* proj = (const bf16_t*)(ws + WS_PROJ); bf16_t* mixed = (bf16_t*)(ws + WS_MIXED); const bf16_t* sw = (const bf16_t*)(ws + WS_SGUW) + (size_t)l * 4 * 128 * 128;
    LAS float* stats = (LAS float*)F.lds;
    LAS unsigned char* VL = F.lds + 1024;
    const float* lng = A->in[7] + l * 256; const float* lnb = A->in[8] + l * 256; const float* bs = A->in[10] + (size_t)l * 4 * 128;
    for (int uu = (F.G - 1 - F.bid); uu < (T / 128) * 4; uu += F.G) {
        const int tk0 = (uu >> 2) * 128, h = uu & 3;
        u32x2 wv[16];
#pragma unroll
        for (int i = 0; i < 16; ++i) wv[i] = *(const u32x2*)(proj + (size_t)(tk0 + F.wave * 16 + i) * PROJW + 256 + 4 * F.lane);
        const int ct = F.wave & 3, th = F.wave >> 2, q = F.lane >> 4, c = F.lane & 15;
        bf16x8 yfs[4][4]; u32x2 uws[4]; float bias4[4]; unsigned short tv[16];
#pragma unroll
        for (int ks = 0; ks < 4; ++ks)
#pragma unroll
            for (int b = 0; b < 4; ++b) yfs[ks][b] = frag_glb(sw + (size_t)h * 128 * 128, th * 64 + b * 16, 128, ks * 32, F.lane);
#pragma unroll
        for (int b = 0; b < 4; ++b) { const int t = th * 64 + b * 16 + c; bias4[b] = bs[h * 128 + t]; uws[b] = *(const u32x2*)(proj + (size_t)(tk0 + t) * PROJW + h * 64 + ct * 16 + 4 * q); }
#pragma unroll
        for (int i = 0; i < 16; ++i) tv[i] = proj[(size_t)(tk0 + (F.tid >> 6) * 16 + i) * PROJW + 256 + h * 64 + (F.tid & 63)];
#pragma unroll
        for (int i = 0; i < 16; ++i) { const int t = F.wave * 16 + i; const u32x2 w = wv[i];
            const float a = bf2f(w.x & 0xffffu), b = bf2f(w.x >> 16), c = bf2f(w.y & 0xffffu), d = bf2f(w.y >> 16);
            const float mean = wave_sum((a + b) + (c + d)) * (1.0f / 256.0f); const float da = a - mean, db = b - mean, dc = c - mean, de = d - mean;
            const float var = wave_sum((da * da + db * db) + (dc * dc + de * de)) * (1.0f / 256.0f);
            if (F.lane == 0) { stats[2 * t] = mean; stats[2 * t + 1] = rsqrtf(var + LN_EPS); } }
        __syncthreads();
        {   const int chn = F.tid & 63, sq = F.tid >> 6; const float g = lng[h * 64 + chn], b = lnb[h * 64 + chn];
#pragma unroll
            for (int j = 0; j < 2; ++j) { unsigned w[4];
#pragma unroll
                for (int tt = 0; tt < 8; ++tt) { const int s = sq * 16 + j * 8 + tt; const float v = (bf2f(tv[j * 8 + tt]) - stats[2 * s]) * stats[2 * s + 1] * g + b;
                    if (tt & 1) w[tt >> 1] |= f2bf(v) << 16; else w[tt >> 1] = f2bf(v); }
                *(LAS u32x4*)(VL + chn * 272 + sq * 32 + j * 16) = (u32x4){w[0], w[1], w[2], w[3]}; }
        }
        __syncthreads();
        {   f32x4 acc[4];
#pragma unroll
            for (int b = 0; b < 4; ++b) acc[b] = (f32x4){0.f, 0.f, 0.f, 0.f};
#pragma unroll
            for (int ks = 0; ks < 4; ++ks) { const bf16x8 xf = frag_lds(VL, ct * 16, 272, ks * 32, F.lane);
#pragma unroll
                for (int b = 0; b < 4; ++b) acc[b] = MFMA16(xf, yfs[ks][b], acc[b]); }
#pragma unroll
            for (int b = 0; b < 4; ++b) { const int t = th * 64 + b * 16 + c; const float bias = bias4[b];
                const int ch0 = h * 64 + ct * 16 + 4 * q; const u32x2 uw = uws[b];
                u32x2 o; o.x = pk2(bf2f(uw.x & 0xffffu) * (acc[b][0] + bias), bf2f(uw.x >> 16) * (acc[b][1] + bias));
                o.y = pk2(bf2f(uw.y & 0xffffu) * (acc[b][2] + bias), bf2f(uw.y >> 16) * (acc[b][3] + bias));
                *(u32x2*)(mixed + (size_t)(tk0 + t) * 1024 + ch0) = o; }
        }
        __syncthreads();
    }
}

__device__ __forceinline__ int scan_chunk(int z, int b, int st) {
    return z == 0 ? (st < 4 ? 512 + b * 4 + st : b * 128 + (st - 4)) : (st < 4 ? 512 + b * 4 + (3 - st) : b * 128 + (131 - st));
}
__device__ __forceinline__ void scan_phase(const Frame& F0, CArgsP A, int l) {
    Frame F = F0; F.tid = opq(F0.tid); F.lane = F.tid & 63; F.wave = __builtin_amdgcn_readfirstlane(F.tid >> 6); F.ws = opq_p(F0.ws);
    unsigned char* ws = F.ws;
    const float* glast = (const float*)(ws + WS_GLAST); const float* gdec = (const float*)(ws + WS_GDEC); bf16_t* sprev = (bf16_t*)(ws + WS_SPREV);
    {   const int idx = F.bid * NTHR + F.tid;
        const int b0 = idx >> 16, rem = idx & 65535, h = rem >> 14, dcat = rem & 127, z = dcat >> 6, d = dcat & 63;
        float S0 = 0.f, S1 = 0.f;
        for (int sb = 0; sb < 132; sb += 12) { float ds0[12], dc0[12], ds1[12], dc1[12];
#pragma unroll
            for (int j = 0; j < 12; ++j) { const int c0 = scan_chunk(z, b0, sb + j), c1 = scan_chunk(z, b0 + 2, sb + j);
                ds0[j] = glast[(size_t)c0 * 65536 + rem]; dc0[j] = gdec[((size_t)c0 * 2 + z) * 256 + h * 64 + d];
                ds1[j] = glast[(size_t)c1 * 65536 + rem]; dc1[j] = gdec[((size_t)c1 * 2 + z) * 256 + h * 64 + d]; }
#pragma unroll
            for (int j = 0; j < 12; ++j) { const int c0 = scan_chunk(z, b0, sb + j), c1 = scan_chunk(z, b0 + 2, sb + j);
                sprev[(size_t)c0 * 65536 + rem] = (bf16_t)f2bf(S0); S0 = dc0[j] * S0 + ds0[j];
                sprev[(size_t)c1 * 65536 + rem] = (bf16_t)f2bf(S1); S1 = dc1[j] * S1 + ds1[j]; }
        }
    }
    const float* hloc = (const float*)(ws + WS_HLOC); bf16_t* ucat = (bf16_t*)(ws + WS_UCAT); const float* lb64 = (const float*)(ws + WS_LB64);
    if (F.bid >= F.G - 16) { const int idx = (F.bid - (F.G - 16)) * NTHR + F.tid;
        const int p = idx & 63, z = (idx >> 6) & 1, b = (idx >> 7) & 3, g = idx >> 9;
        const f32x2 lb = *(const f32x2*)(lb64 + ((size_t)((l * 2 + z) * 16 + g) * 64 + p) * 2);
        float hr = 0.f, hi = 0.f;
        for (int sb = 0; sb < 132; sb += 12) { f32x2 hl[12];
#pragma unroll
            for (int j = 0; j < 12; ++j) { const int ch = scan_chunk(z, b, sb + j); hl[j] = *(const f32x2*)(hloc + ((size_t)g * NCHP + ch) * 256 + z * 128 + p * 2); }
#pragma unroll
            for (int j = 0; j < 12; ++j) { const int ch = scan_chunk(z, b, sb + j);
                *(unsigned*)(ucat + ((size_t)g * NCHP + ch) * S5K + 1024 + z * 128 + p * 2) = pk2(hr, hi);
                const float nr = lb.x * hr - lb.y * hi + hl[j].x, ni = lb.x * hi + lb.y * hr + hl[j].y; hr = nr; hi = ni; }
        }
    }
}

__device__ __forceinline__ void gla_out(const Frame& F0, CArgsP A, int l) {
    Frame F = F0; F.tid = opq(F0.tid); F.lane = F.tid & 63; F.wave = __builtin_amdgcn_readfirstlane(F.tid >> 6); F.ws = opq_p(F0.ws);
    unsigned char* ws = F.ws;
    const bf16_t* proj = (const bf16_t*)(ws + WS_PROJ); bf16_t* mixed = (bf16_t*)(ws + WS_MIXED);
    const bf16_t* KN = (const bf16_t*)(ws + WS_KS); const bf16_t* QH = (const bf16_t*)(ws + WS_QH);
    const bf16_t* VTg = (const bf16_t*)(ws + WS_VT); const bf16_t* sprev = (const bf16_t*)(ws + WS_SPREV);
    const float* ng = A->in[13] + (size_t)l * 512;
    LAS unsigned char* VT2 = F.lds;
    LAS unsigned char* SP2 = F.lds + 256 * 144;
    LAS unsigned char* Pw = F.lds + 256 * 144 + 256 * 272 + F.wave * 2304;
    const int q = F.lane >> 4, c = F.lane & 15, sub = F.wave >> 2, tm = F.wave & 3;
    for (int uu = F.bid; uu < NCH * 2; uu += F.G) {
        const int ch = uu >> 1, hp = uu & 1, h = hp * 2 + sub, tk0 = ch * 64, tok = tk0 + tm * 16 + c;
        u32x4 sv[4], sp[8];
        const size_t erow0 = ((size_t)ch * 4 + hp * 2) * 128;
#pragma unroll
        for (int j = 0; j < 4; ++j) { const int idx = F.tid + NTHR * j; sv[j] = *(const u32x4*)(VTg + (erow0 + (idx >> 3)) * 64 + (idx & 7) * 8); }
#pragma unroll
        for (int j = 0; j < 8; ++j) { const int idx = F.tid + NTHR * j; sp[j] = *(const u32x4*)(sprev + (erow0 + (idx >> 4)) * 128 + (idx & 15) * 8); }
        bf16x8 qh[4], kf[4][2], kb[4][2];
#pragma unroll
        for (int j = 0; j < 4; ++j) qh[j] = frag_glb(QH + h * 128, (size_t)tk0 + tm * 16, 512, j * 32, F.lane);
#pragma unroll
        for (int st = 0; st < 4; ++st)
#pragma unroll
            for (int ks = 0; ks < 2; ++ks) { kf[st][ks] = frag_glb(KN + h * 64, (size_t)tk0 + st * 16, 256, ks * 32, F.lane); kb[st][ks] = frag_glb(KN + h * 64, (size_t)T + tk0 + st * 16, 256, ks * 32, F.lane); }
        u32x2 gw[8];
#pragma unroll
        for (int a = 0; a < 8; ++a) gw[a] = *(const u32x2*)(proj + (size_t)tok * PROJW + 1536 + h * 128 + a * 16 + 4 * q);
#pragma unroll
        for (int j = 0; j < 4; ++j) { const int idx = F.tid + NTHR * j; *(LAS u32x4*)(VT2 + (idx >> 3) * 144 + (idx & 7) * 16) = sv[j]; }
#pragma unroll
        for (int j = 0; j < 8; ++j) { const int idx = F.tid + NTHR * j; *(LAS u32x4*)(SP2 + (idx >> 4) * 272 + (idx & 15) * 16) = sp[j]; }
#pragma unroll
        for (int st = 0; st < 4; ++st) {
            f32x4 sf = (f32x4){0.f, 0.f, 0.f, 0.f}, sb = (f32x4){0.f, 0.f, 0.f, 0.f};
#pragma unroll
            for (int ks = 0; ks < 2; ++ks) { sf = MFMA16(kf[st][ks], qh[ks], sf); sb = MFMA16(kb[st][ks], qh[2 + ks], sb); }
            const int t = tm * 16 + c, s0 = st * 16 + 4 * q;
            u32x2 o; o.x = pk2((s0 + 0) <= t ? sf[0] : sb[0], (s0 + 1) <= t ? sf[1] : sb[1]); o.y = pk2((s0 + 2) <= t ? sf[2] : sb[2], (s0 + 3) <= t ? sf[3] : sb[3]);
            *(LAS u32x2*)(Pw + c * 144 + s0 * 2) = o; }
        __syncthreads();
        bf16x8 pf[2];
#pragma unroll
        for (int ks = 0; ks < 2; ++ks) pf[ks] = frag_lds(Pw, 0, 144, ks * 32, F.lane);
        f32x4 acc[8];
#pragma unroll
        for (int a = 0; a < 8; ++a) { acc[a] = (f32x4){0.f, 0.f, 0.f, 0.f};
#pragma unroll
            for (int ks = 0; ks < 2; ++ks) { const bf16x8 vf = frag_lds(VT2, sub * 128 + a * 16, 144, ks * 32, F.lane); acc[a] = MFMA16(vf, pf[ks], acc[a]); }
#pragma unroll
            for (int j = 0; j < 4; ++j) { const bf16x8 sfr = frag_lds(SP2, sub * 128 + a * 16, 272, j * 32, F.lane); acc[a] = MFMA16(sfr, qh[j], acc[a]); } }
        float ss = 0.f;
#pragma unroll
        for (int a = 0; a < 8; ++a) ss += (acc[a][0] * acc[a][0] + acc[a][1] * acc[a][1]) + (acc[a][2] * acc[a][2] + acc[a][3] * acc[a][3]);
        ss += __shfl_xor(ss, 16); ss += __shfl_xor(ss, 32);
        const float rinv = rsqrtf(ss * (1.0f / 128.0f) + LN_EPS);
#pragma unroll
        for (int a = 0; a < 8; ++a) { const int e0 = h * 128 + a * 16 + 4 * q; const f32x4 nv = *(const f32x4*)(ng + e0);
            u32x2 o; o.x = pk2(acc[a][0] * rinv * nv[0] * siluf_(bf2f(gw[a].x & 0xffffu)), acc[a][1] * rinv * nv[1] * siluf_(bf2f(gw[a].x >> 16)));
            o.y = pk2(acc[a][2] * rinv * nv[2] * siluf_(bf2f(gw[a].y & 0xffffu)), acc[a][3] * rinv * nv[3] * siluf_(bf2f(gw[a].y >> 16)));
            *(u32x2*)(mixed + (size_t)tok * 1024 + 256 + e0) = o; }
        __syncthreads();
    }
}

__device__ __forceinline__ float rs32(const float (&pe)[32], int lane) {
    float r16[16], r8[8], r4[4], r2[2], r1;
    { const bool hi = (lane & 32) != 0;
#pragma unroll
        for (int i = 0; i < 16; ++i) { const float mine = hi ? pe[16 + i] : pe[i], oth = hi ? pe[i] : pe[16 + i]; r16[i] = mine + __shfl_xor(oth, 32); } }
    { const bool hi = (lane & 16) != 0;
#pragma unroll
        for (int i = 0; i < 8; ++i) { const float mine = hi ? r16[8 + i] : r16[i], oth = hi ? r16[i] : r16[8 + i]; r8[i] = mine + __shfl_xor(oth, 16); } }
    { const bool hi = (lane & 8) != 0;
#pragma unroll
        for (int i = 0; i < 4; ++i) { const float mine = hi ? r8[4 + i] : r8[i], oth = hi ? r8[i] : r8[4 + i]; r4[i] = mine + __shfl_xor(oth, 8); } }
    { const bool hi = (lane & 4) != 0;
#pragma unroll
        for (int i = 0; i < 2; ++i) { const float mine = hi ? r4[2 + i] : r4[i], oth = hi ? r4[i] : r4[2 + i]; r2[i] = mine + __shfl_xor(oth, 4); } }
    { const bool hi = (lane & 2) != 0; const float mine = hi ? r2[1] : r2[0], oth = hi ? r2[0] : r2[1]; r1 = mine + __shfl_xor(oth, 2); }
    r1 += __shfl_xor(r1, 1);
    return r1;
}
__device__ __forceinline__ void top4_store(float val, int lane, int* topi_row, float* gate_row, volatile LAS int* hist, bool valid) {
    const int mye = lane >> 1; float tv[4]; int te[4];
#pragma unroll
    for (int k = 0; k < 4; ++k) { float mvv = val; int mi = mye;
#pragma unroll
        for (int o = 1; o < 64; o <<= 1) { const float ov = __shfl_xor(mvv, o); const int oi = __shfl_xor(mi, o); if (ov > mvv || (ov == mvv && oi < mi)) { mvv = ov; mi = oi; } }
        tv[k] = mvv; te[k] = mi; if (mye == mi) val = -3.0e38f; }
    const float e1 = __expf(tv[1] - tv[0]), e2 = __expf(tv[2] - tv[0]), e3 = __expf(tv[3] - tv[0]); const float inv = 1.0f / (1.0f + e1 + e2 + e3);
    if (valid) {
        if (lane == 0) { *(int4*)topi_row = make_int4(te[0], te[1], te[2], te[3]); *(f32x4*)gate_row = (f32x4){inv, e1 * inv, e2 * inv, e3 * inv}; }
        if (lane < 4) { const int e = lane == 0 ? te[0] : (lane == 1 ? te[1] : (lane == 2 ? te[2] : te[3])); __hip_atomic_fetch_add((LAS int*)&hist[e], 1, __ATOMIC_RELAXED, __HIP_MEMORY_SCOPE_WORKGROUP); } }
}
__device__ __forceinline__ void ln1_router(const Frame& F0, CArgsP A, int l, int ntok, bool dry = false) {
    Frame F = F0; F.tid = opq(F0.tid); F.lane = F.tid & 63; F.wave = __builtin_amdgcn_readfirstlane(F.tid >> 6); F.ws = opq_p(F0.ws);
    unsigned char* ws = F.ws;
    float* X = (float*)(ws + WS_X); const bf16_t* TMP = (const bf16_t*)(ws + WS_TMP); unsigned char* H8 = (unsigned char*)(ws + WS_QS); const float* mod = (const float*)(ws + WS_MOD) + (size_t)l * 5 * 6144;
    int* topi = (int*)(ws + WS_TOPI); float* gate = (float*)(ws + WS_GATE); int* wgcnt = (int*)(ws + WS_WGCNT);
    const float* lg = A->in[25] + (size_t)(l * 2 + 0) * D; const float* lb = A->in[26] + (size_t)(l * 2 + 0) * D;
    const float* wrt = (const float*)(ws + WS_WRT) + (size_t)l * D * NEXP; const float* rb = A->in[28] + l * NEXP;
    LAS float* WrT = (LAS float*)F.lds;
    volatile LAS int* hist = (volatile LAS int*)(F.CTLW + 32);
    for (int i = F.tid; i < D * NEXP / 4; i += NTHR) *(LAS f32x4*)(WrT + 4 * i) = *(const f32x4*)(wrt + 4 * i);
    if (F.tid < 32) hist[F.tid] = 0;
    __syncthreads();
    const int per = ntok / F.G, t0 = F.bid * per;
    for (int it = 0; it * 16 < per; ++it) {
        int tk[2]; bool valid[2];
#pragma unroll
        for (int k = 0; k < 2; ++k) { const int ti = it * 16 + F.wave * 2 + k; valid[k] = ti < per; tk[k] = t0 + (valid[k] ? ti : per - 1); valid[k] = valid[k] && !dry; }
        f32x4 v[2][4]; float s[2] = {0.f, 0.f};
#pragma unroll
        for (int k = 0; k < 2; ++k) { const float* mv = mod + (size_t)tok_vec(tk[k]) * 6144;
#pragma unroll
            for (int j = 0; j < 4; ++j) { const int c = 4 * F.lane + 256 * j; const f32x4 x = *(const f32x4*)(X + (size_t)tk[k] * D + c), g1 = *(const f32x4*)(mv + 2048 + c); const u32x2 tw = *(const u32x2*)(TMP + (size_t)tk[k] * D + c);
                const f32x4 tp = (f32x4){bf2f(tw.x & 0xffffu), bf2f(tw.x >> 16), bf2f(tw.y & 0xffffu), bf2f(tw.y >> 16)};
                v[k][j] = x * DN_ALPHA + g1 * tp; s[k] += (v[k][j][0] + v[k][j][1]) + (v[k][j][2] + v[k][j][3]); } }
        float mean[2], s2[2] = {0.f, 0.f}, rstd[2];
#pragma unroll
        for (int k = 0; k < 2; ++k) mean[k] = wave_sum(s[k]) * (1.0f / D);
#pragma unroll
        for (int k = 0; k < 2; ++k)
#pragma unroll
            for (int j = 0; j < 4; ++j) { v[k][j] = v[k][j] - mean[k]; s2[k] += (v[k][j][0] * v[k][j][0] + v[k][j][1] * v[k][j][1]) + (v[k][j][2] * v[k][j][2] + v[k][j][3] * v[k][j][3]); }
#pragma unroll
        for (int k = 0; k < 2; ++k) rstd[k] = rsqrtf(wave_sum(s2[k]) * (1.0f / D) + LN_EPS);
#pragma unroll
        for (int k = 0; k < 2; ++k) { const float* mv = mod + (size_t)tok_vec(tk[k]) * 6144;
#pragma unroll
            for (int j = 0; j < 4; ++j) { const int c = 4 * F.lane + 256 * j; const f32x4 g = *(const f32x4*)(lg + c), b = *(const f32x4*)(lb + c);
                const f32x4 xn = v[k][j] * rstd[k] * g + b;
                const f32x4 sh = *(const f32x4*)(mv + 3072 + c), sc = *(const f32x4*)(mv + 4096 + c); const f32x4 h = xn * (sc + 1.0f) + sh; v[k][j] = h;
                if (valid[k]) { *(f32x4*)(X + (size_t)tk[k] * D + c) = xn; *(unsigned*)(H8 + (size_t)tk[k] * D + c) = pk4_fp8(h[0], h[1], h[2], h[3]); }
                if (dry) asm volatile("" :: "v"(xn[0]), "v"(xn[1]), "v"(xn[2]), "v"(xn[3])); } }
        float pe0[32], pe1[32];
#pragma unroll
        for (int e = 0; e < 32; ++e) { float a0 = 0.f, a1 = 0.f;
#pragma unroll
            for (int j = 0; j < 4; ++j) { const f32x4 w = *(const LAS f32x4*)(WrT + e * 1024 + 4 * F.lane + 256 * j);
                a0 += (v[0][j][0] * w[0] + v[0][j][1] * w[1]) + (v[0][j][2] * w[2] + v[0][j][3] * w[3]);
                a1 += (v[1][j][0] * w[0] + v[1][j][1] * w[1]) + (v[1][j][2] * w[2] + v[1][j][3] * w[3]); }
            pe0[e] = a0; pe1[e] = a1; }
        const float bias = rb[F.lane >> 1];
        const float l0 = rs32(pe0, F.lane) + bias, l1 = rs32(pe1, F.lane) + bias;
        if (dry) asm volatile("" :: "v"(l0), "v"(l1));
        top4_store(l0, F.lane, topi + (size_t)tk[0] * 4, gate + (size_t)tk[0] * 4, hist, valid[0]);
        top4_store(l1, F.lane, topi + (size_t)tk[1] * 4, gate + (size_t)tk[1] * 4, hist, valid[1]);
    }
    __syncthreads();
    if (F.tid < 32) wgcnt[F.bid * 32 + F.tid] = hist[F.tid];
}

__device__ __forceinline__ void slots_phase(const Frame& F0, int ntok) {
    Frame F = F0; F.tid = opq(F0.tid); F.lane = F.tid & 63; F.wave = __builtin_amdgcn_readfirstlane(F.tid >> 6); F.ws = opq_p(F0.ws);
    unsigned char* ws = F.ws;
    const int* wgcnt = (const int*)(ws + WS_WGCNT); const int* topi = (const int*)(ws + WS_TOPI); int* slot_tok = (int*)(ws + WS_SLOTTOK); int* tok_slot = (int*)(ws + WS_TOKSLOT); int* ecnt = (int*)(ws + WS_ECNT);
    volatile LAS int* tot = (volatile LAS int*)(F.CTLW + 64); volatile LAS int* cur = (volatile LAS int*)(F.CTLW + 96); volatile LAS int* ebase = (volatile LAS int*)(F.CTLW + 128);
    volatile LAS int* ptot = (volatile LAS int*)F.lds; volatile LAS int* pmb = ptot + 512;
    {   const int e = F.tid & 31, part = F.tid >> 5; int t = 0, mb = 0;
#pragma unroll
        for (int j = 0; j < 16; ++j) { const int w = part * 16 + j; const int c = wgcnt[w * 32 + e]; t += c; mb += (w < F.bid) ? c : 0; }
        ptot[F.tid] = t; pmb[F.tid] = mb; }
    __syncthreads();
    if (F.tid < 32) { int t = 0, mb = 0;
#pragma unroll
        for (int j = 0; j < 16; ++j) { t += ptot[j * 32 + F.tid]; mb += pmb[j * 32 + F.tid]; }
        tot[F.tid] = t; cur[F.tid] = mb; }
    __syncthreads();
    if (F.tid == 0) { int p = 0; for (int e = 0; e < 32; ++e) { ebase[e] = p * 256; p += (tot[e] + 255) >> 8; } }
    __syncthreads();
    if (F.tid < 32) { cur[F.tid] += ebase[F.tid]; if (F.bid == 0) ecnt[F.tid] = tot[F.tid]; }
    __syncthreads();
    const int per = ntok / F.G, t0 = F.bid * per;
    for (int i = F.tid; i < per * 4; i += NTHR) { const int tk = t0 + (i >> 2); const int e = topi[(size_t)tk * 4 + (i & 3)];
        const int slot = __hip_atomic_fetch_add((LAS int*)&cur[e], 1, __ATOMIC_RELAXED, __HIP_MEMORY_SCOPE_WORKGROUP); slot_tok[slot] = tk; tok_slot[(size_t)tk * 4 + (i & 3)] = slot; }
    if (F.bid < 32) { const int e = F.bid; const int lo = ebase[e] + tot[e], hi = ebase[e] + (((tot[e] + 255) >> 8) << 8); for (int s = lo + F.tid; s < hi; s += NTHR) slot_tok[s] = 0; }
    __syncthreads();
}
__device__ __forceinline__ void moe_prefix(const Frame& F0) {
    Frame F = F0; F.tid = opq(F0.tid); F.lane = F.tid & 63; F.wave = __builtin_amdgcn_readfirstlane(F.tid >> 6); F.ws = opq_p(F0.ws);
    const int* ecnt = (const int*)(F.ws + WS_ECNT); volatile LAS int* pref = (volatile LAS int*)(F.CTLW + 160);
    __syncthreads();
    if (F.tid == 0) { int p = 0; for (int e = 0; e < 32; ++e) { pref[e] = p; p += (ecnt[e] + 255) >> 8; } pref[32] = p; }
    __syncthreads();
}

__device__ __forceinline__ void combine_ln2(const Frame& F0, CArgsP A, int l, int ntok, bool dry = false) {
    Frame F = F0; F.tid = opq(F0.tid); F.lane = F.tid & 63; F.wave = __builtin_amdgcn_readfirstlane(F.tid >> 6); F.ws = opq_p(F0.ws);
    unsigned char* ws = F.ws;
    float* X = (float*)(ws + WS_X); bf16_t* H = (bf16_t*)(ws + WS_H); const bf16_t* YV = (const bf16_t*)(ws + WS_YV);
    const float* mod = (const float*)(ws + WS_MOD) + (size_t)l * 5 * 6144; const float* modn = (const float*)(ws + WS_MOD) + (size_t)(l + 1 < DEPTH ? l + 1 : l) * 5 * 6144;
    const int* tok_slot = (const int*)(ws + WS_TOKSLOT); const float* gate = (const float*)(ws + WS_GATE);
    const float* lg = A->in[25] + (size_t)(l * 2 + 1) * D; const float* lb = A->in[26] + (size_t)(l * 2 + 1) * D;
    const bool lastl = (l == DEPTH - 1);
    const int stride = F.G * NWAVES;
    for (int tb = F.bid * NWAVES + F.wave; tb < ntok; tb += 2 * stride) {
        int tk[2]; bool valid[2];
#pragma unroll
        for (int k = 0; k < 2; ++k) { const int t = tb + k * stride; valid[k] = t < ntok; tk[k] = valid[k] ? t : tb; valid[k] = valid[k] && !dry; }
        f32x4 v[2][4]; float s[2] = {0.f, 0.f};
#pragma unroll
        for (int k = 0; k < 2; ++k) { const float* mv = mod + (size_t)tok_vec(tk[k]) * 6144;
            const int4 sl = *(const int4*)(tok_slot + (size_t)tk[k] * 4); const f32x4 gt = *(const f32x4*)(gate + (size_t)tk[k] * 4);
#pragma unroll
            for (int j = 0; j < 4; ++j) { const int c = 4 * F.lane + 256 * j;
                const u32x2 y0 = *(const u32x2*)(YV + (size_t)sl.x * 1024 + c), y1 = *(const u32x2*)(YV + (size_t)sl.y * 1024 + c), y2 = *(const u32x2*)(YV + (size_t)sl.z * 1024 + c), y3 = *(const u32x2*)(YV + (size_t)sl.w * 1024 + c);
                f32x4 f;
                f[0] = gt[0] * bf2f(y0.x & 0xffffu) + gt[1] * bf2f(y1.x & 0xffffu) + gt[2] * bf2f(y2.x & 0xffffu) + gt[3] * bf2f(y3.x & 0xffffu);
                f[1] = gt[0] * bf2f(y0.x >> 16) + gt[1] * bf2f(y1.x >> 16) + gt[2] * bf2f(y2.x >> 16) + gt[3] * bf2f(y3.x >> 16);
                f[2] = gt[0] * bf2f(y0.y & 0xffffu) + gt[1] * bf2f(y1.y & 0xffffu) + gt[2] * bf2f(y2.y & 0xffffu) + gt[3] * bf2f(y3.y & 0xffffu);
                f[3] = gt[0] * bf2f(y0.y >> 16) + gt[1] * bf2f(y1.y >> 16) + gt[2] * bf2f(y2.y >> 16) + gt[3] * bf2f(y3.y >> 16);
                const f32x4 x = *(const f32x4*)(X + (size_t)tk[k] * D + c), g2 = *(const f32x4*)(mv + 5120 + c);
                v[k][j] = x * DN_ALPHA + g2 * f; s[k] += (v[k][j][0] + v[k][j][1]) + (v[k][j][2] + v[k][j][3]); } }
        float mean[2], s2[2] = {0.f, 0.f}, rstd[2];
#pragma unroll
        for (int k = 0; k < 2; ++k) mean[k] = wave_sum(s[k]) * (1.0f / D);
#pragma unroll
        for (int k = 0; k < 2; ++k)
#pragma unroll
            for (int j = 0; j < 4; ++j) { v[k][j] = v[k][j] - mean[k]; s2[k] += (v[k][j][0] * v[k][j][0] + v[k][j][1] * v[k][j][1]) + (v[k][j][2] * v[k][j][2] + v[k][j][3] * v[k][j][3]); }
#pragma unroll
        for (int k = 0; k < 2; ++k) rstd[k] = rsqrtf(wave_sum(s2[k]) * (1.0f / D) + LN_EPS);
        if (dry) asm volatile("" :: "v"(rstd[0]), "v"(rstd[1]));
#pragma unroll
        for (int k = 0; k < 2; ++k) { if (!valid[k]) continue; const float* mn = modn + (size_t)tok_vec(tk[k]) * 6144;
#pragma unroll
            for (int j = 0; j < 4; ++j) { const int c = 4 * F.lane + 256 * j; const f32x4 g = *(const f32x4*)(lg + c), b = *(const f32x4*)(lb + c); const f32x4 xn = v[k][j] * rstd[k] * g + b;
                if (lastl) { *(f32x4*)(A->out + (size_t)tk[k] * D + c) = xn; }
                else { *(f32x4*)(X + (size_t)tk[k] * D + c) = xn; const f32x4 sh = *(const f32x4*)(mn + c), sc = *(const f32x4*)(mn + 1024 + c); const f32x4 h = xn * (sc + 1.0f) + sh;
                    u32x2 o; o.x = pk2(h[0], h[1]); o.y = pk2(h[2], h[3]); *(u32x2*)(H + (size_t)tk[k] * D + c) = o; } } }
    }
}

constexpr int NPL = 11, NPH = 3 + DEPTH * NPL;
#ifndef REPMASK
#define REPMASK 0u
#endif
__device__ __forceinline__ int reps_of(int b) { int r = 1 + (int)((REPMASK >> b) & 1u); if (REPMASK != 0u) asm volatile("" : "+s"(r)); return r; }

__global__ void __launch_bounds__(NTHR, 2) hybrid_fwd(Args args) {
    extern __shared__ __attribute__((aligned(16))) unsigned char lds[];
    Frame F;
    F.lds = (LAS unsigned char*)lds; F.CTLW = (volatile LAS unsigned*)(F.lds + LDSCTL_OFF);
    F.tid = threadIdx.x; F.lane = F.tid & 63; F.wave = __builtin_amdgcn_readfirstlane(F.tid >> 6); F.G = gridDim.x; F.bid = blockIdx.x; F.ws = args.ws;
    unsigned char* ws = args.ws;
    for (int u = F.tid; u < 256; u += NTHR) F.CTLW[u] = 0u;
    __syncthreads();
    XcdBarrier bar; bar.bar = (unsigned*)(ws + WS_CTL) + CW_BAR; bar.x = 0; bar.st = nullptr;
    if (MK_N_LAUNCHES == 1) bar = xcd_barrier_post((unsigned*)(ws + WS_CTL) + CW_BAR, F.CTLW + 8);
    const int lo = args.ph_lo, hi = args.ph_hi;
#ifndef PHMASK
#define PHMASK 0xFFFFFFFFu
#endif
#define IN(k) (lo <= (k) && (k) < hi)
#define ON(b) ((PHMASK >> (b)) & 1u)
#define REPS(b) reps_of(b)
#define REPBAR(b) do { if (rep + 1 < REPS(b)) { XcdBarrier _b = bar; _b.bar = (unsigned*)opq_p((unsigned char*)_b.bar); asm volatile("" : "+s"(_b.x)); xcd_barrier(_b); } } while (0)
#define SEAM(k) do { if (IN((k) + 1)) { XcdBarrier _b = bar; _b.bar = (unsigned*)opq_p((unsigned char*)_b.bar); asm volatile("" : "+s"(_b.x)); xcd_barrier(_b); } } while (0)
    if (ON(0) && IN(0)) { for (int rep = 0; rep < REPS(0); ++rep) { ph0_prologue(F, argp()); REPBAR(0); } SEAM(0); }
    if (ON(1) && IN(1)) { ph1_mod(F, argp()); SEAM(1); }
    if (ON(2) && IN(2)) { ph2_init(F, argp()); SEAM(2); }
    for (int l = 0; l < DEPTH; ++l) {
        const int pb = 3 + l * NPL;
        const int ntok = (l == DEPTH - 1) ? TLAT : T;
        if (ON(3) && IN(pb + 0)) { for (int rep = 0; rep < REPS(3); ++rep) {
            unsigned char* ws = opq_p(F.ws); CArgsP AP = argp(); (void)AP;
            typedef pg8::DenseSched<T / 256, NINP / 256> SchedT; SchedT S{(const char*)(ws + WS_H), (const char*)(ws + WS_WIN) + (size_t)l * NINP * 2048, (size_t)256 * 2048, (size_t)256 * 2048, F.G, F.bid};
            EpiInProj E{(bf16_t*)(ws + WS_PROJ), (bf16_t*)(ws + WS_UCAT), (float*)(ws + WS_GL), (bf16_t*)(ws + WS_VT)};
            pg8::gemm_phase<EpiInProj, SchedT, false>(F.lds, 2048u, 2048u, 1024, S, E);
            REPBAR(3); } SEAM(pb + 0);
        }
        if (ON(4) && IN(pb + 1)) { for (int rep = 0; rep < REPS(4); ++rep) {
            unsigned char* ws = opq_p(F.ws); CArgsP AP = argp(); (void)AP;
            typedef pg8::BatchSched<NCHP / 256, 1, 16> SchedT; SchedT S{(const char*)(ws + WS_UCAT), (const char*)(ws + WS_S5F) + (size_t)l * 16 * 256 * 2048, (size_t)NCHP * S5K * 2, (size_t)256 * 2048, (size_t)256 * S5K * 2, (size_t)256 * 2048, F.G, (F.bid + 128) & 255};
            EpiHloc E{(float*)(ws + WS_HLOC)};
#ifndef SUBMASK
#define SUBMASK 7
#endif
            if (SUBMASK & 1) pg8::gemm_phase<EpiHloc, SchedT, false>(F.lds, (unsigned)(S5K * 2), 2048u, 1024, S, E);
            __syncthreads();
            if (SUBMASK & 2) gla_local(F, argp(), l);
            if (SUBMASK & 4) sgu_phase(F, argp(), l);
            REPBAR(4); } SEAM(pb + 1);
        }
        if (ON(5) && IN(pb + 2)) { for (int rep = 0; rep < REPS(5); ++rep) { scan_phase(F, argp(), l); REPBAR(5); } SEAM(pb + 2); }
        if (ON(6) && IN(pb + 3)) { for (int rep = 0; rep < REPS(6); ++rep) {
            unsigned char* ws = opq_p(F.ws); CArgsP AP = argp(); (void)AP;
            typedef pg8::BatchSched<NCHP / 256, 4, 16> SchedT; SchedT S{(const char*)(ws + WS_UCAT), (const char*)(ws + WS_S5M) + (size_t)l * 16 * 1024 * S5K * 2, (size_t)NCHP * S5K * 2, (size_t)1024 * S5K * 2, (size_t)256 * S5K * 2, (size_t)256 * S5K * 2, F.G, F.bid};
            EpiS5Y E{(bf16_t*)(ws + WS_YS5)};
            pg8::gemm_phase<EpiS5Y, SchedT, false>(F.lds, (unsigned)(S5K * 2), (unsigned)(S5K * 2), S5K, S, E);
            __syncthreads();
            gla_out(F, argp(), l);
            REPBAR(6); } SEAM(pb + 3);
        }
        if (ON(7) && IN(pb + 4)) { for (int rep = 0; rep < REPS(7); ++rep) {
            unsigned char* ws = opq_p(F.ws); CArgsP AP = argp(); (void)AP;
            typedef pg8::DenseSched<T / 256, 1> SchedT; SchedT S{(const char*)(ws + WS_YS5), (const char*)(ws + WS_GLUT) + (size_t)l * 256 * 512, (size_t)256 * 512, (size_t)256 * 512, F.G, F.bid};
            EpiGlu E{(const bf16_t*)(ws + WS_YS5), (bf16_t*)(ws + WS_MIXED), AP->in[23] + l * 256};
            pg8::gemm_phase<EpiGlu, SchedT, false>(F.lds, 512u, 512u, 256, S, E);
            REPBAR(7); } SEAM(pb + 4);
        }
        if (ON(8) && IN(pb + 5)) { for (int rep = 0; rep < REPS(8); ++rep) {
            unsigned char* ws = opq_p(F.ws); CArgsP AP = argp(); (void)AP;
            typedef pg8::DenseSched<T / 256, 4> SchedT; SchedT S{(const char*)(ws + WS_MIXED), (const char*)(ws + WS_WOUT) + (size_t)l * 1024 * 2048, (size_t)256 * 2048, (size_t)256 * 2048, F.G, F.bid};
            EpiBf16 E{(bf16_t*)(ws + WS_TMP), 1024};
            pg8::gemm_phase<EpiBf16, SchedT, false>(F.lds, 2048u, 2048u, 1024, S, E);
            REPBAR(8); } SEAM(pb + 5);
        }
        if (ON(9) && IN(pb + 6)) { if (REPMASK & 0x200u) { ln1_router(F, argp(), l, ntok, true); __syncthreads(); } ln1_router(F, argp(), l, ntok); SEAM(pb + 6); }
        if (ON(10) && IN(pb + 7)) { for (int rep = 0; rep < REPS(10); ++rep) { slots_phase(F, ntok); REPBAR(10); } SEAM(pb + 7); }
        if (ON(11) && IN(pb + 8)) { for (int rep = 0; rep < REPS(11); ++rep) {
            unsigned char* ws = opq_p(F.ws); CArgsP AP = argp(); (void)AP;
            moe_prefix(F);
            pg8::MoeSched<8, true> S{(const char*)(ws + WS_QS), (const char*)(ws + WS_WUP) + (size_t)l * 32 * 2048 * 1024, (const int*)(ws + WS_SLOTTOK), (const LAS int*)(F.CTLW + 160), 0, (size_t)2048 * 1024, (size_t)256 * 1024, F.G, F.bid};
            EpiUp E{(unsigned char*)(ws + WS_ACT), AP->in[30] + (size_t)l * 32 * 2048};
            pg8::gemm_phase<EpiUp, pg8::MoeSched<8, true>, true, true>(F.lds, 1024u, 1024u, 1024, S, E);
            REPBAR(11); } SEAM(pb + 8);
        }
        if (ON(12) && IN(pb + 9)) { for (int rep = 0; rep < REPS(12); ++rep) {
            unsigned char* ws = opq_p(F.ws); CArgsP AP = argp(); (void)AP;
            moe_prefix(F);
            pg8::MoeSched<4, false> S{(const char*)(ws + WS_ACT), (const char*)(ws + WS_WDN) + (size_t)l * 32 * 1024 * 1024, (const int*)(ws + WS_SLOTTOK), (const LAS int*)(F.CTLW + 160), (size_t)256 * 1024, (size_t)1024 * 1024, (size_t)256 * 1024, F.G, F.bid};
            EpiDown E{(bf16_t*)(ws + WS_YV), AP->in[32] + (size_t)l * 32 * 1024};
            pg8::gemm_phase<EpiDown, pg8::MoeSched<4, false>, false, true>(F.lds, 1024u, 1024u, 1024, S, E);
            REPBAR(12); } SEAM(pb + 9);
        }
        if (ON(13) && IN(pb + 10)) { if (REPMASK & 0x2000u) { combine_ln2(F, argp(), l, ntok, true); __syncthreads(); } combine_ln2(F, argp(), l, ntok); SEAM(pb + 10); }
    }
#undef IN
#undef SEAM
}

extern "C" void kernel_launch(void* const* d_in, const int* in_sizes, int n_in, void* d_out, int out_size, void* d_ws, size_t ws_size, hipStream_t stream) {
    static int grid = 0;
    if (grid == 0) {
        if (n_in != 33 || out_size != TLAT * D || ws_size < WS_END) { fprintf(stderr, "kernel_launch: unexpected problem (n_in %d, out %d, ws %zu)\n", n_in, out_size, ws_size); grid = -1; return; }
        int dev = 0, cus = 0, per_cu = 0;
        if (hipGetDevice(&dev) != hipSuccess || hipDeviceGetAttribute(&cus, hipDeviceAttributeMultiprocessorCount, dev) != hipSuccess) { grid = -1; return; }
        if (hipFuncSetAttribute((const void*)hybrid_fwd, hipFuncAttributeMaxDynamicSharedMemorySize, LDS_BYTES) != hipSuccess) { fprintf(stderr, "kernel_launch: hipFuncSetAttribute failed\n"); grid = -1; return; }
        if (hipOccupancyMaxActiveBlocksPerMultiprocessor(&per_cu, (const void*)hybrid_fwd, NTHR, LDS_BYTES) != hipSuccess || per_cu < 1) fprintf(stderr, "kernel_launch: occupancy query says %d\n", per_cu);
        (void)hipGetLastError();
        grid = cus;
        if (grid != 256) { fprintf(stderr, "kernel_launch: built for 256 CUs, found %d\n", cus); grid = -1; return; }
    }
    if (grid < 0) return;
    if (hipMemsetAsync((char*)d_ws + WS_CTL, 0, CTL_ZERO_BYTES, stream) != hipSuccess) return;
    Args a{};
    for (int i = 0; i < 33; ++i) a.in[i] = (const float*)d_in[i];
    a.out = (float*)d_out; a.ws = (unsigned char*)d_ws;
#if MK_N_LAUNCHES == 1
    a.ph_lo = 0; a.ph_hi = NPH;
    hipLaunchKernelGGL(hybrid_fwd, dim3(grid), dim3(NTHR), LDS_BYTES, stream, a);
#else
    for (int p = 0; p < NPH; ++p) { a.ph_lo = p; a.ph_hi = p + 1; hipLaunchKernelGGL(hybrid_fwd, dim3(grid), dim3(NTHR), LDS_BYTES, stream, a); }
#endif
}
```

```cpp
#include <hip/hip_runtime.h>
#include <cstdio>
#include <cstdint>

#define REPMASK 0u
#ifndef MK_N_LAUNCHES
#define MK_N_LAUNCHES 1
#endif

#define GAS __attribute__((address_space(1)))
#define LAS __attribute__((address_space(3)))
typedef unsigned short bf16_t;
typedef short bf16x8 __attribute__((ext_vector_type(8)));
typedef float f32x4 __attribute__((ext_vector_type(4)));
typedef float f32x2 __attribute__((ext_vector_type(2)));
typedef unsigned u32x4 __attribute__((ext_vector_type(4)));
typedef unsigned u32x2 __attribute__((ext_vector_type(2)));
typedef int s32x4 __attribute__((ext_vector_type(4)));

constexpr int D = 1024, NB = 4, SEQ = 8192, DEPTH = 4, CTXL = 256;
constexpr int TLAT = NB * SEQ, TCTX = NB * CTXL, T = TLAT + TCTX;
constexpr int NIN = 2336, NINP = 2560, PROJW = 2048;
constexpr int NCH = T / 64, NCHP = 768;
constexpr int NEXP = 32, DEXP = 1024;
constexpr int MAXTILES = 560, NSLOT = MAXTILES * 256;
constexpr int S5K = 1280;
constexpr float LN_EPS = 1e-5f;
constexpr float DN_ALPHA = 1.681792830507429f;
constexpr int NWAVES = 8, NTHR = 512;

constexpr size_t MiB = 1u << 20;
constexpr size_t WS_CTL = 0, CTL_ZERO_BYTES = 32768;
constexpr size_t WS_MODP = 1 * MiB, WS_MOD = 5 * MiB, WS_LB64 = 6 * MiB, WS_KTAB = 7 * MiB, WS_SGUW = 15 * MiB, WS_GLUT = 16 * MiB;
constexpr size_t WS_WIN = 17 * MiB, WS_WOUT = 37 * MiB, WS_S5M = 45 * MiB, WS_S5F = 205 * MiB, WS_WUP = 237 * MiB, WS_WDN = 749 * MiB;
constexpr size_t WS_X = 1005 * MiB, WS_H = 1137 * MiB, WS_PROJ = 1203 * MiB, WS_GL = 1335 * MiB, WS_UCAT = 1340 * MiB, WS_HLOC = 1370 * MiB;
constexpr size_t WS_YS5 = 1382 * MiB, WS_QS = 1399 * MiB, WS_KS = 1432 * MiB, WS_QH = 1465 * MiB, WS_VT = 1498 * MiB, WS_GLAST = 1531 * MiB;
constexpr size_t WS_SPREV = 1663 * MiB, WS_GDEC = 1729 * MiB, WS_MIXED = 1731 * MiB, WS_TMP = 1797 * MiB, WS_TOPI = 1929 * MiB, WS_GATE = 1930 * MiB;
constexpr size_t WS_WGCNT = 1931 * MiB, WS_ECNT = 1932 * MiB, WS_SLOTTOK = 1933 * MiB, WS_TOKSLOT = 1934 * MiB, WS_ACT = 1935 * MiB, WS_YV = 2215 * MiB;
constexpr size_t WS_WRT = 2495 * MiB, WS_BUP = 2496 * MiB, WS_BDN = 2497 * MiB, WS_STAT = 2498 * MiB, WS_WRH = 2500 * MiB, WS_WRL = 2501 * MiB, WS_END = 2502 * MiB;
constexpr int CW_BAR = 4096;

constexpr int RING_BYTES = 131072;
constexpr int LDS_BYTES = 163840;
constexpr int LDSCTL_OFF = LDS_BYTES - 1024;

__device__ __forceinline__ float bf2f(unsigned b) { return __uint_as_float(b << 16); }
__device__ __forceinline__ unsigned f2bf(float f) { unsigned u = __float_as_uint(f); return (u + 0x7fffu + ((u >> 16) & 1u)) >> 16; }
__device__ __forceinline__ unsigned pk2(float lo, float hi) { unsigned r; asm("v_cvt_pk_bf16_f32 %0, %1, %2" : "=v"(r) : "v"(lo), "v"(hi)); return r; }
__device__ __forceinline__ unsigned cvt_pk_bf16(float lo, float hi) { unsigned r; asm volatile("v_cvt_pk_bf16_f32 %0, %1, %2" : "=v"(r) : "v"(lo), "v"(hi)); return r; }
__device__ __forceinline__ unsigned pk4_fp8(float a, float b, float c, float d) { int w = 0; w = __builtin_amdgcn_cvt_pk_fp8_f32(a, b, w, false); w = __builtin_amdgcn_cvt_pk_fp8_f32(c, d, w, true); return (unsigned)w; }
__device__ __forceinline__ f32x4 unpk4(u32x2 w) { return (f32x4){bf2f(w.x & 0xffffu), bf2f(w.x >> 16), bf2f(w.y & 0xffffu), bf2f(w.y >> 16)}; }
__device__ __forceinline__ u32x2 pk4(f32x4 v) { u32x2 o; o.x = pk2(v[0], v[1]); o.y = pk2(v[2], v[3]); return o; }
__device__ __forceinline__ float rcpf(float x) { return __builtin_amdgcn_rcpf(x); }
__device__ __forceinline__ float sigmoidf_(float x) { return rcpf(1.0f + __expf(-x)); }
__device__ __forceinline__ float siluf_(float x) { return x * sigmoidf_(x); }
__device__ __forceinline__ float gelu_tanh(float x) { const float u = 0.7978845608028654f * (x + 0.044715f * x * x * x); const float e = __expf(2.0f * u); return x * (1.0f - rcpf(1.0f + e)); }
__device__ __forceinline__ float logsigmoidf_(float x) { return fminf(x, 0.0f) - __logf(1.0f + __expf(-fabsf(x))); }
__device__ __forceinline__ float wave_sum(float v) {
#define WS_DPP(ctrl) v += __int_as_float(__builtin_amdgcn_update_dpp(0, __float_as_int(v), ctrl, 0xf, 0xf, false))
    WS_DPP(0xB1); WS_DPP(0x4E); WS_DPP(0x141); WS_DPP(0x140);
#undef WS_DPP
    const int b = __float_as_int(v);
    const float r0 = __int_as_float(__builtin_amdgcn_readlane(b, 0)), r1 = __int_as_float(__builtin_amdgcn_readlane(b, 16)), r2 = __int_as_float(__builtin_amdgcn_readlane(b, 32)), r3 = __int_as_float(__builtin_amdgcn_readlane(b, 48));
    return (r0 + r1) + (r2 + r3);
}
__device__ __forceinline__ int opq(int x) { asm volatile("" : "+v"(x)); return x; }
__device__ __forceinline__ int opq_s(int x) { asm volatile("" : "+s"(x)); return x; }
__device__ __forceinline__ LAS unsigned char* opq_l(LAS unsigned char* p) { asm volatile("" : "+s"(p)); return p; }
__device__ __forceinline__ int tok_vec(int tk) { return tk < TLAT ? (tk >> 13) : 4; }

#define XB_TMO      128
#define XB_XCNT(j)  (256  + 64 * (j))
#define XB_XSUB(j)  (1280 + 64 * (j))
#define XB_XGEN(j)  (2304 + 64 * (j))
#define XB_TOP      3328
#define XB_TOPGEN   3392
#define XCD_BAR_WORDS 3456
#define XB_SPIN_CAP (1u << 20)
__device__ __forceinline__ unsigned xb_ld(unsigned* p)              { return __hip_atomic_load(p, __ATOMIC_RELAXED, __HIP_MEMORY_SCOPE_AGENT); }
__device__ __forceinline__ unsigned xb_add(unsigned* p, unsigned v) { return __hip_atomic_fetch_add(p, v, __ATOMIC_RELAXED, __HIP_MEMORY_SCOPE_AGENT); }
__device__ __forceinline__ unsigned xb_xcc_id() { return (unsigned)__builtin_amdgcn_s_getreg((3 << 11) | 20) & 0xFu; }
#define XB_SPIN(cond, bar) do { unsigned _sp = 0; while (cond) { __builtin_amdgcn_s_sleep(1); \
    if ((++_sp & 255u) == 0u) { if (xb_ld(&(bar)[XB_TMO])) break; if (_sp > XB_SPIN_CAP) { atomicAdd(&(bar)[XB_TMO], 1u); break; } } } } while (0)
struct XcdBarrier { unsigned* bar; unsigned x; volatile LAS unsigned* st; };
__device__ __forceinline__ XcdBarrier xcd_barrier_post(unsigned* bar, volatile LAS unsigned* st) {
    XcdBarrier b; b.bar = bar; b.x = xb_xcc_id(); b.st = st;
    if (threadIdx.x == 0) (void)xb_add(&bar[XB_XCNT(b.x)], 1u);
    return b;
}
__device__ __forceinline__ void xcd_barrier_complete(unsigned* bar, unsigned x, unsigned& nloc, unsigned& nx) {
    const unsigned G = gridDim.x * gridDim.y * gridDim.z;
    unsigned sum, cnt, mine, sp = 0u;
    for (;;) {
        sum = 0u; cnt = 0u; mine = 0u;
#pragma unroll
        for (unsigned j = 0; j < 16; ++j) { const unsigned c = xb_ld(&bar[XB_XCNT(j)]); sum += c; cnt += (c > 0u) ? 1u : 0u; mine = (j == x) ? c : mine; }
        if (sum == G) break;
        __builtin_amdgcn_s_sleep(1);
        if ((++sp & 255u) == 0u) { if (xb_ld(&bar[XB_TMO])) break; if (sp > XB_SPIN_CAP) { atomicAdd(&bar[XB_TMO], 1u); break; } }
    }
    nloc = mine > 0u ? mine : 1u; nx = cnt > 0u ? cnt : 1u;
}
__device__ __forceinline__ void xcd_barrier(const XcdBarrier& b) {
    asm volatile("s_waitcnt vmcnt(0)" ::: "memory");
    __syncthreads();
    if (threadIdx.x == 0) {
        unsigned* bar = b.bar;
        __builtin_amdgcn_s_waitcnt(0);
        unsigned nloc = b.st[0], nx = b.st[1];
        if (nloc == 0u) { xcd_barrier_complete(bar, b.x, nloc, nx); b.st[0] = nloc; b.st[1] = nx; }
        const unsigned old = xb_add(&bar[XB_XSUB(b.x)], 1u);
        const unsigned gen = old / nloc;
        if (old + 1u == (gen + 1u) * nloc) {
            __builtin_amdgcn_fence(__ATOMIC_RELEASE, "agent");
            asm volatile("s_waitcnt vmcnt(0)" ::: "memory");
            const unsigned og = xb_add(&bar[XB_TOP], 1u);
            const unsigned tg = og / nx;
            if (og + 1u == (tg + 1u) * nx) xb_add(&bar[XB_TOPGEN], 1u);
            else XB_SPIN(xb_ld(&bar[XB_TOPGEN]) == tg, bar);
            __builtin_amdgcn_fence(__ATOMIC_ACQUIRE, "agent");
            xb_add(&bar[XB_XGEN(b.x)], 1u);
            asm volatile("s_waitcnt vmcnt(0)" ::: "memory");
        } else {
            XB_SPIN(xb_ld(&bar[XB_XGEN(b.x)]) == gen, bar);
            __builtin_amdgcn_fence(__ATOMIC_ACQUIRE, "agent");
            asm volatile("s_waitcnt vmcnt(0)" ::: "memory");
        }
    }
    __syncthreads();
}

namespace pg8 {
constexpr int BM = 256, BK = 64, HALF = 128, HTB = HALF * BK * 2, STAGE_BYTES = 8 * HTB, NXCD = 8, WGM = 8;
__host__ __device__ __forceinline__ int lds_byte(int r, int c) { const int st = (r >> 4) * 2 + (c >> 5), rr = r & 15, cc = c & 31, ob = rr * 64 + cc * 2; return st * 1024 + (ob ^ (((ob >> 9) & 1) << 5)); }
__host__ __device__ __forceinline__ void stage_rc(int b, int& R, int& C) { const int st = b / 1024, sb = b % 1024, swz = sb ^ (((sb >> 9) & 1) << 5); R = (st >> 1) * 16 + swz / 64; C = (st & 1) * 32 + (swz % 64) / 2; }
__host__ __device__ __forceinline__ int perm32(int rho) { const int n = rho >> 4, i = rho & 15; return 8 * (i >> 2) + 4 * n + (i & 3); }

struct GUnit { const char* a; const char* b; const int* rows; int pm, pn, grp; };

__device__ __forceinline__ void gld128_asm(f32x4& d, const float* p) { asm volatile("global_load_dwordx4 %0, %1, off" : "=v"(d) : "v"((GAS const float*)p) : "memory"); }
__device__ __forceinline__ void gld32_asm(int& d, const int* p) { asm volatile("global_load_dword %0, %1, off" : "=v"(d) : "v"((GAS const int*)p) : "memory"); }
typedef int i32x4 __attribute__((ext_vector_type(4)));
typedef int i32x8 __attribute__((ext_vector_type(8)));
__device__ __forceinline__ i32x8 cat8(bf16x8 lo, bf16x8 hi) { const i32x4 a = __builtin_bit_cast(i32x4, lo), b = __builtin_bit_cast(i32x4, hi); return __builtin_shufflevector(a, b, 0, 1, 2, 3, 4, 5, 6, 7); }
template <class Epi, class Sched, bool GATHER, bool FP8 = false>
__device__ __forceinline__ void gemm_phase(LAS unsigned char* lds, const unsigned lda, const unsigned ldb, const int K, const Sched& S, const Epi& E) {
    const int tid = opq((int)threadIdx.x), wid = __builtin_amdgcn_readfirstlane(tid >> 6), lane = tid & 63, wr = wid >> 2, wc = wid & 3, fr = lane & 15, fq = lane >> 4;
    int Kq = K; asm volatile("" : "+s"(Kq)); const int nt = FP8 ? Kq / 128 : Kq / BK;
    unsigned voffB[2], cA0[2], cA1[2];
#pragma unroll
    for (int i = 0; i < 2; ++i) { int R, C; stage_rc(tid * 16 + i * 8192, R, C); const int Rb = Epi::PERM ? ((R & ~31) + perm32(R & 31)) : R;
        voffB[i] = (unsigned)Rb * ldb + (unsigned)C * 2u; }
    const size_t kstep = (size_t)(BK * 2);
    const size_t hstepB = (size_t)HALF * ldb;
    const unsigned ldsw = (unsigned)wid * 1024u;
    const int aoff = lds_byte(wr * 64 + fr, fq * 8), boff = lds_byte(wc * 32 + fr, fq * 8);
#define PG8_AOFF(u, o0, o1) do { const int _t = opq((int)threadIdx.x); _Pragma("unroll") for (int _i = 0; _i < 2; ++_i) { int _R, _C; stage_rc(_t * 16 + _i * 8192, _R, _C); \
        if (GATHER) { const unsigned _p = (unsigned)(u).rows[_R]; o0[_i] = (_p & 0xffffu) * lda + (unsigned)_C * 2u; o1[_i] = (_p >> 16) * lda + (unsigned)_C * 2u; } \
        else { o0[_i] = (unsigned)_R * lda + (unsigned)_C * 2u; o1[_i] = o0[_i] + (unsigned)HALF * lda; } } } while (0)
#define PG8_SA(b, h) (((b) * 2 + (h)) * HTB)
#define PG8_SB(b, h) ((4 + (b) * 2 + (h)) * HTB)
#define PG8_STAGE(bufoff, gbase, voff) do { _Pragma("unroll") for (int _i = 0; _i < 2; ++_i) \
        __builtin_amdgcn_global_load_lds((const unsigned*)((const char*)(gbase) + (voff)[_i]), (LAS unsigned*)(lds + (bufoff) + ldsw + _i * 8192), 16, 0, 0); } while (0)
#define PG8_LDA(dst, b, h) do { _Pragma("unroll") for (int m = 0; m < 4; ++m) { dst[m].lo = *(const LAS i32x4*)(lds + PG8_SA(b, h) + aoff + m * 2048); dst[m].hi = *(const LAS i32x4*)(lds + PG8_SA(b, h) + aoff + m * 2048 + 1024); } } while (0)
#define PG8_LDB(dst, b, h) do { _Pragma("unroll") for (int n = 0; n < 2; ++n) { dst[n].lo = *(const LAS i32x4*)(lds + PG8_SB(b, h) + boff + n * 2048); dst[n].hi = *(const LAS i32x4*)(lds + PG8_SB(b, h) + boff + n * 2048 + 1024); } } while (0)
#define PG8_MMA(ai, bj, At, Bt) do { __builtin_amdgcn_s_setprio(1); if constexpr (FP8) asm volatile("s_nop 4"); _Pragma("unroll") for (int m = 0; m < 4; ++m) _Pragma("unroll") for (int n = 0; n < 2; ++n) { \
        if constexpr (FP8) asm volatile("v_mfma_scale_f32_16x16x128_f8f6f4 %0, %1, %2, %0, %3, %3 op_sel_hi:[0,0,0]" : "+v"(acc[ai][bj][m][n]) : "v"(Bt[n]), "v"(At[m]), "v"(sc1)); \
        else { acc[ai][bj][m][n] = __builtin_amdgcn_mfma_f32_16x16x32_bf16(__builtin_bit_cast(bf16x8, (i32x4)Bt[n].lo), __builtin_bit_cast(bf16x8, (i32x4)At[m].lo), acc[ai][bj][m][n], 0, 0, 0); \
               acc[ai][bj][m][n] = __builtin_amdgcn_mfma_f32_16x16x32_bf16(__builtin_bit_cast(bf16x8, (i32x4)Bt[n].hi), __builtin_bit_cast(bf16x8, (i32x4)At[m].hi), acc[ai][bj][m][n], 0, 0, 0); } } \
        __builtin_amdgcn_s_setprio(0); } while (0)
#define PG8_WAIT_V(n) asm volatile("s_waitcnt vmcnt(" #n ")" ::: "memory")
#define PG8_WAIT_L(n) asm volatile("s_waitcnt lgkmcnt(" #n ")" ::: "memory")
#define PG8_BAR __builtin_amdgcn_s_barrier()
#define PG8_SCHED __builtin_amdgcn_sched_barrier(0)
    GUnit cur, nxt; int ui = 0;
    if (!S.next(0, cur)) return;
    f32x4 acc[2][2][4][2];
#pragma unroll
    for (int a = 0; a < 2; ++a)
#pragma unroll
        for (int b = 0; b < 2; ++b)
#pragma unroll
            for (int m = 0; m < 4; ++m)
#pragma unroll
                for (int n = 0; n < 2; ++n) acc[a][b][m][n] = (f32x4){0.f, 0.f, 0.f, 0.f};
    const int sc1 = 0x7f7f7f7f;
    i32x8 At[4], B0[2], B1[2];
    const char* cA = cur.a; const char* cB = cur.b;
    PG8_AOFF(cur, cA0, cA1);
    PG8_STAGE(PG8_SB(0, 0), cB, voffB); PG8_STAGE(PG8_SB(0, 1), cB + hstepB, voffB); PG8_STAGE(PG8_SA(0, 0), cA, cA0); PG8_STAGE(PG8_SA(0, 1), cA, cA1);
    if (wr == 1) PG8_BAR;
    PG8_WAIT_V(2); PG8_BAR;
    PG8_STAGE(PG8_SB(1, 0), cB + kstep, voffB); PG8_STAGE(PG8_SA(1, 0), cA + kstep, cA0); PG8_STAGE(PG8_SB(1, 1), cB + hstepB + kstep, voffB);
    PG8_WAIT_V(6); PG8_BAR;
    for (;;) {
        const bool has_next = S.next(ui + 1, nxt);
        const char* nA = has_next ? nxt.a : cA; const char* nB = has_next ? nxt.b : cB;
        int nr[2] = {0, 0};
        if constexpr (GATHER) { if (has_next) { const int _t = opq((int)threadIdx.x);
#pragma unroll
            for (int i = 0; i < 2; ++i) { int R, C; stage_rc(_t * 16 + i * 8192, R, C); gld32_asm(nr[i], nxt.rows + R); } } }
        f32x4 ebias[4]; E.prefetch(cur, ebias);
#ifdef PROBE_KLOOP2
        int krep = FP8 ? 2 : 1; asm volatile("" : "+s"(krep));
#else
        constexpr int krep = 1;
#endif
        for (int rep = 0; rep < krep; ++rep) {
        for (int t = 0; t < nt; t += 2) {
            const bool lastk = (t == nt - 2), last = lastk && (rep == krep - 1);
            const char* a1 = cA + (size_t)(t + 1) * kstep;
            const char* a2 = lastk ? (last ? nA : cA) : cA + (size_t)(t + 2) * kstep; const char* b2 = lastk ? (last ? nB : cB) : cB + (size_t)(t + 2) * kstep;
            const char* a3 = a2 + kstep; const char* b3 = b2 + kstep;
            unsigned s0[2], s1[2];
#pragma unroll
            for (int i = 0; i < 2; ++i) { s0[i] = cA0[i]; s1[i] = cA1[i];
                if constexpr (GATHER) { if (last && has_next) { asm volatile("" : "+v"(nr[i])); int R, C; stage_rc(opq((int)threadIdx.x) * 16 + i * 8192, R, C);
                    s0[i] = ((unsigned)nr[i] & 0xffffu) * lda + (unsigned)C * 2u; s1[i] = ((unsigned)nr[i] >> 16) * lda + (unsigned)C * 2u; } } }
            PG8_LDB(B0, 0, 0); PG8_LDB(B1, 0, 1); PG8_SCHED; PG8_LDA(At, 0, 0); PG8_STAGE(PG8_SA(1, 1), a1, cA1);
            PG8_WAIT_V(8); PG8_WAIT_L(0); PG8_BAR; PG8_MMA(0, 0, At, B0); PG8_MMA(0, 1, At, B1); PG8_BAR; PG8_SCHED;
            PG8_LDA(At, 0, 1); PG8_STAGE(PG8_SB(0, 0), b2, voffB); PG8_STAGE(PG8_SB(0, 1), b2 + hstepB, voffB); PG8_STAGE(PG8_SA(0, 0), a2, s0);
            PG8_WAIT_V(8); PG8_WAIT_L(0); PG8_BAR; PG8_MMA(1, 0, At, B0); PG8_MMA(1, 1, At, B1); PG8_BAR; PG8_SCHED;
            PG8_LDB(B0, 1, 0); PG8_LDB(B1, 1, 1); PG8_SCHED; PG8_LDA(At, 1, 0); PG8_STAGE(PG8_SA(0, 1), a2, s1);
            PG8_WAIT_V(8); PG8_WAIT_L(0); PG8_BAR; PG8_MMA(0, 0, At, B0); PG8_MMA(0, 1, At, B1); PG8_BAR; PG8_SCHED;
            PG8_LDA(At, 1, 1); PG8_STAGE(PG8_SB(1, 0), b3, voffB); PG8_STAGE(PG8_SB(1, 1), b3 + hstepB, voffB); PG8_STAGE(PG8_SA(1, 0), a3, s0);
            PG8_WAIT_V(8); PG8_WAIT_L(0); PG8_BAR; PG8_MMA(1, 0, At, B0); PG8_MMA(1, 1, At, B1); PG8_BAR; PG8_SCHED;
        }
#ifdef PROBE_KLOOP2
        if (rep + 1 < krep) { asm volatile("s_nop 15\n\ts_nop 15");
#pragma unroll
            for (int a = 0; a < 2; ++a)
#pragma unroll
                for (int b = 0; b < 2; ++b)
#pragma unroll
                    for (int m = 0; m < 4; ++m)
#pragma unroll
                        for (int n = 0; n < 2; ++n) acc[a][b][m][n] = (f32x4){0.f, 0.f, 0.f, 0.f}; }
#endif
        }
        if constexpr (FP8) asm volatile("s_nop 15\n\ts_nop 15");
        if (wr == 0) PG8_BAR;
        if constexpr (Epi::NB == 4) asm volatile("" : "+v"(ebias[0]), "+v"(ebias[1]), "+v"(ebias[2]), "+v"(ebias[3]));
        else if constexpr (Epi::NB == 2) asm volatile("" : "+v"(ebias[0]), "+v"(ebias[1]));
        { const int _t = opq((int)threadIdx.x), _w = __builtin_amdgcn_readfirstlane(_t >> 6), _l = _t & 63; E(acc, cur, _w >> 2, _w & 3, _l & 15, _l >> 4, ebias); }
#ifdef PROBE_EPI2_OFF
        if constexpr (FP8) { const int _t = opq((int)threadIdx.x), _w = __builtin_amdgcn_readfirstlane(_t >> 6), _l = _t & 63; asm volatile("" ::: "memory"); E(acc, cur, _w >> 2, _w & 3, _l & 15, _l >> 4); }
#endif
        if (!has_next) break;
#pragma unroll
        for (int a = 0; a < 2; ++a)
#pragma unroll
            for (int b = 0; b < 2; ++b)
#pragma unroll
                for (int m = 0; m < 4; ++m)
#pragma unroll
                    for (int n = 0; n < 2; ++n) acc[a][b][m][n] = (f32x4){0.f, 0.f, 0.f, 0.f};
        cur = nxt; cA = nA; cB = nB; ++ui;
        if constexpr (GATHER) {
#pragma unroll
            for (int i = 0; i < 2; ++i) { int R, C; stage_rc(opq((int)threadIdx.x) * 16 + i * 8192, R, C); cA0[i] = ((unsigned)nr[i] & 0xffffu) * lda + (unsigned)C * 2u; cA1[i] = ((unsigned)nr[i] >> 16) * lda + (unsigned)C * 2u; } }
        if (wr == 1) PG8_BAR;
    }
    PG8_WAIT_V(0);
    PG8_BAR;
#undef PG8_AOFF
#undef PG8_SA
#undef PG8_SB
#undef PG8_STAGE
#undef PG8_LDA
#undef PG8_LDB
#undef PG8_MMA
#undef PG8_WAIT_V
#undef PG8_WAIT_L
#undef PG8_BAR
#undef PG8_SCHED
}

template <int NM, int NN> struct DenseSched {
    const char* A; const char* B; size_t tstepA, tstepB; int G, c, nm;
    __device__ __forceinline__ bool next(int i, GUnit& u) const {
        constexpr int nig = WGM * NN;
        const int nwg = nm * NN, q = nwg >> 3, r = nwg & 7;
        const int L = i * G + c; if (L >= nwg) return false;
        const int xcd = L & 7, off = L >> 3; const int wgid = (xcd < r ? xcd * (q + 1) : r * (q + 1) + (xcd - r) * q) + off;
        const int gid = wgid / nig, w2 = wgid % nig, fm = gid * WGM, rem = nm - fm;
        if (rem >= WGM) { u.pm = fm + (w2 & 7); u.pn = w2 >> 3; } else { const int sh = __builtin_ctz(rem); u.pm = fm + (w2 & (rem - 1)); u.pn = w2 >> sh; }
        u.grp = 0; u.rows = nullptr;
        u.a = A + (size_t)u.pm * tstepA; u.b = B + (size_t)u.pn * tstepB; return true;
    }
};
template <int NM, int NN, int NGRP> struct BatchSched {
    const char* A; const char* B; size_t gstepA, gstepB, tstepA, tstepB; int G, c;
    __device__ __forceinline__ bool next(int i, GUnit& u) const {
        constexpr int per = NM * NN;
        const int L = i * G + c; if (L >= NGRP * per) return false;
        u.grp = L / per; const int r = L % per; u.pn = r % NN; u.pm = r / NN; u.rows = nullptr;
        u.a = A + (size_t)u.grp * gstepA + (size_t)u.pm * tstepA; u.b = B + (size_t)u.grp * gstepB + (size_t)u.pn * tstepB; return true;
    }
};
template <int NCT, bool GATHER> struct MoeSched {
    const char* A; const char* B; const int* slot_tok; const LAS int* pref; size_t tstepA, estepB, tstepB; int G, c;
    __device__ __forceinline__ bool next(int i, GUnit& u) const {
        constexpr int RPX = 32 / NCT;
        const int TT = pref[NEXP]; const int x = c & 7, w = c >> 3;
        const int chunk = (TT + 7) >> 3, lr = i * RPX + w / NCT;
        const int rt = x * chunk + lr, ct = w % NCT; if (lr >= chunk || rt >= TT) return false;
        int e = 0;
        for (int j = 1; j < NEXP; ++j) e += (pref[j] <= rt) ? 1 : 0;
        u.pm = rt; u.pn = ct; u.grp = e; u.rows = slot_tok + rt * 128;
        u.a = GATHER ? A : A + (size_t)rt * tstepA; u.b = B + (size_t)e * estepB + (size_t)ct * tstepB; return true;
    }
};
}
using pg8::GUnit;

struct Args { const float* in[33]; float* out; unsigned char* ws; int ph_lo, ph_hi; };

typedef const __attribute__((address_space(4))) Args* CArgsP;
__device__ __forceinline__ CArgsP argp() { CArgsP p = (CArgsP)__builtin_amdgcn_kernarg_segment_ptr(); asm volatile("" : "+s"(p)); return p; }
__device__ __forceinline__ unsigned char* opq_p(unsigned char* p) { GAS unsigned char* g = (GAS unsigned char*)p; asm volatile("" : "+s"(g)); return (unsigned char*)g; }
#define GIN(A, i) ((const float*)(GAS const float*)((A)->in[i]))
#define GOUT(A) ((float*)(GAS float*)((A)->out))

struct Frame {
    LAS unsigned char* lds; volatile LAS unsigned* CTLW;
    int tid, lane, wave, G, bid;
    unsigned char* ws;
};

struct EpiInProj { static constexpr int NB = 0; __device__ __forceinline__ void prefetch(const GUnit&, f32x4 (&b)[4]) const { }
    static constexpr bool PERM = true; bf16_t* proj; bf16_t* ucat; float* gl; bf16_t* vt; float* stat;
    __device__ __forceinline__ void operator()(const f32x4 (&acc)[2][2][4][2], const GUnit& u, int wr, int wc, int fr, int fq, const f32x4 (&pb)[4]) const {
        const int row0 = u.pm * 256 + wr * 64 + fr;
        if (u.pn == 4 || u.pn == 5) {
#pragma unroll
            for (int ai = 0; ai < 2; ++ai) { const int chunk = u.pm * 4 + ai * 2 + wr;
#pragma unroll
                for (int bj = 0; bj < 2; ++bj) { const int ecol = (u.pn - 4) * 256 + bj * 128 + wc * 32 + 8 * fq, h = ecol >> 7, e0 = ecol & 127;
                    bf16_t* base = vt + ((size_t)(chunk * 4 + h) * 128 + e0) * 64 + fr;
#pragma unroll
                    for (int m = 0; m < 4; ++m)
#pragma unroll
                        for (int n = 0; n < 2; ++n)
#pragma unroll
                            for (int i = 0; i < 4; ++i) base[(4 * n + i) * 64 + m * 16] = (bf16_t)f2bf(acc[ai][bj][m][n][i]); } }
        } else if (u.pn < 8) {
            const bool dog = u.pn < 2; float ssum[2][4] = {{0.f, 0.f, 0.f, 0.f}, {0.f, 0.f, 0.f, 0.f}}, ssq[2][4] = {{0.f, 0.f, 0.f, 0.f}, {0.f, 0.f, 0.f, 0.f}};
#pragma unroll
            for (int ai = 0; ai < 2; ++ai)
#pragma unroll
                for (int m = 0; m < 4; ++m) { bf16_t* rowp = proj + (size_t)(row0 + ai * 128 + m * 16) * PROJW + u.pn * 256 + wc * 32 + 8 * fq;
#pragma unroll
                    for (int bj = 0; bj < 2; ++bj) { f32x4 v0 = acc[ai][bj][m][0], v1 = acc[ai][bj][m][1];
                        if (dog) {
#pragma unroll
                            for (int j = 0; j < 4; ++j) { v0[j] = gelu_tanh(v0[j]); v1[j] = gelu_tanh(v1[j]); } }
                        u32x4 w; w.x = cvt_pk_bf16(v0[0], v0[1]); w.y = cvt_pk_bf16(v0[2], v0[3]); w.z = cvt_pk_bf16(v1[0], v1[1]); w.w = cvt_pk_bf16(v1[2], v1[3]);
                        *(u32x4*)(rowp + bj * 128) = w;
                        if (u.pn == 1) { const f32x4 r0 = unpk4((u32x2){w.x, w.y}), r1 = unpk4((u32x2){w.z, w.w});
                            ssum[ai][m] += (r0[0] + r0[1]) + (r0[2] + r0[3]) + (r1[0] + r1[1]) + (r1[2] + r1[3]);
                            ssq[ai][m] += (r0[0] * r0[0] + r0[1] * r0[1]) + (r0[2] * r0[2] + r0[3] * r0[3]) + (r1[0] * r1[0] + r1[1] * r1[1]) + (r1[2] * r1[2] + r1[3] * r1[3]); } } }
            if (u.pn == 1) {
#pragma unroll
                for (int ai = 0; ai < 2; ++ai)
#pragma unroll
                    for (int m = 0; m < 4; ++m) { float s = ssum[ai][m], q2 = ssq[ai][m]; s += __shfl_xor(s, 16); s += __shfl_xor(s, 32); q2 += __shfl_xor(q2, 16); q2 += __shfl_xor(q2, 32);
                        if (fq == 0) *(f32x2*)(stat + ((size_t)(row0 + ai * 128 + m * 16) * 4 + wc) * 2) = (f32x2){s, q2}; } }
        } else if (u.pn == 8) {
#pragma unroll
            for (int ai = 0; ai < 2; ++ai)
#pragma unroll
                for (int m = 0; m < 4; ++m) { const int row = row0 + ai * 128 + m * 16, chunk = row >> 6, s = row & 63;
#pragma unroll
                    for (int bj = 0; bj < 2; ++bj) { const int j0 = bj * 128 + wc * 32 + 8 * fq, g = j0 >> 4, h0 = j0 & 15;
                        const f32x4 v0 = acc[ai][bj][m][0], v1 = acc[ai][bj][m][1];
                        u32x4 w; w.x = cvt_pk_bf16(v0[0], v0[1]); w.y = cvt_pk_bf16(v0[2], v0[3]); w.z = cvt_pk_bf16(v1[0], v1[1]); w.w = cvt_pk_bf16(v1[2], v1[3]);
                        *(u32x4*)(ucat + ((size_t)(g * NCHP + chunk) * S5K + s * 16 + h0)) = w; } }
        } else {
            if (wc == 0) {
#pragma unroll
                for (int ai = 0; ai < 2; ++ai)
#pragma unroll
                    for (int m = 0; m < 4; ++m) { float* dst = gl + (size_t)(row0 + ai * 128 + m * 16) * 32 + 8 * fq;
                        *(f32x4*)dst = acc[ai][0][m][0]; *(f32x4*)(dst + 4) = acc[ai][0][m][1]; } }
        }
    }
};
struct EpiHloc { static constexpr int NB = 0; __device__ __forceinline__ void prefetch(const GUnit&, f32x4 (&b)[4]) const { }
    static constexpr bool PERM = false; float* hloc;
    __device__ __forceinline__ void operator()(const f32x4 (&acc)[2][2][4][2], const GUnit& u, int wr, int wc, int fr, int fq, const f32x4 (&pb)[4]) const {
        const int row0 = u.pm * 256 + wr * 64 + fr;
#pragma unroll
        for (int ai = 0; ai < 2; ++ai)
#pragma unroll
            for (int m = 0; m < 4; ++m) { float* rowp = hloc + ((size_t)u.grp * NCHP + row0 + ai * 128 + m * 16) * 256 + wc * 32 + 4 * fq;
#pragma unroll
                for (int bj = 0; bj < 2; ++bj)
#pragma unroll
                    for (int n = 0; n < 2; ++n) *(f32x4*)(rowp + bj * 128 + n * 16) = acc[ai][bj][m][n]; }
    }
};
struct EpiS5Y { static constexpr int NB = 0; __device__ __forceinline__ void prefetch(const GUnit&, f32x4 (&b)[4]) const { }
    static constexpr bool PERM = true; bf16_t* ys5;
    __device__ __forceinline__ void operator()(const f32x4 (&acc)[2][2][4][2], const GUnit& u, int wr, int wc, int fr, int fq, const f32x4 (&pb)[4]) const {
        const int row0 = u.pm * 256 + wr * 64 + fr;
#pragma unroll
        for (int ai = 0; ai < 2; ++ai)
#pragma unroll
            for (int m = 0; m < 4; ++m) { const int c = row0 + ai * 128 + m * 16;
                if (c < NCH) {
#pragma unroll
                    for (int bj = 0; bj < 2; ++bj) { const int j0 = u.pn * 256 + bj * 128 + wc * 32 + 8 * fq, t = j0 >> 4, h0 = j0 & 15;
                        f32x4 v0 = acc[ai][bj][m][0], v1 = acc[ai][bj][m][1];
#pragma unroll
                        for (int j = 0; j < 4; ++j) { v0[j] = gelu_tanh(v0[j]); v1[j] = gelu_tanh(v1[j]); }
                        u32x4 w; w.x = cvt_pk_bf16(v0[0], v0[1]); w.y = cvt_pk_bf16(v0[2], v0[3]); w.z = cvt_pk_bf16(v1[0], v1[1]); w.w = cvt_pk_bf16(v1[2], v1[3]);
                        *(u32x4*)(ys5 + (size_t)(c * 64 + t) * 256 + u.grp * 16 + h0) = w; } } }
    }
};
struct EpiGlu { static constexpr int NB = 4; static constexpr bool PERM = true; const bf16_t* ys5; bf16_t* mixed; const float* bias;
    __device__ __forceinline__ void prefetch(const GUnit&, f32x4 (&b)[4]) const {
        const int _t = opq((int)threadIdx.x), _w = __builtin_amdgcn_readfirstlane(_t >> 6), _l = _t & 63, wc = _w & 3, fq = _l >> 4;
        const float* bp = bias + wc * 32 + 8 * fq; pg8::gld128_asm(b[0], bp); pg8::gld128_asm(b[1], bp + 4); pg8::gld128_asm(b[2], bp + 128); pg8::gld128_asm(b[3], bp + 132); }
    __device__ __forceinline__ void operator()(const f32x4 (&acc)[2][2][4][2], const GUnit& u, int wr, int wc, int fr, int fq, const f32x4 (&pb)[4]) const {
        const int row0 = u.pm * 256 + wr * 64 + fr;
#pragma unroll
        for (int bj = 0; bj < 2; ++bj) { const int n0 = bj * 128 + wc * 32 + 8 * fq;
            const f32x4 b0 = pb[2 * bj], b1 = pb[2 * bj + 1];
#pragma unroll
            for (int ai = 0; ai < 2; ++ai)
#pragma unroll
                for (int m = 0; m < 4; ++m) { const int tok = row0 + ai * 128 + m * 16;
                    const u32x4 yv = *(const u32x4*)(ys5 + (size_t)tok * 256 + n0);
                    const f32x4 v0 = acc[ai][bj][m][0] + b0, v1 = acc[ai][bj][m][1] + b1;
                    float o[8];
                    o[0] = bf2f(yv.x & 0xffffu) * sigmoidf_(v0[0]); o[1] = bf2f(yv.x >> 16) * sigmoidf_(v0[1]); o[2] = bf2f(yv.y & 0xffffu) * sigmoidf_(v0[2]); o[3] = bf2f(yv.y >> 16) * sigmoidf_(v0[3]);
                    o[4] = bf2f(yv.z & 0xffffu) * sigmoidf_(v1[0]); o[5] = bf2f(yv.z >> 16) * sigmoidf_(v1[1]); o[6] = bf2f(yv.w & 0xffffu) * sigmoidf_(v1[2]); o[7] = bf2f(yv.w >> 16) * sigmoidf_(v1[3]);
                    u32x4 w; w.x = cvt_pk_bf16(o[0], o[1]); w.y = cvt_pk_bf16(o[2], o[3]); w.z = cvt_pk_bf16(o[4], o[5]); w.w = cvt_pk_bf16(o[6], o[7]);
                    *(u32x4*)(mixed + (size_t)tok * 1024 + 768 + n0) = w; asm volatile("" ::: "memory"); } }
    }
};
struct EpiF32 { static constexpr int NB = 0; __device__ __forceinline__ void prefetch(const GUnit&, f32x4 (&b)[4]) const { }
    static constexpr bool PERM = false; float* C; int ldc;
    __device__ __forceinline__ void operator()(const f32x4 (&acc)[2][2][4][2], const GUnit& u, int wr, int wc, int fr, int fq, const f32x4 (&pb)[4]) const {
        const int row0 = u.pm * 256 + wr * 64 + fr, col0 = u.pn * 256 + wc * 32 + 4 * fq;
#pragma unroll
        for (int ai = 0; ai < 2; ++ai)
#pragma unroll
            for (int m = 0; m < 4; ++m) { float* rowp = C + (size_t)(row0 + ai * 128 + m * 16) * ldc + col0;
#pragma unroll
                for (int bj = 0; bj < 2; ++bj)
#pragma unroll
                    for (int n = 0; n < 2; ++n) *(f32x4*)(rowp + bj * 128 + n * 16) = acc[ai][bj][m][n]; }
    }
};
struct EpiBf16 { static constexpr int NB = 0; __device__ __forceinline__ void prefetch(const GUnit&, f32x4 (&b)[4]) const { }
    static constexpr bool PERM = true; bf16_t* C; int ldc;
    __device__ __forceinline__ void operator()(const f32x4 (&acc)[2][2][4][2], const GUnit& u, int wr, int wc, int fr, int fq, const f32x4 (&pb)[4]) const {
        const int row0 = u.pm * 256 + wr * 64 + fr, col0 = u.pn * 256 + wc * 32 + 8 * fq;
#pragma unroll
        for (int ai = 0; ai < 2; ++ai)
#pragma unroll
            for (int m = 0; m < 4; ++m) { bf16_t* rowp = C + (size_t)(row0 + ai * 128 + m * 16) * ldc + col0;
#pragma unroll
                for (int bj = 0; bj < 2; ++bj) { const f32x4 v0 = acc[ai][bj][m][0], v1 = acc[ai][bj][m][1];
                    u32x4 w; w.x = cvt_pk_bf16(v0[0], v0[1]); w.y = cvt_pk_bf16(v0[2], v0[3]); w.z = cvt_pk_bf16(v1[0], v1[1]); w.w = cvt_pk_bf16(v1[2], v1[3]);
                    *(u32x4*)(rowp + bj * 128) = w; } }
    }
};
constexpr float WUP_SCALE = 32.0f, WDN_SCALE = 64.0f;
struct EpiUp { static constexpr int NB = 2; static constexpr bool PERM = true; unsigned char* act; const bf16_t* bup16;
    __device__ __forceinline__ void prefetch(const GUnit& u, f32x4 (&b)[4]) const {
        const int _t = opq((int)threadIdx.x), _w = __builtin_amdgcn_readfirstlane(_t >> 6), _l = _t & 63, wc = _w & 3, fq = _l >> 4;
        const float* bg = (const float*)(bup16 + (((size_t)u.grp * 8 + u.pn) * 16 + wc * 4 + fq) * 16);
        pg8::gld128_asm(b[0], bg); pg8::gld128_asm(b[1], bg + 4); }
    __device__ __forceinline__ void operator()(const f32x4 (&acc)[2][2][4][2], const GUnit& u, int wr, int wc, int fr, int fq, const f32x4 (&pb)[4]) const {
        const int row0 = u.pm * 256 + wr * 64 + fr, jj0 = wc * 32 + 8 * fq;
        const u32x4 w0 = __builtin_bit_cast(u32x4, pb[0]), w1 = __builtin_bit_cast(u32x4, pb[1]);
        const f32x4 g0 = (f32x4){bf2f(w0.x & 0xffffu), bf2f(w0.x >> 16), bf2f(w0.y & 0xffffu), bf2f(w0.y >> 16)}, g1 = (f32x4){bf2f(w0.z & 0xffffu), bf2f(w0.z >> 16), bf2f(w0.w & 0xffffu), bf2f(w0.w >> 16)};
        const f32x4 l0 = (f32x4){bf2f(w1.x & 0xffffu), bf2f(w1.x >> 16), bf2f(w1.y & 0xffffu), bf2f(w1.y >> 16)}, l1 = (f32x4){bf2f(w1.z & 0xffffu), bf2f(w1.z >> 16), bf2f(w1.w & 0xffffu), bf2f(w1.w >> 16)};
        const f32x4 l0p = l0 + 1.0f, l1p = l1 + 1.0f;
#pragma unroll
        for (int ai = 0; ai < 2; ++ai)
#pragma unroll
            for (int m = 0; m < 4; ++m) { const int slot = row0 + ai * 128 + m * 16;
                float o[8];
#pragma unroll
                for (int hh = 0; hh < 2; ++hh) { const f32x4 ag = acc[ai][0][m][hh], al = acc[ai][1][m][hh], gb = hh ? g1 : g0, lb = hh ? l1p : l0p;
#pragma unroll
                    for (int j = 0; j < 4; j += 2) {
                        const f32x2 s2 = (f32x2){1.0f / WUP_SCALE, 1.0f / WUP_SCALE};
                        f32x2 xg = __builtin_elementwise_fma((f32x2){ag[j], ag[j + 1]}, s2, (f32x2){gb[j], gb[j + 1]});
                        f32x2 xl = __builtin_elementwise_fma((f32x2){al[j], al[j + 1]}, s2, (f32x2){lb[j], lb[j + 1]});
                        const f32x2 a = (f32x2){fminf(xg.x, 7.0f), fminf(xg.y, 7.0f)};
                        const f32x2 b1 = (f32x2){__builtin_amdgcn_fmed3f(xl.x, -6.0f, 8.0f), __builtin_amdgcn_fmed3f(xl.y, -6.0f, 8.0f)};
                        const f32x2 te = a * (f32x2){-2.4554669595930157f, -2.4554669595930157f};
                        const f32x2 den = (f32x2){__builtin_amdgcn_exp2f(te.x), __builtin_amdgcn_exp2f(te.y)} + (f32x2){1.0f, 1.0f};
                        const f32x2 r = (f32x2){rcpf(den.x), rcpf(den.y)};
                        const f32x2 res = (a * r) * b1; o[4 * hh + j] = res.x; o[4 * hh + j + 1] = res.y; } }
                u32x2 w; w.x = pk4_fp8(o[0], o[1], o[2], o[3]); w.y = pk4_fp8(o[4], o[5], o[6], o[7]);
                *(u32x2*)(act + (size_t)slot * 1024 + u.pn * 128 + jj0) = w; }
    }
};
constexpr float YV_SCALE = 16.0f;
struct EpiDown { static constexpr int NB = 2; static constexpr bool PERM = true; unsigned char* yv; const bf16_t* bdn16;
    __device__ __forceinline__ void prefetch(const GUnit& u, f32x4 (&b)[4]) const {
        const int _t = opq((int)threadIdx.x), _w = __builtin_amdgcn_readfirstlane(_t >> 6), _l = _t & 63, wc = _w & 3, fq = _l >> 4;
        const float* bp = (const float*)(bdn16 + (((size_t)u.grp * 4 + u.pn) * 16 + wc * 4 + fq) * 16);
        pg8::gld128_asm(b[0], bp); pg8::gld128_asm(b[1], bp + 4); }
    __device__ __forceinline__ void operator()(const f32x4 (&acc)[2][2][4][2], const GUnit& u, int wr, int wc, int fr, int fq, const f32x4 (&pb)[4]) const {
        const int row0 = u.pm * 256 + wr * 64 + fr;
#pragma unroll
        for (int bj = 0; bj < 2; ++bj) { const int col = u.pn * 256 + bj * 128 + wc * 32 + 8 * fq;
            const u32x4 wb = __builtin_bit_cast(u32x4, pb[bj]);
            const f32x4 b0 = (f32x4){bf2f(wb.x & 0xffffu), bf2f(wb.x >> 16), bf2f(wb.y & 0xffffu), bf2f(wb.y >> 16)}, b1 = (f32x4){bf2f(wb.z & 0xffffu), bf2f(wb.z >> 16), bf2f(wb.w & 0xffffu), bf2f(wb.w >> 16)};
#pragma unroll
            for (int ai = 0; ai < 2; ++ai)
#pragma unroll
                for (int m = 0; m < 4; ++m) { const int slot = row0 + ai * 128 + m * 16;
                    const f32x4 v0 = (acc[ai][bj][m][0] * (1.0f / WDN_SCALE) + b0) * YV_SCALE, v1 = (acc[ai][bj][m][1] * (1.0f / WDN_SCALE) + b1) * YV_SCALE;
                    u32x2 w; w.x = pk4_fp8(v0[0], v0[1], v0[2], v0[3]); w.y = pk4_fp8(v1[0], v1[1], v1[2], v1[3]);
                    *(u32x2*)(yv + (size_t)slot * 1024 + col) = w; } }
    }
};

__device__ __forceinline__ bf16x8 frag_lds(const LAS unsigned char* base, int row, int pitch_bytes, int k0, int lane) {
    return *(const LAS bf16x8*)(base + (row + (lane & 15)) * pitch_bytes + (k0 + 8 * (lane >> 4)) * 2);
}
__device__ __forceinline__ bf16x8 frag_glb(const bf16_t* base, size_t row, int pitch_elems, int k0, int lane) {
    return *(const bf16x8*)(base + (row + (lane & 15)) * (size_t)pitch_elems + k0 + 8 * (lane >> 4));
}
#define MFMA16(x, y, acc) __builtin_amdgcn_mfma_f32_16x16x32_bf16((x), (y), (acc), 0, 0, 0)

__device__ __forceinline__ void tr_item(const float* W, int ldw, int k0, int n0, bf16_t* dst, int r0, int ldd, LAS float* scr, int lane) {
    float wv[32];
#pragma unroll
    for (int i = 0; i < 32; ++i) wv[i] = W[(size_t)(k0 + 2 * i + (lane >> 5)) * ldw + n0 + (lane & 31)];
#pragma unroll
    for (int i = 0; i < 32; ++i) scr[(2 * i + (lane >> 5)) * 33 + (lane & 31)] = wv[i];
    asm volatile("s_waitcnt lgkmcnt(0)" ::: "memory");
    const int c = lane & 7;
#pragma unroll
    for (int j = 0; j < 4; ++j) { const int n = (lane >> 3) + 8 * j; const LAS float* s = scr + (8 * c) * 33 + n;
        u32x4 o; o.x = pk2(s[0 * 33], s[1 * 33]); o.y = pk2(s[2 * 33], s[3 * 33]); o.z = pk2(s[4 * 33], s[5 * 33]); o.w = pk2(s[6 * 33], s[7 * 33]);
        *(u32x4*)(dst + (size_t)(r0 + n) * ldd + k0 + 8 * c) = o; }
    asm volatile("s_waitcnt lgkmcnt(0)" ::: "memory");
}

__device__ __forceinline__ void tr_item_fp8(const float* W, int ldw, int k0, int n0, unsigned char* dst, int r0, int ldd, float scale, LAS float* scr, int lane) {
    float wv[32];
#pragma unroll
    for (int i = 0; i < 32; ++i) wv[i] = W[(size_t)(k0 + 2 * i + (lane >> 5)) * ldw + n0 + (lane & 31)];
#pragma unroll
    for (int i = 0; i < 32; ++i) scr[(2 * i + (lane >> 5)) * 33 + (lane & 31)] = wv[i] * scale;
    asm volatile("s_waitcnt lgkmcnt(0)" ::: "memory");
#pragma unroll
    for (int j = 0; j < 2; ++j) { const int idx = lane + 64 * j, n = idx >> 2, c = idx & 3; const LAS float* s = scr + (16 * c) * 33 + n;
        u32x4 o; o.x = pk4_fp8(s[0 * 33], s[1 * 33], s[2 * 33], s[3 * 33]); o.y = pk4_fp8(s[4 * 33], s[5 * 33], s[6 * 33], s[7 * 33]);
        o.z = pk4_fp8(s[8 * 33], s[9 * 33], s[10 * 33], s[11 * 33]); o.w = pk4_fp8(s[12 * 33], s[13 * 33], s[14 * 33], s[15 * 33]);
        *(u32x4*)(dst + (size_t)(r0 + n) * ldd + k0 + 16 * c) = o; }
    asm volatile("s_waitcnt lgkmcnt(0)" ::: "memory");
}
__device__ __forceinline__ void tr_item_fp8_64n(const float* W, int ldw, int k0, int n0, unsigned char* dst, int r0, int ldd, float scale, LAS float* scr, int lane) {
    const int n4 = lane & 15, kq = lane >> 4;
    LAS unsigned* sw = (LAS unsigned*)scr;
    f32x4 wv[32];
#pragma unroll
    for (int j = 0; j < 32; ++j) wv[j] = *(const f32x4*)(W + (size_t)(k0 + 16 * (j >> 2) + 4 * kq + (j & 3)) * ldw + n0 + 4 * n4);
#pragma unroll
    for (int jj = 0; jj < 8; ++jj)
#pragma unroll
        for (int m = 0; m < 4; ++m) sw[(4 * n4 + m) * 33 + 4 * jj + kq] = pk4_fp8(wv[jj * 4 + 0][m] * scale, wv[jj * 4 + 1][m] * scale, wv[jj * 4 + 2][m] * scale, wv[jj * 4 + 3][m] * scale);
    asm volatile("s_waitcnt lgkmcnt(0)" ::: "memory");
#pragma unroll
    for (int j = 0; j < 8; ++j) { const int idx = lane + 64 * j, n = idx >> 3, c = idx & 7; const LAS unsigned* s = sw + n * 33 + 4 * c;
        *(u32x4*)(dst + (size_t)(r0 + n) * ldd + k0 + 16 * c) = (u32x4){s[0], s[1], s[2], s[3]}; }
    asm volatile("s_waitcnt lgkmcnt(0)" ::: "memory");
}
constexpr int CONV_PER_WG = 8, CONV_N = 12288, CONV_B_GO = 216 * CONV_PER_WG, CONV_B_GLU = CONV_B_GO + 32 * CONV_PER_WG + 32 * 3 * CONV_PER_WG, CONV_B_OUT = CONV_B_GLU + 124 * CONV_PER_WG, CONV_Q012 = CONV_B_OUT + 240 * CONV_PER_WG, CONV_Q3 = CONV_B_OUT;
constexpr int CONV_DN = 64 * CONV_PER_WG;
__host__ __device__ constexpr int conv_q(int l) { return (l < 3 ? CONV_Q012 : CONV_Q3) + (l > 0 ? CONV_DN : 0); }
__device__ __forceinline__ void conv_expert_item(CArgsP A, unsigned char* ws, int l, int idx, LAS float* scr, int lane) {
    if (idx < 8192) { const int e = idx >> 8, q = idx & 255, kb = q >> 5, nb = q & 31, n0 = 64 * nb, half = n0 >> 10, within = n0 & 1023, ct = within >> 7, jj0 = within & 127, le = l * 32 + e;
        tr_item_fp8_64n(GIN(A, 29) + (size_t)le * 1024 * 2048, 2048, 128 * kb, n0, (unsigned char*)(ws + WS_WUP) + (size_t)le * 2048 * 1024, 256 * ct + 128 * half + jj0, 1024, WUP_SCALE, scr, lane); }
    else { const int r = idx - 8192, e = r >> 7, q = r & 127, kb = q >> 4, nb = q & 15, le = l * 32 + e;
        tr_item_fp8_64n(GIN(A, 31) + (size_t)le * 1024 * 1024, 1024, 128 * kb, 64 * nb, (unsigned char*)(ws + WS_WDN) + (size_t)le * 1024 * 1024, 64 * nb, 1024, WDN_SCALE, scr, lane); }
}
__device__ __forceinline__ void conv_slot(const Frame& F0, CArgsP A, int l, int base, int j, int per = CONV_PER_WG) {
    Frame F = F0; F.tid = opq(F0.tid); F.lane = F.tid & 63; F.wave = __builtin_amdgcn_readfirstlane(F.tid >> 6); F.ws = opq_p(F0.ws); F.lds = opq_l(F0.lds);
    asm volatile("s_waitcnt vmcnt(0)" ::: "memory"); __syncthreads();
    LAS float* scr = (LAS float*)(F.lds + F.wave * 16896);
    for (int it = F.wave; it < per; it += NWAVES) { const int idx = base + j * per + it; if (idx < CONV_N) conv_expert_item(A, F.ws, l, idx, scr, F.lane); }
}
__device__ __forceinline__ void ph0_prologue(const Frame& F0, CArgsP A) {
    Frame F = F0; F.tid = opq(F0.tid); F.lane = F.tid & 63; F.wave = __builtin_amdgcn_readfirstlane(F.tid >> 6); F.ws = opq_p(F0.ws); F.bid = opq_s(F0.bid); F.G = opq_s(F0.G); F.lds = opq_l(F0.lds); F.CTLW = (volatile LAS unsigned*)(F.lds + LDSCTL_OFF);
    unsigned char* ws = F.ws;
    {
        LAS float* sc = (LAS float*)F.lds;
        LAS float* part = sc + 640;
        const float* cvec = GIN(A, 1); const float* cctx = GIN(A, 3); const float* wmod = GIN(A, 4);
        float* modp = (float*)(ws + WS_MODP);
        for (int u = F.bid; u < 768; u += F.G) {
            const int l = u / 192, r = u % 192, cb = r >> 3, ks = r & 7;
            const int col = cb * 256 + (F.tid & 255), kh = F.tid >> 8;
            const float* wp = wmod + ((size_t)l * 1024 + ks * 128 + kh * 64) * 6144 + col;
            float wk[64];
#pragma unroll
            for (int kk = 0; kk < 64; ++kk) wk[kk] = wp[(size_t)kk * 6144];
            for (int i = F.tid; i < 640; i += NTHR) { const int v = i >> 7, kk = i & 127; const float x = v < 4 ? cvec[v * 1024 + ks * 128 + kk] : cctx[ks * 128 + kk]; sc[i] = siluf_(x); }
            __syncthreads();
            float a0 = 0.f, a1 = 0.f, a2 = 0.f, a3 = 0.f, a4 = 0.f;
#pragma unroll
            for (int kk = 0; kk < 64; ++kk) { const float w = wk[kk]; const int sk = kh * 64 + kk;
                a0 += sc[sk] * w; a1 += sc[128 + sk] * w; a2 += sc[256 + sk] * w; a3 += sc[384 + sk] * w; a4 += sc[512 + sk] * w; }
            if (kh == 1) { const int c = F.tid & 255; part[c] = a0; part[256 + c] = a1; part[512 + c] = a2; part[768 + c] = a3; part[1024 + c] = a4; }
            __syncthreads();
            if (kh == 0) { const int c = F.tid & 255; float* o = modp + ((size_t)(ks * 4 + l) * 5) * 6144 + col;
                o[0] = a0 + part[c]; o[6144] = a1 + part[256 + c]; o[2 * 6144] = a2 + part[512 + c]; o[3 * 6144] = a3 + part[768 + c]; o[4 * 6144] = a4 + part[1024 + c]; }
            __syncthreads();
        }
    }
    {
        LAS float* scr = (LAS float*)(F.lds + F.wave * 16896);
        const int gw = F.bid * NWAVES + F.wave, NGW = F.G * NWAVES;
        constexpr int LE0 = CONV_N - conv_q(0), LE1 = CONV_N - conv_q(1), LE2 = CONV_N - conv_q(2), LE3 = CONV_N - conv_q(3);
        constexpr int I_IN = 4 * 16 * 73, I_OUT = 4 * 16 * 32, I_EXP = LE0 + LE1 + LE2 + LE3, I_GLU = 4 * 4 * 8;
        constexpr int NITEMS = I_IN + I_OUT + I_EXP + I_GLU;
        for (int it = gw; it < NITEMS; it += NGW) {
            int r = it;
            if (r < I_IN) { const int l = r / 1168, q = r % 1168, kb = q / 73, nb = q % 73, n0 = 32 * nb;
                const int r0 = nb < 64 ? n0 : (nb == 64 ? 2304 : 2048 + (n0 - 2080));
                tr_item(GIN(A, 6) + (size_t)l * 1024 * NIN, NIN, 64 * kb, n0, (bf16_t*)(ws + WS_WIN) + (size_t)l * NINP * 1024, r0, 1024, scr, F.lane); continue; }
            r -= I_IN;
            if (r < I_OUT) { const int l = r / 512, q = r % 512, kb = q / 32, nb = q % 32;
                tr_item(GIN(A, 24) + (size_t)l * 1024 * 1024, 1024, 64 * kb, 32 * nb, (bf16_t*)(ws + WS_WOUT) + (size_t)l * 1024 * 1024, 32 * nb, 1024, scr, F.lane); continue; }
            r -= I_OUT;
            if (r < I_EXP) { const int l = r < LE0 ? 0 : (r < LE0 + LE1 ? 1 : (r < LE0 + LE1 + LE2 ? 2 : 3)); const int idx = conv_q(l) + r - (l == 0 ? 0 : (l == 1 ? LE0 : (l == 2 ? LE0 + LE1 : LE0 + LE1 + LE2)));
                conv_expert_item(A, ws, l, idx, scr, F.lane); continue; }
            r -= I_EXP;
            { const int l = r / 32, q = r % 32, kb = q / 8, nb = q % 8;
                tr_item(GIN(A, 22) + (size_t)l * 256 * 256, 256, 64 * kb, 32 * nb, (bf16_t*)(ws + WS_GLUT) + (size_t)l * 256 * 256, 32 * nb, 256, scr, F.lane); }
        }
        const int gt = F.bid * NTHR + F.tid, NGT = F.G * NTHR;
        for (int i = gt; i < 4 * 224 * 128; i += NGT) { const int l = i / (224 * 128), q = i % (224 * 128);
            *(u32x4*)((bf16_t*)(ws + WS_WIN) + ((size_t)l * NINP + 2336) * 1024 + (size_t)q * 8) = (u32x4){0u, 0u, 0u, 0u}; }
        { const float* bu = GIN(A, 30); bf16_t* bo = (bf16_t*)(ws + WS_BUP);
            for (int i = gt; i < 4 * 32 * 2048; i += NGT) { const int le = i >> 11, r = i & 2047, ct = r >> 8, wc = (r >> 6) & 3, fq = (r >> 4) & 3, j = r & 15;
                const int col = (j < 8 ? 0 : 1024) + ct * 128 + wc * 32 + fq * 8 + (j & 7); bo[i] = (bf16_t)f2bf(bu[(size_t)le * 2048 + col]); } }
        { const float* bd = GIN(A, 32); bf16_t* bo = (bf16_t*)(ws + WS_BDN);
            for (int i = gt; i < 4 * 32 * 1024; i += NGT) { const int le = i >> 10, r = i & 1023, ct = r >> 8, wc = (r >> 6) & 3, fq = (r >> 4) & 3, j = r & 15;
                const int col = ct * 256 + (j >> 3) * 128 + wc * 32 + fq * 8 + (j & 7); bo[i] = (bf16_t)f2bf(bd[(size_t)le * 1024 + col]); } }
        { const float* rw = GIN(A, 27); float* wrt = (float*)(ws + WS_WRT);
            bf16_t* wh = (bf16_t*)(ws + WS_WRH); bf16_t* wl = (bf16_t*)(ws + WS_WRL);
            for (int i = gt; i < 4 * D * NEXP; i += NGT) { const int l = i >> 15, q = i & 32767, e = q >> 10, k = q & 1023; const float w = rw[(size_t)l * 32768 + k * 32 + e]; wrt[i] = w;
                const unsigned hb = f2bf(w); wh[i] = (bf16_t)hb; wl[i] = (bf16_t)f2bf(w - bf2f(hb)); } }
        const float* sw = GIN(A, 9); bf16_t* swo = (bf16_t*)(ws + WS_SGUW);
        for (int i = gt; i < 4 * 4 * 128 * 128 / 4; i += NGT) { const f32x4 v = *(const f32x4*)(sw + (size_t)i * 4); u32x2 o; o.x = pk2(v[0], v[1]); o.y = pk2(v[2], v[3]); *(u32x2*)(swo + (size_t)i * 4) = o; }
    }
    __syncthreads();
    {
        LAS f32x2* LP = (LAS f32x2*)F.lds;
        LAS f32x2* BB = LP + 2 * 65 * 64;
        LAS f32x2* CC = BB + 2 * 64 * 16;
        const float* lam_re = GIN(A, 14); const float* lam_im = GIN(A, 15); const float* log_dt = GIN(A, 16);
        const float* b_re = GIN(A, 17); const float* b_im = GIN(A, 18); const float* c_re = GIN(A, 19); const float* c_im = GIN(A, 20);
        for (int uq = F.bid; uq < 256; uq += F.G) {
            const int u = uq >> 2, qd = uq & 3, l = u >> 4, g = u & 15;
            LAS f32x2* QQ = CC + 2 * 16 * 64;
            if (F.tid < 256) { const int z = (F.tid >> 6) & 1, p = F.tid & 63;
                const int idx = ((l * 2 + z) * 16 + g) * 64 + p; const double dt = exp((double)log_dt[(l * 2 + z) * 16 + g]);
                const double lr = lam_re[idx], li = lam_im[idx]; const double mag = exp(lr * dt), ang = li * dt; double sn, cs; sincos(ang, &sn, &cs);
                const double wr = mag * cs, wi = mag * sn;
                if (F.tid < 128) {
                    double ar = 1.0, ai = 0.0;
                    for (int n = 0; n < 65; ++n) { LP[(z * 65 + n) * 64 + p] = (f32x2){(float)ar, (float)ai};
                        if (n == 64 && qd == 0) *(f32x2*)((float*)(ws + WS_LB64) + (size_t)idx * 2) = (f32x2){(float)ar, (float)ai};
                        const double nr2 = ar * wr - ai * wi; ai = ar * wi + ai * wr; ar = nr2; }
                } else { const double nr = wr - 1.0, ni = wi, den = lr * lr + li * li;
                    QQ[z * 64 + p] = (f32x2){(float)((nr * lr + ni * li) / den), (float)((ni * lr - nr * li) / den)}; } }
            __syncthreads();
            for (int i = F.tid; i < 2 * 64 * 16; i += NTHR) { const int z = i >> 10, p = (i >> 4) & 63, h = i & 15;
                const int idx = ((l * 2 + z) * 16 + g) * 64 + p; const f32x2 q = QQ[z * 64 + p];
                const float br = b_re[(size_t)idx * 16 + h], bi = b_im[(size_t)idx * 16 + h];
                BB[i] = (f32x2){q.x * br - q.y * bi, q.x * bi + q.y * br}; }
            for (int i = F.tid; i < 2 * 16 * 64; i += NTHR) { const int z = i >> 10, h = (i >> 6) & 15, p = i & 63;
                const size_t idx = ((size_t)((l * 2 + z) * 16 + g) * 16 + h) * 64 + p; CC[i] = (f32x2){c_re[idx], c_im[idx]}; }
            __syncthreads();
            float* KT = (float*)(ws + WS_KTAB) + (size_t)u * 32768;
            {
                const int h = (F.tid >> 4) & 15, h2 = F.tid & 15, t0 = qd * 16 + (F.tid >> 8);
                for (int zz = 0; zz < 2; ++zz) { float acc8[8];
#pragma unroll
                    for (int jj = 0; jj < 8; ++jj) acc8[jj] = 0.f;
                    for (int p = 0; p < 64; ++p) { const f32x2 c = CC[(zz * 16 + h) * 64 + p], b = BB[(zz * 64 + p) * 16 + h2]; const float cbr = c.x * b.x - c.y * b.y, cbi = c.x * b.y + c.y * b.x;
#pragma unroll
                        for (int jj = 0; jj < 8; ++jj) { const f32x2 w = LP[(zz * 65 + t0 + 2 * jj) * 64 + p]; acc8[jj] += cbr * w.x - cbi * w.y; } }
#pragma unroll
                    for (int jj = 0; jj < 8; ++jj) KT[((zz * 64 + t0 + 2 * jj) * 16 + h) * 16 + h2] = acc8[jj]; } }
            bf16_t* Mo = (bf16_t*)(ws + WS_S5M) + (size_t)u * 1024 * S5K;
            for (int it = F.tid; it < 256 * 32; it += NTHR) { const int row = qd * 256 + (it >> 5), cv = 128 + (it & 31), t = row >> 4, h = row & 15; float v[8];
                const int idx0 = (cv - 128) * 8, z = idx0 >> 7, p0 = (idx0 & 127) >> 1, n = z == 0 ? t + 1 : 64 - t;
#pragma unroll
                for (int i = 0; i < 8; ++i) { const int p = p0 + (i >> 1); const f32x2 c = CC[(z * 16 + h) * 64 + p], w = LP[(z * 65 + n) * 64 + p];
                    v[i] = (i & 1) ? -(c.x * w.y + c.y * w.x) : (c.x * w.x - c.y * w.y); }
                u32x4 o; o.x = pk2(v[0], v[1]); o.y = pk2(v[2], v[3]); o.z = pk2(v[4], v[5]); o.w = pk2(v[6], v[7]);
                *(u32x4*)(Mo + (size_t)row * S5K + cv * 8) = o; }
            bf16_t* Fo = (bf16_t*)(ws + WS_S5F) + (size_t)u * 256 * 1024;
            for (int it = F.tid; it < 64 * 128; it += NTHR) { const int r = qd * 64 + (it >> 7), cv = it & 127, z = r >> 7, p = (r & 127) >> 1, ri = r & 1, s = cv >> 1, h0 = (cv & 1) * 8, m = z == 0 ? 63 - s : s;
                const f32x2 w = LP[(z * 65 + m) * 64 + p]; float v[8];
#pragma unroll
                for (int i = 0; i < 8; ++i) { const f32x2 b = BB[(z * 64 + p) * 16 + h0 + i]; v[i] = ri ? (w.x * b.y + w.y * b.x) : (w.x * b.x - w.y * b.y); }
                u32x4 o; o.x = pk2(v[0], v[1]); o.y = pk2(v[2], v[3]); o.z = pk2(v[4], v[5]); o.w = pk2(v[6], v[7]);
                *(u32x4*)(Fo + (size_t)r * 1024 + cv * 8) = o; }
            __syncthreads();
        }
    }
}

__device__ __forceinline__ void ph1_mod(const Frame& F0, CArgsP A) {
    Frame F = F0; F.tid = opq(F0.tid); F.lane = F.tid & 63; F.wave = __builtin_amdgcn_readfirstlane(F.tid >> 6); F.ws = opq_p(F0.ws); F.bid = opq_s(F0.bid); F.G = opq_s(F0.G); F.lds = opq_l(F0.lds); F.CTLW = (volatile LAS unsigned*)(F.lds + LDSCTL_OFF);
    const float* modp = (const float*)(F.ws + WS_MODP); float* mod = (float*)(F.ws + WS_MOD); const float* bmod = GIN(A, 5);
    for (int i = F.bid * NTHR + F.tid; i < 4 * 5 * 6144; i += F.G * NTHR) { const int l = i / 30720, j = i % 6144; float s = bmod[l * 6144 + j];
#pragma unroll
        for (int ks = 0; ks < 8; ++ks) s += modp[(size_t)ks * 122880 + i];
        mod[i] = s; }
    const float* dsk = GIN(A, 21);
    for (int it = F.bid * NTHR + F.tid; it < 64 * 1024 * 128; it += F.G * NTHR) { const int u = it >> 17, r = it & 131071, row = r >> 7, cv = r & 127, t = row >> 4, h = row & 15, s = cv >> 1, h0 = (cv & 1) * 8;
        const float* KT = (const float*)(F.ws + WS_KTAB) + (size_t)u * 32768; float v[8];
        if (s < t) { const f32x4 a = *(const f32x4*)(KT + ((0 * 64 + (t - s)) * 16 + h) * 16 + h0), b = *(const f32x4*)(KT + ((0 * 64 + (t - s)) * 16 + h) * 16 + h0 + 4);
            v[0] = a[0]; v[1] = a[1]; v[2] = a[2]; v[3] = a[3]; v[4] = b[0]; v[5] = b[1]; v[6] = b[2]; v[7] = b[3]; }
        else if (s > t) { const f32x4 a = *(const f32x4*)(KT + ((1 * 64 + (s - t)) * 16 + h) * 16 + h0), b = *(const f32x4*)(KT + ((1 * 64 + (s - t)) * 16 + h) * 16 + h0 + 4);
            v[0] = a[0]; v[1] = a[1]; v[2] = a[2]; v[3] = a[3]; v[4] = b[0]; v[5] = b[1]; v[6] = b[2]; v[7] = b[3]; }
        else { const float* k0 = KT + ((0 * 64 + 0) * 16 + h) * 16 + h0; const float* k1 = KT + ((1 * 64 + 0) * 16 + h) * 16 + h0; const float dd = dsk[u * 16 + h];
#pragma unroll
            for (int i = 0; i < 8; ++i) v[i] = k0[i] + k1[i] + ((h0 + i == h) ? dd : 0.f); }
        u32x4 o; o.x = pk2(v[0], v[1]); o.y = pk2(v[2], v[3]); o.z = pk2(v[4], v[5]); o.w = pk2(v[6], v[7]);
        *(u32x4*)((bf16_t*)(F.ws + WS_S5M) + ((size_t)u * 1024 + row) * S5K + cv * 8) = o; }
}
__device__ __forceinline__ void ph2_init(const Frame& F0, CArgsP A) {
    Frame F = F0; F.tid = opq(F0.tid); F.lane = F.tid & 63; F.wave = __builtin_amdgcn_readfirstlane(F.tid >> 6); F.ws = opq_p(F0.ws); F.bid = opq_s(F0.bid); F.G = opq_s(F0.G); F.lds = opq_l(F0.lds); F.CTLW = (volatile LAS unsigned*)(F.lds + LDSCTL_OFF);
    const float* mod = (const float*)(F.ws + WS_MOD); bf16_t* X = (bf16_t*)(F.ws + WS_X); bf16_t* H = (bf16_t*)(F.ws + WS_H);
    const int stride = F.G * NWAVES;
    for (int tk = F.bid * NWAVES + F.wave; tk < T; tk += 2 * stride) {
        const int tk2 = tk + stride < T ? tk + stride : tk; const bool two = tk + stride < T;
        const float* src0 = tk < TLAT ? GIN(A, 0) + (size_t)tk * D : GIN(A, 2) + (size_t)(tk - TLAT) * D;
        const float* src1 = tk2 < TLAT ? GIN(A, 0) + (size_t)tk2 * D : GIN(A, 2) + (size_t)(tk2 - TLAT) * D;
        const float* mv0 = mod + (size_t)tok_vec(tk) * 6144; const float* mv1 = mod + (size_t)tok_vec(tk2) * 6144;
        f32x4 x0[4], x1[4];
#pragma unroll
        for (int j = 0; j < 4; ++j) { const int c = 4 * F.lane + 256 * j; x0[j] = *(const f32x4*)(src0 + c); x1[j] = *(const f32x4*)(src1 + c); }
#pragma unroll
        for (int j = 0; j < 4; ++j) { const int c = 4 * F.lane + 256 * j; const f32x4 x = x0[j], sh = *(const f32x4*)(mv0 + c), sc = *(const f32x4*)(mv0 + 1024 + c);
            *(u32x2*)(X + (size_t)tk * D + c) = pk4(x); const f32x4 h = x * (sc + 1.0f) + sh;
            u32x2 o; o.x = pk2(h[0], h[1]); o.y = pk2(h[2], h[3]); *(u32x2*)(H + (size_t)tk * D + c) = o; }
        if (two) {
#pragma unroll
            for (int j = 0; j < 4; ++j) { const int c = 4 * F.lane + 256 * j; const f32x4 x = x1[j], sh = *(const f32x4*)(mv1 + c), sc = *(const f32x4*)(mv1 + 1024 + c);
                *(u32x2*)(X + (size_t)tk2 * D + c) = pk4(x); const f32x4 h = x * (sc + 1.0f) + sh;
                u32x2 o; o.x = pk2(h[0], h[1]); o.y = pk2(h[2], h[3]); *(u32x2*)(H + (size_t)tk2 * D + c) = o; } }
    }
}

template <int Z> __device__ __forceinline__ void gla_cols(const LAS float* GLs, const LAS unsigned char* Qs, const LAS unsigned char* Ks, LAS unsigned char* KTrow, const float (&gu)[16], float gb,
                                                          bf16_t* QHp, bf16_t* KNp, float& tot) {
    float b = 0.f;
    const LAS float* gl0 = GLs + Z * 16;
    const int tf = Z ? 63 : 0;
    f32x4 g0 = *(const LAS f32x4*)(gl0 + tf * 32), g1 = *(const LAS f32x4*)(gl0 + tf * 32 + 4), g2 = *(const LAS f32x4*)(gl0 + tf * 32 + 8), g3 = *(const LAS f32x4*)(gl0 + tf * 32 + 12);
    unsigned qw = *(const LAS unsigned short*)(Qs + tf * 528), kw = *(const LAS unsigned short*)(Ks + tf * 528);
    for (int j = 0; j < 8; ++j) { const int tg = Z ? 7 - j : j; unsigned w[4] = {0u, 0u, 0u, 0u};
#pragma unroll
        for (int tt = 0; tt < 8; ++tt) { const int ti = Z ? 7 - tt : tt, t = tg * 8 + ti;
            const int tn = Z ? t - 1 : t + 1;
            const f32x4 n0 = *(const LAS f32x4*)(gl0 + tn * 32), n1 = *(const LAS f32x4*)(gl0 + tn * 32 + 4), n2 = *(const LAS f32x4*)(gl0 + tn * 32 + 8), n3 = *(const LAS f32x4*)(gl0 + tn * 32 + 12);
            const unsigned qn = *(const LAS unsigned short*)(Qs + tn * 528), kn2 = *(const LAS unsigned short*)(Ks + tn * 528);
            f32x2 pa = (f32x2){gb, 0.0f}, pb = (f32x2){0.0f, 0.0f};
            pa = __builtin_elementwise_fma((f32x2){g0[0], g0[1]}, (f32x2){gu[0], gu[1]}, pa); pb = __builtin_elementwise_fma((f32x2){g0[2], g0[3]}, (f32x2){gu[2], gu[3]}, pb);
            pa = __builtin_elementwise_fma((f32x2){g1[0], g1[1]}, (f32x2){gu[4], gu[5]}, pa); pb = __builtin_elementwise_fma((f32x2){g1[2], g1[3]}, (f32x2){gu[6], gu[7]}, pb);
            pa = __builtin_elementwise_fma((f32x2){g2[0], g2[1]}, (f32x2){gu[8], gu[9]}, pa); pb = __builtin_elementwise_fma((f32x2){g2[2], g2[3]}, (f32x2){gu[10], gu[11]}, pb);
            pa = __builtin_elementwise_fma((f32x2){g3[0], g3[1]}, (f32x2){gu[12], gu[13]}, pa); pb = __builtin_elementwise_fma((f32x2){g3[2], g3[3]}, (f32x2){gu[14], gu[15]}, pb);
            const f32x2 pc = pa + pb; const float s2 = pc.x + pc.y;
            const float ls2 = fminf(s2, 0.0f) - __builtin_amdgcn_logf(1.0f + __builtin_amdgcn_exp2f(-fabsf(s2)));
            b += ls2 * (1.0f / 16.0f);
            const float e = __builtin_amdgcn_exp2f(b), ri = rcpf(e);
            const float qv = bf2f(qw) * 0.125f, kv = bf2f(kw);
            const unsigned qk = cvt_pk_bf16(qv * e, kv * ri);
            QHp[(size_t)t * 512] = (bf16_t)(qk & 0xffffu); KNp[(size_t)t * 256] = (bf16_t)(qk >> 16);
            w[ti >> 1] |= (ti & 1) ? (qk & 0xffff0000u) : (qk >> 16);
            g0 = n0; g1 = n1; g2 = n2; g3 = n3; qw = qn; kw = kn2; asm volatile("" ::: "memory"); }
        *(LAS u32x4*)(KTrow + tg * 16) = (u32x4){w[0], w[1], w[2], w[3]}; }
    tot = b;
}
__device__ __forceinline__ void gla_local(const Frame& F0, CArgsP A, int l) {
    Frame F = F0; F.tid = opq(F0.tid); F.lane = F.tid & 63; F.wave = __builtin_amdgcn_readfirstlane(F.tid >> 6); F.ws = opq_p(F0.ws); F.bid = opq_s(F0.bid); F.G = opq_s(F0.G); F.lds = opq_l(F0.lds); F.CTLW = (volatile LAS unsigned*)(F.lds + LDSCTL_OFF);
    unsigned char* ws = F.ws;
    LAS float* GLs = (LAS float*)(F.lds + 128);
    LAS unsigned char* KTl = F.lds + 8192 + 256;
    LAS unsigned char* Qs = F.lds + 81920 + 1024;
    LAS unsigned char* Ks = Qs + 64 * 528;
    LAS float* DEC = (LAS float*)(Ks + 64 * 528);
    const int z = F.tid >> 8, col = F.tid & 255, hh = col >> 6, dd = col & 63;
#define GLA_STAGE_LD(chx) { const int tkx = (chx) * 64; const unsigned char* wsx = opq_p(ws); const bf16_t* projx = (const bf16_t*)(wsx + WS_PROJ); \
        glv = *(const f32x4*)((const float*)(wsx + WS_GL) + (size_t)tkx * 32 + 4 * F.tid); \
        _Pragma("unroll") for (int i = 0; i < 4; ++i) { const int idx = F.tid + NTHR * i, row = idx >> 5, c16 = idx & 31; \
            qv4[i] = *(const u32x4*)(projx + (size_t)(tkx + row) * PROJW + 512 + c16 * 8); kv4[i] = *(const u32x4*)(projx + (size_t)(tkx + row) * PROJW + 768 + c16 * 8); } }
#define GLA_STAGE_ST() { *(LAS f32x4*)(GLs + 4 * F.tid) = glv; \
        _Pragma("unroll") for (int i = 0; i < 4; ++i) { const int idx = F.tid + NTHR * i, row = idx >> 5, c16 = idx & 31; \
            *(LAS u32x4*)(Qs + row * 528 + c16 * 16) = qv4[i]; *(LAS u32x4*)(Ks + row * 528 + c16 * 16) = kv4[i]; } }
    f32x4 glv; u32x4 qv4[4], kv4[4];
    if (F.bid < NCH) { GLA_STAGE_LD(F.bid) GLA_STAGE_ST() }
    for (int ch = F.bid; ch < NCH; ch += F.G) {
        unsigned char* wsl = opq_p(ws);
        const bf16_t* proj = (const bf16_t*)(wsl + WS_PROJ); const float* gl = (const float*)(wsl + WS_GL);
        bf16_t* KN = (bf16_t*)(wsl + WS_KS); bf16_t* QH = (bf16_t*)(wsl + WS_QH); const bf16_t* VTg = (const bf16_t*)(wsl + WS_VT);
        bf16_t* glast = (bf16_t*)(wsl + WS_GLAST); float* gdec = (float*)(wsl + WS_GDEC);
        const int tk0 = ch * 64;
        bf16x8 yfp[2][2][4];
#pragma unroll
        for (int ks = 0; ks < 2; ++ks)
#pragma unroll
            for (int b = 0; b < 4; ++b) yfp[0][ks][b] = frag_glb(VTg, ((size_t)ch * 4 + (F.wave >> 1)) * 128 + b * 16, 64, ks * 32, F.lane);
        float gu[16];
        {   CArgsP Ax = argp();
#pragma unroll
            for (int r = 0; r < 16; ++r) gu[r] = GIN(Ax, 11)[(((size_t)l * 2 + z) * 16 + r) * 256 + col] * 1.4426950408889634f;
        }
        const float gb = GIN(argp(), 12)[((size_t)l * 2 + z) * 256 + col] * 1.4426950408889634f;
        __syncthreads();
        float tot;
        bf16_t* QHp = QH + ((size_t)tk0 * 4 + hh) * 128 + z * 64 + dd; bf16_t* KNp = KN + ((size_t)z * T + tk0) * 256 + col;
        if (z == 0) gla_cols<0>(GLs, Qs + col * 2, Ks + col * 2, KTl + (0 * 256 + col) * 144, gu, gb, QHp, KNp, tot);
        else        gla_cols<1>(GLs, Qs + col * 2, Ks + col * 2, KTl + (1 * 256 + col) * 144, gu, gb, QHp, KNp, tot);
#pragma unroll
        for (int ks = 0; ks < 2; ++ks)
#pragma unroll
            for (int b = 0; b < 4; ++b) yfp[1][ks][b] = frag_glb(VTg, ((size_t)ch * 4 + (F.wave >> 1)) * 128 + 64 + b * 16, 64, ks * 32, F.lane);
        const float dec = __builtin_amdgcn_exp2f(tot);
        DEC[z * 256 + col] = dec; gdec[((size_t)ch * 2 + z) * 256 + col] = dec;
        __syncthreads();
        const bool more = ch + F.G < NCH;
        {
            const int wz = F.wave & 1, wh = F.wave >> 1, q = F.lane >> 4, c = F.lane & 15;
#pragma unroll
            for (int eh = 0; eh < 2; ++eh) {
                if (eh == 1) { asm volatile("" ::: "memory"); if (more) GLA_STAGE_LD(ch + F.G) }
                f32x4 acc[4][4];
#pragma unroll
                for (int a = 0; a < 4; ++a)
#pragma unroll
                    for (int b = 0; b < 4; ++b) acc[a][b] = (f32x4){0.f, 0.f, 0.f, 0.f};
#pragma unroll
                for (int ks = 0; ks < 2; ++ks) { bf16x8 xf[4];
#pragma unroll
                    for (int a = 0; a < 4; ++a) xf[a] = frag_lds(KTl, wz * 256 + wh * 64 + a * 16, 144, ks * 32, F.lane);
#pragma unroll
                    for (int a = 0; a < 4; ++a)
#pragma unroll
                        for (int b = 0; b < 4; ++b) acc[a][b] = MFMA16(xf[a], yfp[eh][ks][b], acc[a][b]); }
#pragma unroll
                for (int a = 0; a < 4; ++a) { const int d0 = a * 16 + 4 * q; const f32x4 dv = *(const LAS f32x4*)(DEC + wz * 256 + wh * 64 + d0);
#pragma unroll
                    for (int b = 0; b < 4; ++b) { const int e = eh * 64 + b * 16 + c;
                        *(u32x2*)(glast + (((size_t)ch * 4 + wh) * 128 + e) * 128 + wz * 64 + d0) = pk4(acc[a][b] * dv); } }
            }
        }
        if (more) GLA_STAGE_ST()
    }
#undef GLA_STAGE_LD
#undef GLA_STAGE_ST
}

__device__ __forceinline__ void sgu_phase(const Frame& F0, CArgsP A, int l) {
    Frame F = F0; F.tid = opq(F0.tid); F.lane = F.tid & 63; F.wave = __builtin_amdgcn_readfirstlane(F.tid >> 6); F.ws = opq_p(F0.ws); F.bid = opq_s(F0.bid); F.G = opq_s(F0.G); F.lds = opq_l(F0.lds); F.CTLW = (volatile LAS unsigned*)(F.lds + LDSCTL_OFF);
    unsigned char* ws = F.ws;
    const bf16_t* proj = (const bf16_t*)(ws + WS_PROJ); bf16_t* mixed = (bf16_t*)(ws + WS_MIXED); const bf16_t* sw = (const bf16_t*)(ws + WS_SGUW) + (size_t)l * 4 * 128 * 128;
    LAS unsigned char* VL = F.lds;
    const float* lng = GIN(A, 7) + l * 256; const float* lnb = GIN(A, 8) + l * 256; const float* bs = GIN(A, 10) + (size_t)l * 4 * 128;
    const float* stat = (const float*)(ws + WS_STAT);
    int u0, un; { const int b = F.bid; if (b < 16 || (b >= 128 && b < 176)) { u0 = 0; un = 0; } else { const int ci = b < 128 ? b - 16 : b - 176 + 112; if (ci < 96) { u0 = 6 * ci; un = 6; } else { u0 = 576 + 5 * (ci - 96); un = 5; } } }
    for (int uu = u0; uu < u0 + un; ++uu) {
        const int tk0 = (uu >> 2) * 128, h = uu & 3;
        const int ct = F.wave & 3, th = F.wave >> 2, q = F.lane >> 4, c = F.lane & 15;
        bf16x8 yfs[4][4]; u32x2 uws[4]; float bias4[4]; unsigned short tv[16];
#pragma unroll
        for (int i = 0; i < 16; ++i) { const int s = F.wave * 16 + i; tv[i] = proj[(size_t)(tk0 + s) * PROJW + 256 + h * 64 + (F.tid & 63)]; }
#pragma unroll
        for (int ks = 0; ks < 4; ++ks)
#pragma unroll
            for (int b = 0; b < 4; ++b) yfs[ks][b] = frag_glb(sw + (size_t)h * 128 * 128, th * 64 + b * 16, 128, ks * 32, F.lane);
#pragma unroll
        for (int b = 0; b < 4; ++b) { const int t = th * 64 + b * 16 + c; bias4[b] = bs[h * 128 + t]; uws[b] = *(const u32x2*)(proj + (size_t)(tk0 + t) * PROJW + h * 64 + ct * 16 + 4 * q); }
        asm volatile("" ::: "memory");
        int mean_l, rstd_l;
        {   const int s = F.wave * 16 + (F.lane & 15); const f32x4 pa = *(const f32x4*)(stat + (size_t)(tk0 + s) * 8), pb2 = *(const f32x4*)(stat + (size_t)(tk0 + s) * 8 + 4);
            asm volatile("" ::: "memory");
            const float sm = (pa[0] + pa[2]) + (pb2[0] + pb2[2]), sq = (pa[1] + pa[3]) + (pb2[1] + pb2[3]);
            const float mean = sm * (1.0f / 256.0f), rstd = rsqrtf(fmaxf(sq * (1.0f / 256.0f) - mean * mean, 0.0f) + LN_EPS);
            mean_l = __float_as_int(mean); rstd_l = __float_as_int(rstd); }
        {   const int chn = F.tid & 63, sq = F.wave; const float g = lng[h * 64 + chn], b = lnb[h * 64 + chn];
#pragma unroll
            for (int j = 0; j < 2; ++j) { unsigned w[4]; float vv[8];
#pragma unroll
                for (int tt = 0; tt < 8; ++tt) { const float mean = __int_as_float(__builtin_amdgcn_readlane(mean_l, j * 8 + tt)), rstd = __int_as_float(__builtin_amdgcn_readlane(rstd_l, j * 8 + tt));
                    vv[tt] = (bf2f(tv[j * 8 + tt]) - mean) * rstd * g + b; }
#pragma unroll
                for (int i = 0; i < 4; ++i) w[i] = pk2(vv[2 * i], vv[2 * i + 1]);
                *(LAS u32x4*)(VL + chn * 272 + sq * 32 + j * 16) = (u32x4){w[0], w[1], w[2], w[3]}; }
        }
        __syncthreads();
        {   f32x4 acc[4];
#pragma unroll
            for (int b = 0; b < 4; ++b) acc[b] = (f32x4){0.f, 0.f, 0.f, 0.f};
#pragma unroll
            for (int ks = 0; ks < 4; ++ks) { const bf16x8 xf = frag_lds(VL, ct * 16, 272, ks * 32, F.lane);
#pragma unroll
                for (int b = 0; b < 4; ++b) acc[b] = MFMA16(xf, yfs[ks][b], acc[b]); }
#pragma unroll
            for (int b = 0; b < 4; ++b) { const int t = th * 64 + b * 16 + c; const float bias = bias4[b];
                const int ch0 = h * 64 + ct * 16 + 4 * q; const u32x2 uw = uws[b];
                u32x2 o; o.x = pk2(bf2f(uw.x & 0xffffu) * (acc[b][0] + bias), bf2f(uw.x >> 16) * (acc[b][1] + bias));
                o.y = pk2(bf2f(uw.y & 0xffffu) * (acc[b][2] + bias), bf2f(uw.y >> 16) * (acc[b][3] + bias));
                *(u32x2*)(mixed + (size_t)(tk0 + t) * 1024 + ch0) = o; }
        }
        __syncthreads();
    }
}

__device__ __forceinline__ int scan_chunk(int z, int b, int st) {
    return z == 0 ? (st < 4 ? 512 + b * 4 + st : b * 128 + (st - 4)) : (st < 4 ? 512 + b * 4 + (3 - st) : b * 128 + (131 - st));
}
__device__ __forceinline__ void scan_phase(const Frame& F0, CArgsP A, int l) {
    Frame F = F0; F.tid = opq(F0.tid); F.lane = F.tid & 63; F.wave = __builtin_amdgcn_readfirstlane(F.tid >> 6); F.ws = opq_p(F0.ws); F.bid = opq_s(F0.bid); F.G = opq_s(F0.G); F.lds = opq_l(F0.lds); F.CTLW = (volatile LAS unsigned*)(F.lds + LDSCTL_OFF);
    unsigned char* ws = F.ws;
    const bf16_t* glast = (const bf16_t*)(ws + WS_GLAST); const float* gdec = (const float*)(ws + WS_GDEC); bf16_t* sprev = (bf16_t*)(ws + WS_SPREV);
    const float* hloc = (const float*)(ws + WS_HLOC); bf16_t* ucat = (bf16_t*)(ws + WS_UCAT); const float* lb64 = (const float*)(ws + WS_LB64);
    if (F.bid < 128 && F.wave == 7) { const int p = F.lane, z = F.bid & 1, b = (F.bid >> 1) & 3, g = F.bid >> 3;
        const f32x2 lb = *(const f32x2*)(lb64 + ((size_t)((l * 2 + z) * 16 + g) * 64 + p) * 2);
        float hr = 0.f, hi = 0.f;
        for (int sb = 0; sb < 132; sb += 44) { f32x2 hl[44];
#pragma unroll
            for (int j = 0; j < 44; ++j) { const int ch = scan_chunk(z, b, sb + j); hl[j] = *(const f32x2*)(hloc + ((size_t)g * NCHP + ch) * 256 + z * 128 + p * 2); }
#pragma unroll
            for (int j = 0; j < 44; ++j) { const int ch = scan_chunk(z, b, sb + j);
                *(unsigned*)(ucat + ((size_t)g * NCHP + ch) * S5K + 1024 + z * 128 + p * 2) = pk2(hr, hi);
                const float nr = lb.x * hr - lb.y * hi + hl[j].x, ni = lb.x * hi + lb.y * hr + hl[j].y; hr = nr; hi = ni; }
        }
    }
    {   const int idx = F.bid * NTHR + F.tid;
        const int b = idx >> 15, rem = (idx & 32767) * 2, h = rem >> 14, dcat = rem & 127, z = dcat >> 6, d = dcat & 63;
        const bf16_t* gsrc = glast + rem; bf16_t* gdst = sprev + rem; const float* dsrc = gdec + z * 256 + h * 64 + d;
        float S0 = 0.f, S1 = 0.f;
        unsigned dsA[22], dsB[22]; f32x2 dcA[22], dcB[22];
#define SCAN_LOAD(DS_, DC_, sb_) { _Pragma("unroll") for (int j = 0; j < 22; ++j) { const int c = scan_chunk(z, b, (sb_) + j); DS_[j] = *(const unsigned*)(gsrc + (size_t)c * 65536); DC_[j] = *(const f32x2*)(dsrc + (size_t)c * 512); } }
#define SCAN_STEP(DS_, DC_, sb_) { _Pragma("unroll") for (int j = 0; j < 22; ++j) { const int c = scan_chunk(z, b, (sb_) + j); *(unsigned*)(gdst + (size_t)c * 65536) = pk2(S0, S1); \
            S0 = DC_[j].x * S0 + bf2f(DS_[j] & 0xffffu); S1 = DC_[j].y * S1 + bf2f(DS_[j] >> 16); } }
        SCAN_LOAD(dsA, dcA, 0)
        for (int sb = 0; sb < 132; sb += 44) {
            SCAN_LOAD(dsB, dcB, sb + 22)
            SCAN_STEP(dsA, dcA, sb)
            if (sb + 44 < 132) SCAN_LOAD(dsA, dcA, sb + 44)
            SCAN_STEP(dsB, dcB, sb + 22)
        }
#undef SCAN_LOAD
#undef SCAN_STEP
    }
}

__device__ __forceinline__ void gla_out(const Frame& F0, CArgsP A, int l) {
    Frame F = F0; F.tid = opq(F0.tid); F.lane = F.tid & 63; F.wave = __builtin_amdgcn_readfirstlane(F.tid >> 6); F.ws = opq_p(F0.ws); F.bid = opq_s(F0.bid); F.G = opq_s(F0.G); F.lds = opq_l(F0.lds); F.CTLW = (volatile LAS unsigned*)(F.lds + LDSCTL_OFF);
    unsigned char* ws = F.ws;
    const bf16_t* proj = (const bf16_t*)(ws + WS_PROJ); bf16_t* mixed = (bf16_t*)(ws + WS_MIXED);
    const bf16_t* KN = (const bf16_t*)(ws + WS_KS); const bf16_t* QH = (const bf16_t*)(ws + WS_QH);
    const bf16_t* VTg = (const bf16_t*)(ws + WS_VT); const bf16_t* sprev = (const bf16_t*)(ws + WS_SPREV);
    const float* ng = GIN(A, 13) + (size_t)l * 512;
    LAS unsigned char* VT2 = F.lds;
    LAS unsigned char* SP2 = F.lds + 256 * 144;
    LAS unsigned char* Pw = F.lds + 256 * 144 + 256 * 272 + F.wave * 2304;
    const int q = F.lane >> 4, c = F.lane & 15, sub = F.wave >> 2, tm = F.wave & 3;
    const int nun = (l == DEPTH - 1) ? 1024 : NCH * 2;
    for (int uu = (F.bid + 64) & 255; uu < nun; uu += F.G) {
        const int ch = uu >> 1, hp = uu & 1, h = hp * 2 + sub, tk0 = ch * 64, tok = tk0 + tm * 16 + c;
        u32x4 sv[4], sp[8];
        const size_t erow0 = ((size_t)ch * 4 + hp * 2) * 128;
#pragma unroll
        for (int j = 0; j < 4; ++j) { const int idx = F.tid + NTHR * j; sv[j] = *(const u32x4*)(VTg + (erow0 + (idx >> 3)) * 64 + (idx & 7) * 8); }
#pragma unroll
        for (int j = 0; j < 8; ++j) { const int idx = F.tid + NTHR * j; sp[j] = *(const u32x4*)(sprev + (erow0 + (idx >> 4)) * 128 + (idx & 15) * 8); }
        bf16x8 qh[4], kf[4][2], kb[4][2];
#pragma unroll
        for (int j = 0; j < 4; ++j) qh[j] = frag_glb(QH + h * 128, (size_t)tk0 + tm * 16, 512, j * 32, F.lane);
#pragma unroll
        for (int st = 0; st < 4; ++st)
#pragma unroll
            for (int ks = 0; ks < 2; ++ks) { kf[st][ks] = frag_glb(KN + h * 64, (size_t)tk0 + st * 16, 256, ks * 32, F.lane); kb[st][ks] = frag_glb(KN + h * 64, (size_t)T + tk0 + st * 16, 256, ks * 32, F.lane); }
        u32x2 gw[8];
#pragma unroll
        for (int a = 0; a < 8; ++a) gw[a] = *(const u32x2*)(proj + (size_t)tok * PROJW + 1536 + h * 128 + a * 16 + 4 * q);
#pragma unroll
        for (int j = 0; j < 4; ++j) { const int idx = F.tid + NTHR * j; *(LAS u32x4*)(VT2 + (idx >> 3) * 144 + (idx & 7) * 16) = sv[j]; }
#pragma unroll
        for (int j = 0; j < 8; ++j) { const int idx = F.tid + NTHR * j; *(LAS u32x4*)(SP2 + (idx >> 4) * 272 + (idx & 15) * 16) = sp[j]; }
#pragma unroll
        for (int st = 0; st < 4; ++st) {
            f32x4 sf = (f32x4){0.f, 0.f, 0.f, 0.f}, sb = (f32x4){0.f, 0.f, 0.f, 0.f};
#pragma unroll
            for (int ks = 0; ks < 2; ++ks) { sf = MFMA16(kf[st][ks], qh[ks], sf); sb = MFMA16(kb[st][ks], qh[2 + ks], sb); }
            const int t = tm * 16 + c, s0 = st * 16 + 4 * q;
            u32x2 o; o.x = pk2((s0 + 0) <= t ? sf[0] : sb[0], (s0 + 1) <= t ? sf[1] : sb[1]); o.y = pk2((s0 + 2) <= t ? sf[2] : sb[2], (s0 + 3) <= t ? sf[3] : sb[3]);
            *(LAS u32x2*)(Pw + c * 144 + s0 * 2) = o; }
        __syncthreads();
        bf16x8 pf[2];
#pragma unroll
        for (int ks = 0; ks < 2; ++ks) pf[ks] = frag_lds(Pw, 0, 144, ks * 32, F.lane);
        f32x4 acc[8];
#pragma unroll
        for (int a = 0; a < 8; ++a) acc[a] = (f32x4){0.f, 0.f, 0.f, 0.f};
        bf16x8 f0[8], f1[8];
#define GO_LD(dst, base, pitch, kk) { _Pragma("unroll") for (int a = 0; a < 8; ++a) dst[a] = frag_lds(base, sub * 128 + a * 16, pitch, (kk) * 32, F.lane); asm volatile("" ::: "memory"); }
#define GO_MM(src, bop) { _Pragma("unroll") for (int a = 0; a < 8; ++a) acc[a] = MFMA16(src[a], bop, acc[a]); }
        GO_LD(f0, VT2, 144, 0)
        GO_LD(f1, VT2, 144, 1)  GO_MM(f0, pf[0])
        GO_LD(f0, SP2, 272, 0)  GO_MM(f1, pf[1])
        GO_LD(f1, SP2, 272, 1)  GO_MM(f0, qh[0])
        GO_LD(f0, SP2, 272, 2)  GO_MM(f1, qh[1])
        GO_LD(f1, SP2, 272, 3)  GO_MM(f0, qh[2])
        GO_MM(f1, qh[3])
#undef GO_LD
#undef GO_MM
        float ss = 0.f;
#pragma unroll
        for (int a = 0; a < 8; ++a) ss += (acc[a][0] * acc[a][0] + acc[a][1] * acc[a][1]) + (acc[a][2] * acc[a][2] + acc[a][3] * acc[a][3]);
        ss += __shfl_xor(ss, 16); ss += __shfl_xor(ss, 32);
        const float rinv = rsqrtf(ss * (1.0f / 128.0f) + LN_EPS);
#pragma unroll
        for (int a = 0; a < 8; ++a) { const int e0 = h * 128 + a * 16 + 4 * q; const f32x4 nv = *(const f32x4*)(ng + e0);
            u32x2 o; o.x = pk2(acc[a][0] * rinv * nv[0] * siluf_(bf2f(gw[a].x & 0xffffu)), acc[a][1] * rinv * nv[1] * siluf_(bf2f(gw[a].x >> 16)));
            o.y = pk2(acc[a][2] * rinv * nv[2] * siluf_(bf2f(gw[a].y & 0xffffu)), acc[a][3] * rinv * nv[3] * siluf_(bf2f(gw[a].y >> 16)));
            *(u32x2*)(mixed + (size_t)tok * 1024 + 256 + e0) = o; }
        __syncthreads();
    }
}

__device__ __forceinline__ float rs32(const float (&pe)[32], int lane) {
    float r16[16], r8[8], r4[4], r2[2], r1;
    { const bool hi = (lane & 32) != 0;
#pragma unroll
        for (int i = 0; i < 16; ++i) { const float mine = hi ? pe[16 + i] : pe[i], oth = hi ? pe[i] : pe[16 + i]; r16[i] = mine + __shfl_xor(oth, 32); } }
    { const bool hi = (lane & 16) != 0;
#pragma unroll
        for (int i = 0; i < 8; ++i) { const float mine = hi ? r16[8 + i] : r16[i], oth = hi ? r16[i] : r16[8 + i]; r8[i] = mine + __shfl_xor(oth, 16); } }
    { const bool hi = (lane & 8) != 0;
#pragma unroll
        for (int i = 0; i < 4; ++i) { const float mine = hi ? r8[4 + i] : r8[i], oth = hi ? r8[i] : r8[4 + i]; r4[i] = mine + __shfl_xor(oth, 8); } }
    { const bool hi = (lane & 4) != 0;
#pragma unroll
        for (int i = 0; i < 2; ++i) { const float mine = hi ? r4[2 + i] : r4[i], oth = hi ? r4[i] : r4[2 + i]; r2[i] = mine + __shfl_xor(oth, 4); } }
    { const bool hi = (lane & 2) != 0; const float mine = hi ? r2[1] : r2[0], oth = hi ? r2[0] : r2[1]; r1 = mine + __shfl_xor(oth, 2); }
    r1 += __shfl_xor(r1, 1);
    return r1;
}
__device__ __forceinline__ float rs16(const float (&r16)[16], int lane) {
    float r8[8], r4[4], r2[2], r1;
    { const bool hi = (lane & 16) != 0;
#pragma unroll
        for (int i = 0; i < 8; ++i) { const float mine = hi ? r16[8 + i] : r16[i], oth = hi ? r16[i] : r16[8 + i]; r8[i] = mine + __shfl_xor(oth, 16); } }
    { const bool hi = (lane & 8) != 0;
#pragma unroll
        for (int i = 0; i < 4; ++i) { const float mine = hi ? r8[4 + i] : r8[i], oth = hi ? r8[i] : r8[4 + i]; r4[i] = mine + __shfl_xor(oth, 8); } }
    { const bool hi = (lane & 4) != 0;
#pragma unroll
        for (int i = 0; i < 2; ++i) { const float mine = hi ? r4[2 + i] : r4[i], oth = hi ? r4[i] : r4[2 + i]; r2[i] = mine + __shfl_xor(oth, 4); } }
    { const bool hi = (lane & 2) != 0; const float mine = hi ? r2[1] : r2[0], oth = hi ? r2[0] : r2[1]; r1 = mine + __shfl_xor(oth, 2); }
    r1 += __shfl_xor(r1, 1);
    return r1;
}
__device__ __forceinline__ void top4_store(float val, int lane, LAS int* topi_row, float* gate_row, volatile LAS int* hist, bool valid, LAS float* scr) {
    const int mye = lane >> 1;
    if ((lane & 1) == 0) scr[mye] = val;
    asm volatile("s_waitcnt lgkmcnt(0)" ::: "memory");
    int rank = 0;
#pragma unroll
    for (int i = 0; i < 8; ++i) { const f32x4 o = *(const LAS f32x4*)(scr + 4 * i);
#pragma unroll
        for (int j = 0; j < 4; ++j) asm volatile("v_cmp_gt_f32_e32 vcc, %1, %2\n\tv_addc_co_u32_e32 %0, vcc, 0, %0, vcc" : "+v"(rank) : "v"(o[j]), "v"(val) : "vcc"); }
    {
        const bool ev = (lane & 1) == 0;
        const bool ok = __builtin_popcountll(__ballot(ev && rank == 0)) == 1 && __builtin_popcountll(__ballot(ev && rank == 1)) == 1 && __builtin_popcountll(__ballot(ev && rank == 2)) == 1 && __builtin_popcountll(__ballot(ev && rank == 3)) == 1;
        if (!ok) { rank = 0;
#pragma unroll
            for (int i = 0; i < 8; ++i) { const f32x4 o = *(const LAS f32x4*)(scr + 4 * i);
#pragma unroll
                for (int j = 0; j < 4; ++j) { const int e2 = 4 * i + j; rank += (o[j] > val || (o[j] == val && e2 < mye)) ? 1 : 0; } } } }
    if ((lane & 1) == 0 && rank < 4) { scr[32 + rank] = val; ((LAS int*)scr)[36 + rank] = mye; }
    asm volatile("s_waitcnt lgkmcnt(0)" ::: "memory");
    const f32x4 tv = *(const LAS f32x4*)(scr + 32); const s32x4 te = *(const LAS s32x4*)(scr + 36);
    const float e1 = __expf(tv[1] - tv[0]), e2 = __expf(tv[2] - tv[0]), e3 = __expf(tv[3] - tv[0]); const float inv = 1.0f / (1.0f + e1 + e2 + e3);
    if (valid) {
        if (lane == 0) *(f32x4*)gate_row = (f32x4){inv, e1 * inv, e2 * inv, e3 * inv};
        if (lane < 4) { const int e = lane == 0 ? te[0] : (lane == 1 ? te[1] : (lane == 2 ? te[2] : te[3])); const int r = __hip_atomic_fetch_add((LAS int*)&hist[e], 1, __ATOMIC_RELAXED, __HIP_MEMORY_SCOPE_WORKGROUP); topi_row[lane] = e | (r << 8); } }
    asm volatile("s_waitcnt lgkmcnt(0)" ::: "memory");
}
__device__ __forceinline__ void ln1_router(const Frame& F0, CArgsP A, int l, int ntok, bool dry = false) {
    Frame F = F0; F.tid = opq(F0.tid); F.lane = F.tid & 63; F.wave = __builtin_amdgcn_readfirstlane(F.tid >> 6); F.ws = opq_p(F0.ws); F.bid = opq_s(F0.bid); F.G = opq_s(F0.G); F.lds = opq_l(F0.lds); F.CTLW = (volatile LAS unsigned*)(F.lds + LDSCTL_OFF);
    unsigned char* ws = F.ws;
    bf16_t* X = (bf16_t*)(ws + WS_X); const bf16_t* TMP = (const bf16_t*)(ws + WS_TMP); unsigned char* H8 = (unsigned char*)(ws + WS_QS); const float* mod = (const float*)(ws + WS_MOD) + (size_t)l * 5 * 6144;
    float* gate = (float*)(ws + WS_GATE);
    const float* lg = GIN(A, 25) + (size_t)(l * 2 + 0) * D; const float* lb = GIN(A, 26) + (size_t)(l * 2 + 0) * D;
    const float* rb = GIN(A, 28) + l * NEXP;
    LAS unsigned char* HS = F.lds;
    LAS float* PL = (LAS float*)(F.lds + 16 * 4112);
    volatile LAS int* hist = (volatile LAS int*)(F.CTLW + 32);
    LAS int* ltopi = (LAS int*)(F.lds + 90112);
    bf16x8 wh[2][4], wl[2][4];
    { const bf16_t* gh = (const bf16_t*)(ws + WS_WRH) + (size_t)l * 32768; const bf16_t* gl2 = (const bf16_t*)(ws + WS_WRL) + (size_t)l * 32768;
#pragma unroll
        for (int nt = 0; nt < 2; ++nt)
#pragma unroll
            for (int ks = 0; ks < 4; ++ks) { wh[nt][ks] = frag_glb(gh, nt * 16, 1024, F.wave * 128 + ks * 32, F.lane); wl[nt][ks] = frag_glb(gl2, nt * 16, 1024, F.wave * 128 + ks * 32, F.lane); } }
    if (F.tid < 32) hist[F.tid] = 0;
    LAS float* PV = (LAS float*)(F.lds + 92224);
    for (int i = F.tid; i < 512; i += NTHR) ((LAS f32x4*)PV)[i] = i < 256 ? *(const f32x4*)(lg + 4 * i) : *(const f32x4*)(lb + 4 * (i - 256));
    for (int i = F.tid; i < 5 * 768; i += NTHR) { const int vv = i / 768, r = i % 768; f32x4 x = *(const f32x4*)(mod + (size_t)vv * 6144 + 2048 + 4 * r); if (r >= 512) x += 1.0f; ((LAS f32x4*)(PV + 2048 + vv * 3072))[r] = x; }
    __syncthreads();
    const int per = ntok / F.G, t0 = F.bid * per;
    f32x4 xq[2][4]; u32x2 tq[2][4];
#define LN1_TOK(it_, k_) (t0 + (((it_) * 16 + F.wave * 2 + (k_)) < per ? ((it_) * 16 + F.wave * 2 + (k_)) : per - 1))
#pragma unroll
    for (int k = 0; k < 2; ++k)
#pragma unroll
        for (int j = 0; j < 4; ++j) { const int c = 4 * F.lane + 256 * j, t = LN1_TOK(0, k); xq[k][j] = unpk4(*(const u32x2*)(X + (size_t)t * D + c)); tq[k][j] = *(const u32x2*)(TMP + (size_t)t * D + c); }
    for (int it = 0; it * 16 < per; ++it) {
        int tk[2]; bool valid[2];
#pragma unroll
        for (int k = 0; k < 2; ++k) { const int ti = it * 16 + F.wave * 2 + k; valid[k] = ti < per; tk[k] = t0 + (valid[k] ? ti : per - 1); valid[k] = valid[k] && !dry; }
        f32x4 v[2][4]; float s[2] = {0.f, 0.f};
#pragma unroll
        for (int k = 0; k < 2; ++k) { const LAS float* mv = PV + 2048 + tok_vec(tk[k]) * 3072;
#pragma unroll
            for (int j = 0; j < 4; ++j) { const int c = 4 * F.lane + 256 * j; const f32x4 x = xq[k][j], g1 = *(const LAS f32x4*)(mv + c); const u32x2 tw = tq[k][j];
                const f32x4 tp = (f32x4){bf2f(tw.x & 0xffffu), bf2f(tw.x >> 16), bf2f(tw.y & 0xffffu), bf2f(tw.y >> 16)};
                v[k][j] = x * DN_ALPHA + g1 * tp; s[k] += (v[k][j][0] + v[k][j][1]) + (v[k][j][2] + v[k][j][3]); } }
#pragma unroll
        for (int k = 0; k < 2; ++k)
#pragma unroll
            for (int j = 0; j < 4; ++j) { const int c = 4 * F.lane + 256 * j, t = LN1_TOK(it + 1, k); xq[k][j] = unpk4(*(const u32x2*)(X + (size_t)t * D + c)); tq[k][j] = *(const u32x2*)(TMP + (size_t)t * D + c); }
        float mean[2], s2[2] = {0.f, 0.f}, rstd[2];
#pragma unroll
        for (int k = 0; k < 2; ++k) mean[k] = wave_sum(s[k]) * (1.0f / D);
#pragma unroll
        for (int k = 0; k < 2; ++k)
#pragma unroll
            for (int j = 0; j < 4; ++j) { v[k][j] = v[k][j] - mean[k]; s2[k] += (v[k][j][0] * v[k][j][0] + v[k][j][1] * v[k][j][1]) + (v[k][j][2] * v[k][j][2] + v[k][j][3] * v[k][j][3]); }
#pragma unroll
        for (int k = 0; k < 2; ++k) rstd[k] = rsqrtf(wave_sum(s2[k]) * (1.0f / D) + LN_EPS);
#pragma unroll
        for (int k = 0; k < 2; ++k) { const LAS float* mv = PV + 2048 + tok_vec(tk[k]) * 3072;
#pragma unroll
            for (int j = 0; j < 4; ++j) { const int c = 4 * F.lane + 256 * j; const f32x4 g = *(const LAS f32x4*)(PV + c), b = *(const LAS f32x4*)(PV + 1024 + c);
                const f32x4 xn = v[k][j] * rstd[k] * g + b;
                const f32x4 sh = *(const LAS f32x4*)(mv + 1024 + c), sc1 = *(const LAS f32x4*)(mv + 2048 + c); const f32x4 h = xn * sc1 + sh; v[k][j] = h;
                if (valid[k]) { *(u32x2*)(X + (size_t)tk[k] * D + c) = pk4(xn); *(unsigned*)(H8 + (size_t)tk[k] * D + c) = pk4_fp8(h[0], h[1], h[2], h[3]); }
                if (dry) asm volatile("" :: "v"(xn[0]), "v"(xn[1]), "v"(xn[2]), "v"(xn[3])); } }
#pragma unroll
        for (int k = 0; k < 2; ++k)
#pragma unroll
            for (int j = 0; j < 4; ++j) { const f32x4 h = v[k][j]; const unsigned h0 = f2bf(h[0]), h1 = f2bf(h[1]), h2b = f2bf(h[2]), h3 = f2bf(h[3]);
                u32x2 hi; hi.x = h0 | (h1 << 16); hi.y = h2b | (h3 << 16);
                u32x2 lo; lo.x = pk2(h[0] - bf2f(h0), h[1] - bf2f(h1)); lo.y = pk2(h[2] - bf2f(h2b), h[3] - bf2f(h3));
                LAS unsigned char* rowp = HS + (F.wave * 2 + k) * 4112 + (4 * F.lane + 256 * j) * 2;
                *(LAS u32x2*)rowp = hi; *(LAS u32x2*)(rowp + 2048) = lo; }
        __syncthreads();
        {   f32x4 pa[2] = {(f32x4){0.f, 0.f, 0.f, 0.f}, (f32x4){0.f, 0.f, 0.f, 0.f}};
#pragma unroll
            for (int ks = 0; ks < 4; ++ks) { const bf16x8 ah = frag_lds(HS, 0, 4112, F.wave * 128 + ks * 32, F.lane), al = frag_lds(HS, 0, 4112, 1024 + F.wave * 128 + ks * 32, F.lane);
#pragma unroll
                for (int nt = 0; nt < 2; ++nt) { pa[nt] = MFMA16(wh[nt][ks], ah, pa[nt]); pa[nt] = MFMA16(wl[nt][ks], ah, pa[nt]); pa[nt] = MFMA16(wh[nt][ks], al, pa[nt]); } }
            const int q = F.lane >> 4, c = F.lane & 15;
#pragma unroll
            for (int nt = 0; nt < 2; ++nt) *(LAS f32x4*)(PL + (F.wave * 16 + c) * 32 + nt * 16 + 4 * q) = pa[nt]; }
        __syncthreads();
        float l0 = rb[F.lane >> 1], l1 = l0;
#pragma unroll
        for (int w = 0; w < 8; ++w) { l0 += PL[(w * 16 + F.wave * 2 + 0) * 32 + (F.lane >> 1)]; l1 += PL[(w * 16 + F.wave * 2 + 1) * 32 + (F.lane >> 1)]; }
        if (dry) asm volatile("" :: "v"(l0), "v"(l1));
        LAS float* scr = (LAS float*)(F.lds + 16 * 4112 + 8 * 16 * 32 * 4) + F.wave * 96;
        top4_store(l0, F.lane, ltopi + (tk[0] - t0) * 4, gate + (size_t)tk[0] * 4, hist, valid[0], scr);
        top4_store(l1, F.lane, ltopi + (tk[1] - t0) * 4, gate + (size_t)tk[1] * 4, hist, valid[1], scr + 48);
    }
    __syncthreads();
    if (dry) return;
    {   unsigned* gc = (unsigned*)(ws + WS_CTL) + 64 + l * 960;
        unsigned* xbar = (unsigned*)(ws + WS_CTL) + CW_BAR;
        int* tok_slot = (int*)(ws + WS_TOKSLOT); unsigned short* slot_tok = (unsigned short*)(ws + WS_SLOTTOK); int* ecnt = (int*)(ws + WS_ECNT);
        volatile LAS int* tot = (volatile LAS int*)(F.CTLW + 64); volatile LAS int* cur = (volatile LAS int*)(F.CTLW + 96); volatile LAS int* ebase = (volatile LAS int*)(F.CTLW + 128);
        if (F.tid < 32) cur[F.tid] = (int)xb_add(gc + 16 * F.tid, (unsigned)hist[F.tid]);
        asm volatile("s_waitcnt vmcnt(0) lgkmcnt(0)" ::: "memory");
        __syncthreads();
        if (F.tid == 0) { (void)xb_add(gc + 16 * 32, 1u); XB_SPIN(xb_ld(gc + 16 * 32) != (unsigned)F.G, xbar); }
        __syncthreads();
        if (F.tid < 32) tot[F.tid] = (int)xb_ld(gc + 16 * F.tid);
        __syncthreads();
        if (F.tid == 0) { int p = 0; for (int e = 0; e < 32; ++e) { ebase[e] = p * 256; p += (tot[e] + 255) >> 8; } }
        __syncthreads();
        if (F.tid < 32) { cur[F.tid] += ebase[F.tid]; if (F.bid == 0) ecnt[F.tid] = tot[F.tid]; }
        __syncthreads();
        for (int i = F.tid; i < per * 4; i += NTHR) { const int v = ltopi[i]; const int slot = cur[v & 255] + (v >> 8);
            slot_tok[(slot >> 8) * 256 + 2 * (slot & 127) + ((slot >> 7) & 1)] = (unsigned short)(t0 + (i >> 2)); tok_slot[(size_t)t0 * 4 + i] = slot; }
        if (F.bid < 32) { const int e = F.bid; const int lo = ebase[e] + tot[e], hi = ebase[e] + (((tot[e] + 255) >> 8) << 8); for (int sl = lo + F.tid; sl < hi; sl += NTHR) slot_tok[(sl >> 8) * 256 + 2 * (sl & 127) + ((sl >> 7) & 1)] = 0; }
    }
}

__device__ __forceinline__ void moe_prefix(const Frame& F0) {
    Frame F = F0; F.tid = opq(F0.tid); F.lane = F.tid & 63; F.wave = __builtin_amdgcn_readfirstlane(F.tid >> 6); F.ws = opq_p(F0.ws); F.bid = opq_s(F0.bid); F.G = opq_s(F0.G); F.lds = opq_l(F0.lds); F.CTLW = (volatile LAS unsigned*)(F.lds + LDSCTL_OFF);
    const int* ecnt = (const int*)(F.ws + WS_ECNT); volatile LAS int* pref = (volatile LAS int*)(F.CTLW + 160);
    __syncthreads();
    if (F.tid < 32) {
        const int c = (ecnt[F.tid] + 255) >> 8; int incl = c;
#pragma unroll
        for (int o = 1; o < 32; o <<= 1) { const int v = __shfl_up(incl, o, 32); if (F.tid >= o) incl += v; }
        pref[F.tid] = incl - c; if (F.tid == 31) pref[32] = incl; }
    __syncthreads();
}

__device__ __forceinline__ void combine_ln2(const Frame& F0, CArgsP A, int l, int ntok, bool dry = false) {
    Frame F = F0; F.tid = opq(F0.tid); F.lane = F.tid & 63; F.wave = __builtin_amdgcn_readfirstlane(F.tid >> 6); F.ws = opq_p(F0.ws); F.bid = opq_s(F0.bid); F.G = opq_s(F0.G); F.lds = opq_l(F0.lds); F.CTLW = (volatile LAS unsigned*)(F.lds + LDSCTL_OFF);
    unsigned char* ws = F.ws;
    bf16_t* X = (bf16_t*)(ws + WS_X); bf16_t* H = (bf16_t*)(ws + WS_H); const unsigned char* YV = (const unsigned char*)(ws + WS_YV);
    const float* mod = (const float*)(ws + WS_MOD) + (size_t)l * 5 * 6144; const float* modn = (const float*)(ws + WS_MOD) + (size_t)(l + 1 < DEPTH ? l + 1 : l) * 5 * 6144;
    const int* tok_slot = (const int*)(ws + WS_TOKSLOT); const float* gate = (const float*)(ws + WS_GATE);
    const float* lg = GIN(A, 25) + (size_t)(l * 2 + 1) * D; const float* lb = GIN(A, 26) + (size_t)(l * 2 + 1) * D;
    const bool lastl = (l == DEPTH - 1);
    const int stride = F.G * NWAVES, tb0 = F.bid * NWAVES + F.wave;
    LAS float* PV = (LAS float*)F.lds;
    for (int i = F.tid; i < 512; i += NTHR) ((LAS f32x4*)PV)[i] = i < 256 ? *(const f32x4*)(lg + 4 * i) : *(const f32x4*)(lb + 4 * (i - 256));
    for (int i = F.tid; i < 5 * 768; i += NTHR) { const int vv = i / 768, r = i % 768; f32x4 x = r < 256 ? *(const f32x4*)(mod + (size_t)vv * 6144 + 5120 + 4 * r) : *(const f32x4*)(modn + (size_t)vv * 6144 + 4 * (r - 256));
        if (r >= 512) x += 1.0f; ((LAS f32x4*)(PV + 2048 + vv * 3072))[r] = x; }
    __syncthreads();
#define CMB_TOK(it_, k_) ((tb0 + (2 * (it_) + (k_)) * stride) < ntok ? (tb0 + (2 * (it_) + (k_)) * stride) : tb0)
    s32x4 slq[2]; f32x4 gtq[2], gtc[2]; unsigned yq[2][4][4]; f32x4 xq[2][4];
#pragma unroll
    for (int k = 0; k < 2; ++k) { const int t = CMB_TOK(0, k); slq[k] = *(const s32x4*)(tok_slot + (size_t)t * 4); gtq[k] = *(const f32x4*)(gate + (size_t)t * 4); }
#pragma unroll
    for (int k = 0; k < 2; ++k) { const int t = CMB_TOK(0, k); gtc[k] = gtq[k];
#pragma unroll
        for (int j = 0; j < 4; ++j) { const int c = 4 * F.lane + 256 * j; xq[k][j] = unpk4(*(const u32x2*)(X + (size_t)t * D + c));
#pragma unroll
            for (int e = 0; e < 4; ++e) yq[k][e][j] = *(const unsigned*)(YV + (size_t)slq[k][e] * 1024 + c); } }
#pragma unroll
    for (int k = 0; k < 2; ++k) { const int t = CMB_TOK(1, k); slq[k] = *(const s32x4*)(tok_slot + (size_t)t * 4); gtq[k] = *(const f32x4*)(gate + (size_t)t * 4); }
    for (int it = 0; tb0 + 2 * it * stride < ntok; ++it) {
        int tk[2]; bool valid[2];
#pragma unroll
        for (int k = 0; k < 2; ++k) { const int t = tb0 + (2 * it + k) * stride; valid[k] = (t < ntok) && !dry; tk[k] = t < ntok ? t : tb0; }
        f32x4 v[2][4]; float s[2] = {0.f, 0.f};
#pragma unroll
        for (int k = 0; k < 2; ++k) { const LAS float* mv = PV + 2048 + tok_vec(tk[k]) * 3072; const f32x4 gt = gtc[k];
#pragma unroll
            for (int j = 0; j < 4; ++j) { const int c = 4 * F.lane + 256 * j;
                f32x4 f = (f32x4){0.f, 0.f, 0.f, 0.f};
#pragma unroll
                for (int e = 0; e < 4; ++e) { const f32x2 lo = __builtin_amdgcn_cvt_pk_f32_fp8((int)yq[k][e][j], false), hi = __builtin_amdgcn_cvt_pk_f32_fp8((int)yq[k][e][j], true);
                    const float ge = gt[e] * (1.0f / YV_SCALE); f[0] += ge * lo.x; f[1] += ge * lo.y; f[2] += ge * hi.x; f[3] += ge * hi.y; }
                const f32x4 x = xq[k][j], g2 = *(const LAS f32x4*)(mv + c);
                v[k][j] = x * DN_ALPHA + g2 * f; s[k] += (v[k][j][0] + v[k][j][1]) + (v[k][j][2] + v[k][j][3]); } }
#pragma unroll
        for (int k = 0; k < 2; ++k) { const int t = CMB_TOK(it + 1, k); gtc[k] = gtq[k];
#pragma unroll
            for (int j = 0; j < 4; ++j) { const int c = 4 * F.lane + 256 * j; xq[k][j] = unpk4(*(const u32x2*)(X + (size_t)t * D + c));
#pragma unroll
                for (int e = 0; e < 4; ++e) yq[k][e][j] = *(const unsigned*)(YV + (size_t)slq[k][e] * 1024 + c); } }
#pragma unroll
        for (int k = 0; k < 2; ++k) { const int t = CMB_TOK(it + 2, k); slq[k] = *(const s32x4*)(tok_slot + (size_t)t * 4); gtq[k] = *(const f32x4*)(gate + (size_t)t * 4); }
        float mean[2], s2[2] = {0.f, 0.f}, rstd[2];
#pragma unroll
        for (int k = 0; k < 2; ++k) mean[k] = wave_sum(s[k]) * (1.0f / D);
#pragma unroll
        for (int k = 0; k < 2; ++k)
#pragma unroll
            for (int j = 0; j < 4; ++j) { v[k][j] = v[k][j] - mean[k]; s2[k] += (v[k][j][0] * v[k][j][0] + v[k][j][1] * v[k][j][1]) + (v[k][j][2] * v[k][j][2] + v[k][j][3] * v[k][j][3]); }
#pragma unroll
        for (int k = 0; k < 2; ++k) rstd[k] = rsqrtf(wave_sum(s2[k]) * (1.0f / D) + LN_EPS);
        if (dry) asm volatile("" :: "v"(rstd[0]), "v"(rstd[1]));
#pragma unroll
        for (int k = 0; k < 2; ++k) { if (!valid[k]) continue; const LAS float* mn = PV + 2048 + tok_vec(tk[k]) * 3072;
#pragma unroll
            for (int j = 0; j < 4; ++j) { const int c = 4 * F.lane + 256 * j; const f32x4 g = *(const LAS f32x4*)(PV + c), b = *(const LAS f32x4*)(PV + 1024 + c); const f32x4 xn = v[k][j] * rstd[k] * g + b;
                if (lastl) { *(f32x4*)(GOUT(A) + (size_t)tk[k] * D + c) = xn; }
                else { *(u32x2*)(X + (size_t)tk[k] * D + c) = pk4(xn); const f32x4 sh = *(const LAS f32x4*)(mn + 1024 + c), sc1 = *(const LAS f32x4*)(mn + 2048 + c); const f32x4 h = xn * sc1 + sh;
                    u32x2 o; o.x = pk2(h[0], h[1]); o.y = pk2(h[2], h[3]); *(u32x2*)(H + (size_t)tk[k] * D + c) = o; } } }
    }
}

#ifndef STAGGER_UP
#define STAGGER_UP 0
#endif
#ifndef STAGGER_DN
#define STAGGER_DN 0
#endif
__device__ __forceinline__ void stagger(int bid, int step) {
    if (step > 0) { const unsigned long long t0 = __builtin_amdgcn_s_memrealtime(), d = (unsigned long long)((bid & 7) * step);
        while (__builtin_amdgcn_s_memrealtime() - t0 < d) __builtin_amdgcn_s_sleep(8); }
}
constexpr int NPL = 10, NPH = 3 + DEPTH * NPL;
#ifndef REPMASK
#define REPMASK 0u
#endif
__device__ __forceinline__ int reps_of(int b) { int r = 1 + (int)((REPMASK >> b) & 1u); if (REPMASK != 0u) asm volatile("" : "+s"(r)); return r; }

__global__ void __launch_bounds__(NTHR, 2) hybrid_fwd(Args args) {
    extern __shared__ __attribute__((aligned(16))) unsigned char lds[];
    Frame F;
    F.lds = (LAS unsigned char*)lds; F.CTLW = (volatile LAS unsigned*)(F.lds + LDSCTL_OFF);
    F.tid = threadIdx.x; F.lane = F.tid & 63; F.wave = __builtin_amdgcn_readfirstlane(F.tid >> 6); F.G = gridDim.x; F.bid = blockIdx.x; F.ws = args.ws;
    unsigned char* ws = args.ws;
    for (int u = F.tid; u < 256; u += NTHR) F.CTLW[u] = 0u;
    __syncthreads();
    XcdBarrier bar; bar.bar = (unsigned*)(ws + WS_CTL) + CW_BAR; bar.x = 0; bar.st = nullptr;
    if (MK_N_LAUNCHES == 1) bar = xcd_barrier_post((unsigned*)(ws + WS_CTL) + CW_BAR, F.CTLW + 8);
    const int lo = args.ph_lo, hi = args.ph_hi;
#ifndef PHMASK
#define PHMASK 0xFFFFFFFFu
#endif
#define IN(k) (lo <= (k) && (k) < hi)
#define ON(b) ((PHMASK >> (b)) & 1u)
#define REPS(b) reps_of(b)
#define REPBAR(b) do { if (rep + 1 < REPS(b)) { XcdBarrier _b = bar; _b.bar = (unsigned*)opq_p((unsigned char*)_b.bar); asm volatile("" : "+s"(_b.x)); xcd_barrier(_b); } } while (0)
#ifndef NBAR
#define NBAR 1
#endif
#define SEAM(k) do { if (IN((k) + 1)) { for (int _r = 0; _r < NBAR; ++_r) { XcdBarrier _b = bar; _b.bar = (unsigned*)opq_p((unsigned char*)_b.bar); asm volatile("" : "+s"(_b.x)); xcd_barrier(_b); } } } while (0)
    if (ON(0) && IN(0)) { for (int rep = 0; rep < REPS(0); ++rep) { ph0_prologue(F, argp()); REPBAR(0); } SEAM(0); }
    if (ON(1) && IN(1)) { ph1_mod(F, argp()); SEAM(1); }
    if (ON(2) && IN(2)) { ph2_init(F, argp()); SEAM(2); }
    for (int l = 0; l < DEPTH; ++l) {
        const int pb = 3 + l * NPL;
        const int ntok = (l == DEPTH - 1) ? TLAT : T;
        if (ON(3) && IN(pb + 0)) { for (int rep = 0; rep < REPS(3); ++rep) {
            unsigned char* ws = opq_p(F.ws); CArgsP AP = argp(); (void)AP;
            typedef pg8::DenseSched<T / 256, NINP / 256> SchedT; SchedT S{(const char*)(ws + WS_H), (const char*)(ws + WS_WIN) + (size_t)l * NINP * 2048, (size_t)256 * 2048, (size_t)256 * 2048, opq_s(F.G), opq_s(F.bid), T / 256};
            EpiInProj E{(bf16_t*)(ws + WS_PROJ), (bf16_t*)(ws + WS_UCAT), (float*)(ws + WS_GL), (bf16_t*)(ws + WS_VT), (float*)(ws + WS_STAT)};
            pg8::gemm_phase<EpiInProj, SchedT, false>(F.lds, 2048u, 2048u, 1024, S, E);
            if (opq_s(F.bid) >= 40) conv_slot(F, argp(), l, 0, opq_s(F.bid) - 40);
            REPBAR(3); } SEAM(pb + 0);
        }
        if (ON(4) && IN(pb + 1)) { for (int rep = 0; rep < REPS(4); ++rep) {
            unsigned char* ws = opq_p(F.ws); CArgsP AP = argp(); (void)AP;
            typedef pg8::BatchSched<NCHP / 256, 1, 16> SchedT; SchedT S{(const char*)(ws + WS_UCAT), (const char*)(ws + WS_S5F) + (size_t)l * 16 * 256 * 2048, (size_t)NCHP * S5K * 2, (size_t)256 * 2048, (size_t)256 * S5K * 2, (size_t)256 * 2048, opq_s(F.G), (opq_s(F.bid) + 128) & 255};
            EpiHloc E{(float*)(ws + WS_HLOC)};
#ifndef SUBMASK
#define SUBMASK 7
#endif
            if (SUBMASK & 1) pg8::gemm_phase<EpiHloc, SchedT, false>(F.lds, (unsigned)(S5K * 2), 2048u, 1024, S, E);
            __syncthreads();
#ifndef SUBREP
#define SUBREP 0
#endif
            if (SUBMASK & 2) gla_local(F, argp(), l);
            if (SUBREP & 2) { __syncthreads(); gla_local(F, argp(), l); }
            __syncthreads(); asm volatile("" ::: "memory");
            if (SUBMASK & 4) sgu_phase(F, argp(), l);
            if (SUBREP & 4) { __syncthreads(); sgu_phase(F, argp(), l); }
            REPBAR(4); } SEAM(pb + 1);
        }
        if (ON(5) && IN(pb + 2)) { for (int rep = 0; rep < REPS(5); ++rep) { scan_phase(F, argp(), l); REPBAR(5); } SEAM(pb + 2); }
        if (ON(6) && IN(pb + 3)) { for (int rep = 0; rep < REPS(6); ++rep) {
            unsigned char* ws = opq_p(F.ws); CArgsP AP = argp(); (void)AP;
            typedef pg8::BatchSched<NCHP / 256, 4, 16> SchedT; SchedT S{(const char*)(ws + WS_UCAT), (const char*)(ws + WS_S5M) + (size_t)l * 16 * 1024 * S5K * 2, (size_t)NCHP * S5K * 2, (size_t)1024 * S5K * 2, (size_t)256 * S5K * 2, (size_t)256 * S5K * 2, opq_s(F.G), opq_s(F.bid)};
            EpiS5Y E{(bf16_t*)(ws + WS_YS5)};
            pg8::gemm_phase<EpiS5Y, SchedT, false>(F.lds, (unsigned)(S5K * 2), (unsigned)(S5K * 2), S5K, S, E);
            __syncthreads();
            gla_out(F, argp(), l);
            if (opq_s(F.bid) >= 224) conv_slot(F, argp(), l, CONV_B_GO + 32 * CONV_PER_WG, opq_s(F.bid) - 224, 3 * CONV_PER_WG);
            else if (opq_s(F.bid) >= 192) conv_slot(F, argp(), l, CONV_B_GO, opq_s(F.bid) - 192);
            REPBAR(6); } SEAM(pb + 3);
        }
        if (ON(7) && IN(pb + 4)) { for (int rep = 0; rep < REPS(7); ++rep) {
            unsigned char* ws = opq_p(F.ws); CArgsP AP = argp(); (void)AP;
            typedef pg8::DenseSched<T / 256, 1> SchedT; SchedT S{(const char*)(ws + WS_YS5), (const char*)(ws + WS_GLUT) + (size_t)l * 256 * 512, (size_t)256 * 512, (size_t)256 * 512, opq_s(F.G), opq_s(F.bid), T / 256};
            EpiGlu E{(const bf16_t*)(ws + WS_YS5), (bf16_t*)(ws + WS_MIXED), GIN(AP, 23) + l * 256};
            pg8::gemm_phase<EpiGlu, SchedT, false>(F.lds, 512u, 512u, 256, S, E);
            if (opq_s(F.bid) >= 132) conv_slot(F, argp(), l, CONV_B_GLU, opq_s(F.bid) - 132);
            REPBAR(7); } SEAM(pb + 4);
        }
        if (ON(8) && IN(pb + 5)) { for (int rep = 0; rep < REPS(8); ++rep) {
            unsigned char* ws = opq_p(F.ws); CArgsP AP = argp(); (void)AP;
            typedef pg8::DenseSched<T / 256, 4> SchedT; SchedT S{(const char*)(ws + WS_MIXED), (const char*)(ws + WS_WOUT) + (size_t)l * 1024 * 2048, (size_t)256 * 2048, (size_t)256 * 2048, opq_s(F.G), opq_s(F.bid), opq_s(ntok / 256)};
            EpiBf16 E{(bf16_t*)(ws + WS_TMP), 1024};
            pg8::gemm_phase<EpiBf16, SchedT, false>(F.lds, 2048u, 2048u, 1024, S, E);
            if (l < DEPTH - 1 && opq_s(F.bid) >= 16) conv_slot(F, argp(), l, CONV_B_OUT, opq_s(F.bid) - 16);
            REPBAR(8); } SEAM(pb + 5);
        }
        if (ON(9) && IN(pb + 6)) { if (REPMASK & 0x200u) { ln1_router(F, argp(), l, ntok, true); __syncthreads(); } ln1_router(F, argp(), l, ntok); SEAM(pb + 6); }
        if (ON(11) && IN(pb + 7)) { for (int rep = 0; rep < REPS(11); ++rep) {
            unsigned char* ws = opq_p(F.ws); CArgsP AP = argp(); (void)AP;
            moe_prefix(F); stagger(F.bid, STAGGER_UP);
            pg8::MoeSched<8, true> S{(const char*)(ws + WS_QS), (const char*)(ws + WS_WUP) + (size_t)l * 32 * 2048 * 1024, (const int*)(ws + WS_SLOTTOK), (const LAS int*)(F.CTLW + 160), 0, (size_t)2048 * 1024, (size_t)256 * 1024, opq_s(F.G), opq_s(F.bid)};
            EpiUp E{(unsigned char*)(ws + WS_ACT), (const bf16_t*)(ws + WS_BUP) + (size_t)l * 32 * 2048};
            pg8::gemm_phase<EpiUp, pg8::MoeSched<8, true>, true, true>(F.lds, 1024u, 1024u, 1024, S, E);
            REPBAR(11); } SEAM(pb + 7);
        }
        if (ON(12) && IN(pb + 8)) { for (int rep = 0; rep < REPS(12); ++rep) {
            unsigned char* ws = opq_p(F.ws); CArgsP AP = argp(); (void)AP;
            moe_prefix(F); stagger(F.bid, STAGGER_DN);
            pg8::MoeSched<4, false> S{(const char*)(ws + WS_ACT), (const char*)(ws + WS_WDN) + (size_t)l * 32 * 1024 * 1024, (const int*)(ws + WS_SLOTTOK), (const LAS int*)(F.CTLW + 160), (size_t)256 * 1024, (size_t)1024 * 1024, (size_t)256 * 1024, opq_s(F.G), opq_s(F.bid)};
            EpiDown E{(unsigned char*)(ws + WS_YV), (const bf16_t*)(ws + WS_BDN) + (size_t)l * 32 * 1024};
            pg8::gemm_phase<EpiDown, pg8::MoeSched<4, false>, false, true>(F.lds, 1024u, 1024u, 1024, S, E);
            if (l + 1 < DEPTH && opq_s(F.bid) >= 192) conv_slot(F, argp(), l + 1, conv_q(l + 1) - CONV_DN, opq_s(F.bid) - 192);
            REPBAR(12); } SEAM(pb + 8);
        }
        if (ON(13) && IN(pb + 9)) { if (REPMASK & 0x2000u) { combine_ln2(F, argp(), l, ntok, true); __syncthreads(); } combine_ln2(F, argp(), l, ntok); SEAM(pb + 9); }
    }
#undef IN
#undef SEAM
}

extern "C" void kernel_launch(void* const* d_in, const int* in_sizes, int n_in, void* d_out, int out_size, void* d_ws, size_t ws_size, hipStream_t stream) {
    static int grid = 0;
    if (grid == 0) {
        if (n_in != 33 || out_size != TLAT * D || ws_size < WS_END) { fprintf(stderr, "kernel_launch: unexpected problem (n_in %d, out %d, ws %zu)\n", n_in, out_size, ws_size); grid = -1; return; }
        int dev = 0, cus = 0, per_cu = 0;
        if (hipGetDevice(&dev) != hipSuccess || hipDeviceGetAttribute(&cus, hipDeviceAttributeMultiprocessorCount, dev) != hipSuccess) { grid = -1; return; }
        if (hipFuncSetAttribute((const void*)hybrid_fwd, hipFuncAttributeMaxDynamicSharedMemorySize, LDS_BYTES) != hipSuccess) { fprintf(stderr, "kernel_launch: hipFuncSetAttribute failed\n"); grid = -1; return; }
        if (hipOccupancyMaxActiveBlocksPerMultiprocessor(&per_cu, (const void*)hybrid_fwd, NTHR, LDS_BYTES) != hipSuccess || per_cu < 1) fprintf(stderr, "kernel_launch: occupancy query says %d\n", per_cu);
        (void)hipGetLastError();
        grid = cus;
        if (grid != 256) { fprintf(stderr, "kernel_launch: built for 256 CUs, found %d\n", cus); grid = -1; return; }
    }
    if (grid < 0) return;
    if (hipMemsetAsync((char*)d_ws + WS_CTL, 0, CTL_ZERO_BYTES, stream) != hipSuccess) return;
    Args a{};
    for (int i = 0; i < 33; ++i) a.in[i] = (const float*)d_in[i];
    a.out = (float*)d_out; a.ws = (unsigned char*)d_ws;
#if MK_N_LAUNCHES == 1
    a.ph_lo = 0; a.ph_hi = NPH;
    hipLaunchKernelGGL(hybrid_fwd, dim3(grid), dim3(NTHR), LDS_BYTES, stream, a);
#else
    for (int p = 0; p < NPH; ++p) { a.ph_lo = p; a.ph_hi = p + 1; hipLaunchKernelGGL(hybrid_fwd, dim3(grid), dim3(NTHR), LDS_BYTES, stream, a); }
#endif
}
```

```cpp
#include <hip/hip_runtime.h>
#include <cstdio>
#include <cstdint>

#define REPMASK 0u
#ifndef MK_N_LAUNCHES
#define MK_N_LAUNCHES 1
#endif

#define GAS __attribute__((address_space(1)))
#define LAS __attribute__((address_space(3)))
typedef unsigned short bf16_t;
typedef short bf16x8 __attribute__((ext_vector_type(8)));
typedef float f32x4 __attribute__((ext_vector_type(4)));
typedef float f32x2 __attribute__((ext_vector_type(2)));
typedef unsigned u32x4 __attribute__((ext_vector_type(4)));
typedef unsigned u32x2 __attribute__((ext_vector_type(2)));
typedef int s32x4 __attribute__((ext_vector_type(4)));

constexpr int D = 1024, NB = 4, SEQ = 8192, DEPTH = 4, CTXL = 256;
constexpr int TLAT = NB * SEQ, TCTX = NB * CTXL, T = TLAT + TCTX;
constexpr int NIN = 2336, NINP = 2560, PROJW = 2048;
constexpr int NCH = T / 64, NCHP = 768;
constexpr int NEXP = 32, DEXP = 1024;
constexpr int MAXTILES = 560, NSLOT = MAXTILES * 256;
constexpr int S5K = 1280;
constexpr float LN_EPS = 1e-5f;
constexpr float DN_ALPHA = 1.681792830507429f;
constexpr int NWAVES = 8, NTHR = 512;

constexpr size_t MiB = 1u << 20;
constexpr size_t WS_CTL = 0, CTL_ZERO_BYTES = 32768;
constexpr size_t WS_MODP = 1 * MiB, WS_MOD = 5 * MiB, WS_LB64 = 6 * MiB, WS_KTAB = 7 * MiB, WS_SGUW = 15 * MiB, WS_GLUT = 16 * MiB;
constexpr size_t WS_WIN = 17 * MiB, WS_WOUT = 37 * MiB, WS_S5M = 45 * MiB, WS_S5F = 205 * MiB, WS_WUP = 237 * MiB, WS_WDN = 749 * MiB;
constexpr size_t WS_X = 1005 * MiB, WS_H = 1137 * MiB, WS_PROJ = 1203 * MiB, WS_GL = 1335 * MiB, WS_UCAT = 1340 * MiB, WS_HLOC = 1370 * MiB;
constexpr size_t WS_YS5 = 1382 * MiB, WS_QS = 1399 * MiB, WS_KS = 1432 * MiB, WS_QH = 1465 * MiB, WS_VT = 1498 * MiB, WS_GLAST = 1531 * MiB;
constexpr size_t WS_SPREV = 1663 * MiB, WS_GDEC = 1729 * MiB, WS_MIXED = 1731 * MiB, WS_TMP = 1797 * MiB, WS_TOPI = 1929 * MiB, WS_GATE = 1930 * MiB;
constexpr size_t WS_WGCNT = 1931 * MiB, WS_ECNT = 1932 * MiB, WS_SLOTTOK = 1933 * MiB, WS_TOKSLOT = 1934 * MiB, WS_ACT = 1935 * MiB, WS_YV = 2215 * MiB;
constexpr size_t WS_WRT = 2495 * MiB, WS_BUP = 2496 * MiB, WS_BDN = 2497 * MiB, WS_STAT = 2498 * MiB, WS_WRH = 2500 * MiB, WS_WRL = 2501 * MiB, WS_END = 2502 * MiB;
constexpr int CW_BAR = 4096;

constexpr int RING_BYTES = 131072;
constexpr int LDS_BYTES = 163840;
constexpr int LDSCTL_OFF = LDS_BYTES - 1024;

__device__ __forceinline__ float bf2f(unsigned b) { return __uint_as_float(b << 16); }
__device__ __forceinline__ unsigned f2bf(float f) { unsigned u = __float_as_uint(f); return (u + 0x7fffu + ((u >> 16) & 1u)) >> 16; }
__device__ __forceinline__ unsigned pk2(float lo, float hi) { unsigned r; asm("v_cvt_pk_bf16_f32 %0, %1, %2" : "=v"(r) : "v"(lo), "v"(hi)); return r; }
__device__ __forceinline__ unsigned cvt_pk_bf16(float lo, float hi) { unsigned r; asm volatile("v_cvt_pk_bf16_f32 %0, %1, %2" : "=v"(r) : "v"(lo), "v"(hi)); return r; }
__device__ __forceinline__ unsigned pk4_fp8(float a, float b, float c, float d) { int w = 0; w = __builtin_amdgcn_cvt_pk_fp8_f32(a, b, w, false); w = __builtin_amdgcn_cvt_pk_fp8_f32(c, d, w, true); return (unsigned)w; }
__device__ __forceinline__ f32x4 unpk4(u32x2 w) { return (f32x4){bf2f(w.x & 0xffffu), bf2f(w.x >> 16), bf2f(w.y & 0xffffu), bf2f(w.y >> 16)}; }
__device__ __forceinline__ u32x2 pk4(f32x4 v) { u32x2 o; o.x = pk2(v[0], v[1]); o.y = pk2(v[2], v[3]); return o; }
__device__ __forceinline__ float rcpf(float x) { return __builtin_amdgcn_rcpf(x); }
__device__ __forceinline__ float sigmoidf_(float x) { return rcpf(1.0f + __expf(-x)); }
__device__ __forceinline__ float siluf_(float x) { return x * sigmoidf_(x); }
__device__ __forceinline__ float gelu_tanh(float x) { const float u = 0.7978845608028654f * (x + 0.044715f * x * x * x); const float e = __expf(2.0f * u); return x * (1.0f - rcpf(1.0f + e)); }
__device__ __forceinline__ float logsigmoidf_(float x) { return fminf(x, 0.0f) - __logf(1.0f + __expf(-fabsf(x))); }
__device__ __forceinline__ float wave_sum(float v) {
#define WS_DPP(ctrl) v += __int_as_float(__builtin_amdgcn_update_dpp(0, __float_as_int(v), ctrl, 0xf, 0xf, false))
    WS_DPP(0xB1); WS_DPP(0x4E); WS_DPP(0x141); WS_DPP(0x140);
#undef WS_DPP
    const int b = __float_as_int(v);
    const float r0 = __int_as_float(__builtin_amdgcn_readlane(b, 0)), r1 = __int_as_float(__builtin_amdgcn_readlane(b, 16)), r2 = __int_as_float(__builtin_amdgcn_readlane(b, 32)), r3 = __int_as_float(__builtin_amdgcn_readlane(b, 48));
    return (r0 + r1) + (r2 + r3);
}
__device__ __forceinline__ int opq(int x) { asm volatile("" : "+v"(x)); return x; }
__device__ __forceinline__ int opq_s(int x) { asm volatile("" : "+s"(x)); return x; }
__device__ __forceinline__ LAS unsigned char* opq_l(LAS unsigned char* p) { asm volatile("" : "+s"(p)); return p; }
__device__ __forceinline__ int tok_vec(int tk) { return tk < TLAT ? (tk >> 13) : 4; }

#define XB_TMO      128
#define XB_XCNT(j)  (256  + 64 * (j))
#define XB_XSUB(j)  (1280 + 64 * (j))
#define XB_XGEN(j)  (2304 + 64 * (j))
#define XB_TOP      3328
#define XB_TOPGEN   3392
#define XCD_BAR_WORDS 3456
#define XB_SPIN_CAP (1u << 20)
__device__ __forceinline__ unsigned xb_ld(unsigned* p)              { return __hip_atomic_load(p, __ATOMIC_RELAXED, __HIP_MEMORY_SCOPE_AGENT); }
__device__ __forceinline__ unsigned xb_add(unsigned* p, unsigned v) { return __hip_atomic_fetch_add(p, v, __ATOMIC_RELAXED, __HIP_MEMORY_SCOPE_AGENT); }
__device__ __forceinline__ unsigned xb_xcc_id() { return (unsigned)__builtin_amdgcn_s_getreg((3 << 11) | 20) & 0xFu; }
#define XB_SPIN(cond, bar) do { unsigned _sp = 0; while (cond) { __builtin_amdgcn_s_sleep(1); \
    if ((++_sp & 255u) == 0u) { if (xb_ld(&(bar)[XB_TMO])) break; if (_sp > XB_SPIN_CAP) { atomicAdd(&(bar)[XB_TMO], 1u); break; } } } } while (0)
struct XcdBarrier { unsigned* bar; unsigned x; volatile LAS unsigned* st; };
__device__ __forceinline__ XcdBarrier xcd_barrier_post(unsigned* bar, volatile LAS unsigned* st) {
    XcdBarrier b; b.bar = bar; b.x = xb_xcc_id(); b.st = st;
    if (threadIdx.x == 0) (void)xb_add(&bar[XB_XCNT(b.x)], 1u);
    return b;
}
__device__ __forceinline__ void xcd_barrier_complete(unsigned* bar, unsigned x, unsigned& nloc, unsigned& nx) {
    const unsigned G = gridDim.x * gridDim.y * gridDim.z;
    unsigned sum, cnt, mine, sp = 0u;
    for (;;) {
        sum = 0u; cnt = 0u; mine = 0u;
#pragma unroll
        for (unsigned j = 0; j < 16; ++j) { const unsigned c = xb_ld(&bar[XB_XCNT(j)]); sum += c; cnt += (c > 0u) ? 1u : 0u; mine = (j == x) ? c : mine; }
        if (sum == G) break;
        __builtin_amdgcn_s_sleep(1);
        if ((++sp & 255u) == 0u) { if (xb_ld(&bar[XB_TMO])) break; if (sp > XB_SPIN_CAP) { atomicAdd(&bar[XB_TMO], 1u); break; } }
    }
    nloc = mine > 0u ? mine : 1u; nx = cnt > 0u ? cnt : 1u;
}
__device__ __forceinline__ void xcd_barrier(const XcdBarrier& b) {
    asm volatile("s_waitcnt vmcnt(0)" ::: "memory");
    __syncthreads();
    if (threadIdx.x == 0) {
        unsigned* bar = b.bar;
        __builtin_amdgcn_s_waitcnt(0);
        unsigned nloc = b.st[0], nx = b.st[1];
        if (nloc == 0u) { xcd_barrier_complete(bar, b.x, nloc, nx); b.st[0] = nloc; b.st[1] = nx; }
        const unsigned old = xb_add(&bar[XB_XSUB(b.x)], 1u);
        const unsigned gen = old / nloc;
        if (old + 1u == (gen + 1u) * nloc) {
            __builtin_amdgcn_fence(__ATOMIC_RELEASE, "agent");
            asm volatile("s_waitcnt vmcnt(0)" ::: "memory");
            const unsigned og = xb_add(&bar[XB_TOP], 1u);
            const unsigned tg = og / nx;
            if (og + 1u == (tg + 1u) * nx) xb_add(&bar[XB_TOPGEN], 1u);
            else XB_SPIN(xb_ld(&bar[XB_TOPGEN]) == tg, bar);
            __builtin_amdgcn_fence(__ATOMIC_ACQUIRE, "agent");
            (void)xb_add(&bar[XB_XGEN(b.x)], 1u);
        } else {
            XB_SPIN(xb_ld(&bar[XB_XGEN(b.x)]) == gen, bar);
            __builtin_amdgcn_fence(__ATOMIC_ACQUIRE, "agent");
            asm volatile("s_waitcnt vmcnt(0)" ::: "memory");
        }
    }
    __syncthreads();
}

namespace pg8 {
constexpr int BM = 256, BK = 64, HALF = 128, HTB = HALF * BK * 2, STAGE_BYTES = 8 * HTB, NXCD = 8, WGM = 8;
__host__ __device__ __forceinline__ int lds_byte(int r, int c) { const int st = (r >> 4) * 2 + (c >> 5), rr = r & 15, cc = c & 31, ob = rr * 64 + cc * 2; return st * 1024 + (ob ^ (((ob >> 9) & 1) << 5)); }
__host__ __device__ __forceinline__ void stage_rc(int b, int& R, int& C) { const int st = b / 1024, sb = b % 1024, swz = sb ^ (((sb >> 9) & 1) << 5); R = (st >> 1) * 16 + swz / 64; C = (st & 1) * 32 + (swz % 64) / 2; }
__host__ __device__ __forceinline__ int perm32(int rho) { const int n = rho >> 4, i = rho & 15; return 8 * (i >> 2) + 4 * n + (i & 3); }

struct GUnit { const char* a; const char* b; const int* rows; int pm, pn, grp; };

__device__ __forceinline__ void gld128_asm(f32x4& d, const float* p) { asm volatile("global_load_dwordx4 %0, %1, off" : "=v"(d) : "v"((GAS const float*)p) : "memory"); }
__device__ __forceinline__ void gld32_asm(int& d, const int* p) { asm volatile("global_load_dword %0, %1, off" : "=v"(d) : "v"((GAS const int*)p) : "memory"); }
typedef int i32x4 __attribute__((ext_vector_type(4)));
typedef int i32x8 __attribute__((ext_vector_type(8)));
__device__ __forceinline__ i32x8 cat8(bf16x8 lo, bf16x8 hi) { const i32x4 a = __builtin_bit_cast(i32x4, lo), b = __builtin_bit_cast(i32x4, hi); return __builtin_shufflevector(a, b, 0, 1, 2, 3, 4, 5, 6, 7); }
template <class Epi, class Sched, bool GATHER, bool FP8 = false>
__device__ __forceinline__ void gemm_phase(LAS unsigned char* lds, const unsigned lda, const unsigned ldb, const int K, const Sched& S, const Epi& E) {
    const int tid = opq((int)threadIdx.x), wid = __builtin_amdgcn_readfirstlane(tid >> 6), lane = tid & 63, wr = wid >> 2, wc = wid & 3, fr = lane & 15, fq = lane >> 4;
    int Kq = K; asm volatile("" : "+s"(Kq)); const int nt = FP8 ? Kq / 128 : Kq / BK;
    unsigned voffB[2], cA0[2], cA1[2];
#pragma unroll
    for (int i = 0; i < 2; ++i) { int R, C; stage_rc(tid * 16 + i * 8192, R, C); const int Rb = Epi::PERM ? ((R & ~31) + perm32(R & 31)) : R;
        voffB[i] = (unsigned)Rb * ldb + (unsigned)C * 2u; }
    const size_t kstep = (size_t)(BK * 2);
    const size_t hstepB = (size_t)HALF * ldb;
    const unsigned ldsw = (unsigned)wid * 1024u;
    const int aoff = lds_byte(wr * 64 + fr, fq * 8), boff = lds_byte(wc * 32 + fr, fq * 8);
#define PG8_AOFF(u, o0, o1) do { const int _t = opq((int)threadIdx.x); _Pragma("unroll") for (int _i = 0; _i < 2; ++_i) { int _R, _C; stage_rc(_t * 16 + _i * 8192, _R, _C); \
        if (GATHER) { const unsigned _p = (unsigned)(u).rows[_R]; o0[_i] = (_p & 0xffffu) * lda + (unsigned)_C * 2u; o1[_i] = (_p >> 16) * lda + (unsigned)_C * 2u; } \
        else { o0[_i] = (unsigned)_R * lda + (unsigned)_C * 2u; o1[_i] = o0[_i] + (unsigned)HALF * lda; } } } while (0)
#define PG8_SA(b, h) (((b) * 2 + (h)) * HTB)
#define PG8_SB(b, h) ((4 + (b) * 2 + (h)) * HTB)
#define PG8_STAGE(bufoff, gbase, voff) do { _Pragma("unroll") for (int _i = 0; _i < 2; ++_i) \
        __builtin_amdgcn_global_load_lds((const unsigned*)((const char*)(gbase) + (voff)[_i]), (LAS unsigned*)(lds + (bufoff) + ldsw + _i * 8192), 16, 0, 0); } while (0)
#define PG8_LDA(dst, b, h) do { _Pragma("unroll") for (int m = 0; m < 4; ++m) { dst[m].lo = *(const LAS i32x4*)(lds + PG8_SA(b, h) + aoff + m * 2048); dst[m].hi = *(const LAS i32x4*)(lds + PG8_SA(b, h) + aoff + m * 2048 + 1024); } } while (0)
#define PG8_LDB(dst, b, h) do { _Pragma("unroll") for (int n = 0; n < 2; ++n) { dst[n].lo = *(const LAS i32x4*)(lds + PG8_SB(b, h) + boff + n * 2048); dst[n].hi = *(const LAS i32x4*)(lds + PG8_SB(b, h) + boff + n * 2048 + 1024); } } while (0)
#define PG8_MMA(ai, bj, At, Bt) do { __builtin_amdgcn_s_setprio(1); if constexpr (FP8) asm volatile("s_nop 4"); _Pragma("unroll") for (int m = 0; m < 4; ++m) _Pragma("unroll") for (int n = 0; n < 2; ++n) { \
        if constexpr (FP8) asm volatile("v_mfma_scale_f32_16x16x128_f8f6f4 %0, %1, %2, %0, %3, %3 op_sel_hi:[0,0,0]" : "+v"(acc[ai][bj][m][n]) : "v"(Bt[n]), "v"(At[m]), "v"(sc1)); \
        else { acc[ai][bj][m][n] = __builtin_amdgcn_mfma_f32_16x16x32_bf16(__builtin_bit_cast(bf16x8, (i32x4)Bt[n].lo), __builtin_bit_cast(bf16x8, (i32x4)At[m].lo), acc[ai][bj][m][n], 0, 0, 0); \
               acc[ai][bj][m][n] = __builtin_amdgcn_mfma_f32_16x16x32_bf16(__builtin_bit_cast(bf16x8, (i32x4)Bt[n].hi), __builtin_bit_cast(bf16x8, (i32x4)At[m].hi), acc[ai][bj][m][n], 0, 0, 0); } } \
        __builtin_amdgcn_s_setprio(0); } while (0)
#define PG8_WAIT_V(n) asm volatile("s_waitcnt vmcnt(" #n ")" ::: "memory")
#define PG8_WAIT_L(n) asm volatile("s_waitcnt lgkmcnt(" #n ")" ::: "memory")
#define PG8_BAR __builtin_amdgcn_s_barrier()
#define PG8_SCHED __builtin_amdgcn_sched_barrier(0)
    GUnit cur, nxt; int ui = 0;
    if (!S.next(0, cur)) return;
    f32x4 acc[2][2][4][2];
#pragma unroll
    for (int a = 0; a < 2; ++a)
#pragma unroll
        for (int b = 0; b < 2; ++b)
#pragma unroll
            for (int m = 0; m < 4; ++m)
#pragma unroll
                for (int n = 0; n < 2; ++n) acc[a][b][m][n] = (f32x4){0.f, 0.f, 0.f, 0.f};
    const int sc1 = 0x7f7f7f7f;
    i32x8 At[4], B0[2], B1[2];
    const char* cA = cur.a; const char* cB = cur.b;
    PG8_AOFF(cur, cA0, cA1);
    PG8_STAGE(PG8_SB(0, 0), cB, voffB); PG8_STAGE(PG8_SB(0, 1), cB + hstepB, voffB); PG8_STAGE(PG8_SA(0, 0), cA, cA0); PG8_STAGE(PG8_SA(0, 1), cA, cA1);
    if (wr == 1) PG8_BAR;
    PG8_WAIT_V(2); PG8_BAR;
    PG8_STAGE(PG8_SB(1, 0), cB + kstep, voffB); PG8_STAGE(PG8_SA(1, 0), cA + kstep, cA0); PG8_STAGE(PG8_SB(1, 1), cB + hstepB + kstep, voffB);
    PG8_WAIT_V(6); PG8_BAR;
    for (;;) {
        const bool has_next = S.next(ui + 1, nxt);
        const char* nA = has_next ? nxt.a : cA; const char* nB = has_next ? nxt.b : cB;
        int nr[2] = {0, 0};
        if constexpr (GATHER) { if (has_next) { const int _t = opq((int)threadIdx.x);
#pragma unroll
            for (int i = 0; i < 2; ++i) { int R, C; stage_rc(_t * 16 + i * 8192, R, C); gld32_asm(nr[i], nxt.rows + R); } } }
        f32x4 ebias[4]; E.prefetch(cur, ebias);
#ifdef PROBE_KLOOP2
        int krep = FP8 ? 2 : 1; asm volatile("" : "+s"(krep));
#else
        constexpr int krep = 1;
#endif
        for (int rep = 0; rep < krep; ++rep) {
        for (int t = 0; t < nt; t += 2) {
            const bool lastk = (t == nt - 2), last = lastk && (rep == krep - 1);
            const char* a1 = cA + (size_t)(t + 1) * kstep;
            const char* a2 = lastk ? (last ? nA : cA) : cA + (size_t)(t + 2) * kstep; const char* b2 = lastk ? (last ? nB : cB) : cB + (size_t)(t + 2) * kstep;
            const char* a3 = a2 + kstep; const char* b3 = b2 + kstep;
            unsigned s0[2], s1[2];
#pragma unroll
            for (int i = 0; i < 2; ++i) { s0[i] = cA0[i]; s1[i] = cA1[i];
                if constexpr (GATHER) { if (last && has_next) { asm volatile("" : "+v"(nr[i])); int R, C; stage_rc(opq((int)threadIdx.x) * 16 + i * 8192, R, C);
                    s0[i] = ((unsigned)nr[i] & 0xffffu) * lda + (unsigned)C * 2u; s1[i] = ((unsigned)nr[i] >> 16) * lda + (unsigned)C * 2u; } } }
            PG8_LDB(B0, 0, 0); PG8_LDB(B1, 0, 1); PG8_SCHED; PG8_LDA(At, 0, 0); PG8_STAGE(PG8_SA(1, 1), a1, cA1);
            PG8_WAIT_V(8); PG8_WAIT_L(0); PG8_BAR; PG8_MMA(0, 0, At, B0); PG8_MMA(0, 1, At, B1); PG8_BAR; PG8_SCHED;
            PG8_LDA(At, 0, 1); PG8_STAGE(PG8_SB(0, 0), b2, voffB); PG8_STAGE(PG8_SB(0, 1), b2 + hstepB, voffB); PG8_STAGE(PG8_SA(0, 0), a2, s0);
            PG8_WAIT_V(8); PG8_WAIT_L(0); PG8_BAR; PG8_MMA(1, 0, At, B0); PG8_MMA(1, 1, At, B1); PG8_BAR; PG8_SCHED;
            PG8_LDB(B0, 1, 0); PG8_LDB(B1, 1, 1); PG8_SCHED; PG8_LDA(At, 1, 0); PG8_STAGE(PG8_SA(0, 1), a2, s1);
            PG8_WAIT_V(8); PG8_WAIT_L(0); PG8_BAR; PG8_MMA(0, 0, At, B0); PG8_MMA(0, 1, At, B1); PG8_BAR; PG8_SCHED;
            PG8_LDA(At, 1, 1); PG8_STAGE(PG8_SB(1, 0), b3, voffB); PG8_STAGE(PG8_SB(1, 1), b3 + hstepB, voffB); PG8_STAGE(PG8_SA(1, 0), a3, s0);
            PG8_WAIT_V(8); PG8_WAIT_L(0); PG8_BAR; PG8_MMA(1, 0, At, B0); PG8_MMA(1, 1, At, B1); PG8_BAR; PG8_SCHED;
        }
#ifdef PROBE_KLOOP2
        if (rep + 1 < krep) { asm volatile("s_nop 15\n\ts_nop 15");
#pragma unroll
            for (int a = 0; a < 2; ++a)
#pragma unroll
                for (int b = 0; b < 2; ++b)
#pragma unroll
                    for (int m = 0; m < 4; ++m)
#pragma unroll
                        for (int n = 0; n < 2; ++n) acc[a][b][m][n] = (f32x4){0.f, 0.f, 0.f, 0.f}; }
#endif
        }
        if constexpr (FP8) asm volatile("s_nop 15\n\ts_nop 15");
        if (wr == 0) PG8_BAR;
        if constexpr (Epi::NB == 4) asm volatile("" : "+v"(ebias[0]), "+v"(ebias[1]), "+v"(ebias[2]), "+v"(ebias[3]));
        else if constexpr (Epi::NB == 2) asm volatile("" : "+v"(ebias[0]), "+v"(ebias[1]));
        { const int _t = opq((int)threadIdx.x), _w = __builtin_amdgcn_readfirstlane(_t >> 6), _l = _t & 63; E(acc, cur, _w >> 2, _w & 3, _l & 15, _l >> 4, ebias); }
#ifdef PROBE_EPI2_OFF
        if constexpr (FP8) { const int _t = opq((int)threadIdx.x), _w = __builtin_amdgcn_readfirstlane(_t >> 6), _l = _t & 63; asm volatile("" ::: "memory"); E(acc, cur, _w >> 2, _w & 3, _l & 15, _l >> 4); }
#endif
        if (!has_next) break;
#pragma unroll
        for (int a = 0; a < 2; ++a)
#pragma unroll
            for (int b = 0; b < 2; ++b)
#pragma unroll
                for (int m = 0; m < 4; ++m)
#pragma unroll
                    for (int n = 0; n < 2; ++n) acc[a][b][m][n] = (f32x4){0.f, 0.f, 0.f, 0.f};
        cur = nxt; cA = nA; cB = nB; ++ui;
        if constexpr (GATHER) {
#pragma unroll
            for (int i = 0; i < 2; ++i) { int R, C; stage_rc(opq((int)threadIdx.x) * 16 + i * 8192, R, C); cA0[i] = ((unsigned)nr[i] & 0xffffu) * lda + (unsigned)C * 2u; cA1[i] = ((unsigned)nr[i] >> 16) * lda + (unsigned)C * 2u; } }
        if (wr == 1) PG8_BAR;
    }
    PG8_WAIT_V(0);
    PG8_BAR;
#undef PG8_AOFF
#undef PG8_SA
#undef PG8_SB
#undef PG8_STAGE
#undef PG8_LDA
#undef PG8_LDB
#undef PG8_MMA
#undef PG8_WAIT_V
#undef PG8_WAIT_L
#undef PG8_BAR
#undef PG8_SCHED
}

template <int NM, int NN> struct DenseSched {
    const char* A; const char* B; size_t tstepA, tstepB; int G, c, nm;
    __device__ __forceinline__ bool next(int i, GUnit& u) const {
        constexpr int nig = WGM * NN;
        const int nwg = nm * NN, q = nwg >> 3, r = nwg & 7;
        const int L = i * G + c; if (L >= nwg) return false;
        const int xcd = L & 7, off = L >> 3; const int wgid = (xcd < r ? xcd * (q + 1) : r * (q + 1) + (xcd - r) * q) + off;
        const int gid = wgid / nig, w2 = wgid % nig, fm = gid * WGM, rem = nm - fm;
        if (rem >= WGM) { u.pm = fm + (w2 & 7); u.pn = w2 >> 3; } else { const int sh = __builtin_ctz(rem); u.pm = fm + (w2 & (rem - 1)); u.pn = w2 >> sh; }
        u.grp = 0; u.rows = nullptr;
        u.a = A + (size_t)u.pm * tstepA; u.b = B + (size_t)u.pn * tstepB; return true;
    }
};
template <int NM, int NN, int NGRP> struct BatchSched {
    const char* A; const char* B; size_t gstepA, gstepB, tstepA, tstepB; int G, c;
    __device__ __forceinline__ bool next(int i, GUnit& u) const {
        constexpr int per = NM * NN;
        const int L = i * G + c; if (L >= NGRP * per) return false;
        u.grp = L / per; const int r = L % per; u.pn = r % NN; u.pm = r / NN; u.rows = nullptr;
        u.a = A + (size_t)u.grp * gstepA + (size_t)u.pm * tstepA; u.b = B + (size_t)u.grp * gstepB + (size_t)u.pn * tstepB; return true;
    }
};
template <int NCT, bool GATHER> struct MoeSched {
    const char* A; const char* B; const int* slot_tok; const LAS int* pref; size_t tstepA, estepB, tstepB; int G, c;
    __device__ __forceinline__ bool next(int i, GUnit& u) const {
        constexpr int RPX = 32 / NCT;
        const int TT = pref[NEXP]; const int x = c & 7, w = c >> 3;
        const int chunk = (TT + 7) >> 3, lr = i * RPX + w / NCT;
        const int rt = x * chunk + lr, ct = w % NCT; if (lr >= chunk || rt >= TT) return false;
        int e = 0;
        for (int j = 1; j < NEXP; ++j) e += (pref[j] <= rt) ? 1 : 0;
        u.pm = rt; u.pn = ct; u.grp = e; u.rows = slot_tok + rt * 128;
        u.a = GATHER ? A : A + (size_t)rt * tstepA; u.b = B + (size_t)e * estepB + (size_t)ct * tstepB; return true;
    }
};
}
using pg8::GUnit;

struct Args { const float* in[33]; float* out; unsigned char* ws; int ph_lo, ph_hi; };

typedef const __attribute__((address_space(4))) Args* CArgsP;
__device__ __forceinline__ CArgsP argp() { CArgsP p = (CArgsP)__builtin_amdgcn_kernarg_segment_ptr(); asm volatile("" : "+s"(p)); return p; }
__device__ __forceinline__ unsigned char* opq_p(unsigned char* p) { GAS unsigned char* g = (GAS unsigned char*)p; asm volatile("" : "+s"(g)); return (unsigned char*)g; }
#define GIN(A, i) ((const float*)(GAS const float*)((A)->in[i]))
#define GOUT(A) ((float*)(GAS float*)((A)->out))

struct Frame {
    LAS unsigned char* lds; volatile LAS unsigned* CTLW;
    int tid, lane, wave, G, bid;
    unsigned char* ws;
};

struct EpiInProj { static constexpr int NB = 0; __device__ __forceinline__ void prefetch(const GUnit&, f32x4 (&b)[4]) const { }
    static constexpr bool PERM = true; bf16_t* proj; bf16_t* ucat; float* gl; bf16_t* vt; float* stat;
    __device__ __forceinline__ void operator()(const f32x4 (&acc)[2][2][4][2], const GUnit& u, int wr, int wc, int fr, int fq, const f32x4 (&pb)[4]) const {
        const int row0 = u.pm * 256 + wr * 64 + fr;
        if (u.pn == 4 || u.pn == 5) {
#pragma unroll
            for (int ai = 0; ai < 2; ++ai) { const int chunk = u.pm * 4 + ai * 2 + wr;
#pragma unroll
                for (int bj = 0; bj < 2; ++bj) { const int ecol = (u.pn - 4) * 256 + bj * 128 + wc * 32 + 8 * fq, h = ecol >> 7, e0 = ecol & 127;
                    bf16_t* base = vt + ((size_t)(chunk * 4 + h) * 128 + e0) * 64 + fr;
#pragma unroll
                    for (int m = 0; m < 4; ++m)
#pragma unroll
                        for (int n = 0; n < 2; ++n)
#pragma unroll
                            for (int i = 0; i < 4; ++i) base[(4 * n + i) * 64 + m * 16] = (bf16_t)f2bf(acc[ai][bj][m][n][i]); } }
        } else if (u.pn < 8) {
            const bool dog = u.pn < 2; float ssum[2][4] = {{0.f, 0.f, 0.f, 0.f}, {0.f, 0.f, 0.f, 0.f}}, ssq[2][4] = {{0.f, 0.f, 0.f, 0.f}, {0.f, 0.f, 0.f, 0.f}};
#pragma unroll
            for (int ai = 0; ai < 2; ++ai)
#pragma unroll
                for (int m = 0; m < 4; ++m) { bf16_t* rowp = proj + (size_t)(row0 + ai * 128 + m * 16) * PROJW + u.pn * 256 + wc * 32 + 8 * fq;
#pragma unroll
                    for (int bj = 0; bj < 2; ++bj) { f32x4 v0 = acc[ai][bj][m][0], v1 = acc[ai][bj][m][1];
                        if (dog) {
#pragma unroll
                            for (int j = 0; j < 4; ++j) { v0[j] = gelu_tanh(v0[j]); v1[j] = gelu_tanh(v1[j]); } }
                        u32x4 w; w.x = cvt_pk_bf16(v0[0], v0[1]); w.y = cvt_pk_bf16(v0[2], v0[3]); w.z = cvt_pk_bf16(v1[0], v1[1]); w.w = cvt_pk_bf16(v1[2], v1[3]);
                        *(u32x4*)(rowp + bj * 128) = w;
                        if (u.pn == 1) { const f32x4 r0 = unpk4((u32x2){w.x, w.y}), r1 = unpk4((u32x2){w.z, w.w});
                            ssum[ai][m] += (r0[0] + r0[1]) + (r0[2] + r0[3]) + (r1[0] + r1[1]) + (r1[2] + r1[3]);
                            ssq[ai][m] += (r0[0] * r0[0] + r0[1] * r0[1]) + (r0[2] * r0[2] + r0[3] * r0[3]) + (r1[0] * r1[0] + r1[1] * r1[1]) + (r1[2] * r1[2] + r1[3] * r1[3]); } } }
            if (u.pn == 1) {
#pragma unroll
                for (int ai = 0; ai < 2; ++ai)
#pragma unroll
                    for (int m = 0; m < 4; ++m) { float s = ssum[ai][m], q2 = ssq[ai][m]; s += __shfl_xor(s, 16); s += __shfl_xor(s, 32); q2 += __shfl_xor(q2, 16); q2 += __shfl_xor(q2, 32);
                        if (fq == 0) *(f32x2*)(stat + ((size_t)(row0 + ai * 128 + m * 16) * 4 + wc) * 2) = (f32x2){s, q2}; } }
        } else if (u.pn == 8) {
#pragma unroll
            for (int ai = 0; ai < 2; ++ai)
#pragma unroll
                for (int m = 0; m < 4; ++m) { const int row = row0 + ai * 128 + m * 16, chunk = row >> 6, s = row & 63;
#pragma unroll
                    for (int bj = 0; bj < 2; ++bj) { const int j0 = bj * 128 + wc * 32 + 8 * fq, g = j0 >> 4, h0 = j0 & 15;
                        const f32x4 v0 = acc[ai][bj][m][0], v1 = acc[ai][bj][m][1];
                        u32x4 w; w.x = cvt_pk_bf16(v0[0], v0[1]); w.y = cvt_pk_bf16(v0[2], v0[3]); w.z = cvt_pk_bf16(v1[0], v1[1]); w.w = cvt_pk_bf16(v1[2], v1[3]);
                        *(u32x4*)(ucat + ((size_t)(g * NCHP + chunk) * S5K + s * 16 + h0)) = w; } }
        } else {
            if (wc == 0) {
#pragma unroll
                for (int ai = 0; ai < 2; ++ai)
#pragma unroll
                    for (int m = 0; m < 4; ++m) { float* dst = gl + (size_t)(row0 + ai * 128 + m * 16) * 32 + 8 * fq;
                        *(f32x4*)dst = acc[ai][0][m][0]; *(f32x4*)(dst + 4) = acc[ai][0][m][1]; } }
        }
    }
};
struct EpiHloc { static constexpr int NB = 0; __device__ __forceinline__ void prefetch(const GUnit&, f32x4 (&b)[4]) const { }
    static constexpr bool PERM = false; float* hloc;
    __device__ __forceinline__ void operator()(const f32x4 (&acc)[2][2][4][2], const GUnit& u, int wr, int wc, int fr, int fq, const f32x4 (&pb)[4]) const {
        const int row0 = u.pm * 256 + wr * 64 + fr;
#pragma unroll
        for (int ai = 0; ai < 2; ++ai)
#pragma unroll
            for (int m = 0; m < 4; ++m) { float* rowp = hloc + ((size_t)u.grp * NCHP + row0 + ai * 128 + m * 16) * 256 + wc * 32 + 4 * fq;
#pragma unroll
                for (int bj = 0; bj < 2; ++bj)
#pragma unroll
                    for (int n = 0; n < 2; ++n) *(f32x4*)(rowp + bj * 128 + n * 16) = acc[ai][bj][m][n]; }
    }
};
struct EpiS5Y { static constexpr int NB = 0; __device__ __forceinline__ void prefetch(const GUnit&, f32x4 (&b)[4]) const { }
    static constexpr bool PERM = true; bf16_t* ys5;
    __device__ __forceinline__ void operator()(const f32x4 (&acc)[2][2][4][2], const GUnit& u, int wr, int wc, int fr, int fq, const f32x4 (&pb)[4]) const {
        const int row0 = u.pm * 256 + wr * 64 + fr;
#pragma unroll
        for (int ai = 0; ai < 2; ++ai)
#pragma unroll
            for (int m = 0; m < 4; ++m) { const int c = row0 + ai * 128 + m * 16;
                if (c < NCH) {
#pragma unroll
                    for (int bj = 0; bj < 2; ++bj) { const int j0 = u.pn * 256 + bj * 128 + wc * 32 + 8 * fq, t = j0 >> 4, h0 = j0 & 15;
                        f32x4 v0 = acc[ai][bj][m][0], v1 = acc[ai][bj][m][1];
#pragma unroll
                        for (int j = 0; j < 4; ++j) { v0[j] = gelu_tanh(v0[j]); v1[j] = gelu_tanh(v1[j]); }
                        u32x4 w; w.x = cvt_pk_bf16(v0[0], v0[1]); w.y = cvt_pk_bf16(v0[2], v0[3]); w.z = cvt_pk_bf16(v1[0], v1[1]); w.w = cvt_pk_bf16(v1[2], v1[3]);
                        *(u32x4*)(ys5 + (size_t)(c * 64 + t) * 256 + u.grp * 16 + h0) = w; } } }
    }
};
struct EpiGlu { static constexpr int NB = 4; static constexpr bool PERM = true; const bf16_t* ys5; bf16_t* mixed; const float* bias;
    __device__ __forceinline__ void prefetch(const GUnit&, f32x4 (&b)[4]) const {
        const int _t = opq((int)threadIdx.x), _w = __builtin_amdgcn_readfirstlane(_t >> 6), _l = _t & 63, wc = _w & 3, fq = _l >> 4;
        const float* bp = bias + wc * 32 + 8 * fq; pg8::gld128_asm(b[0], bp); pg8::gld128_asm(b[1], bp + 4); pg8::gld128_asm(b[2], bp + 128); pg8::gld128_asm(b[3], bp + 132); }
    __device__ __forceinline__ void operator()(const f32x4 (&acc)[2][2][4][2], const GUnit& u, int wr, int wc, int fr, int fq, const f32x4 (&pb)[4]) const {
        const int row0 = u.pm * 256 + wr * 64 + fr;
#pragma unroll
        for (int bj = 0; bj < 2; ++bj) { const int n0 = bj * 128 + wc * 32 + 8 * fq;
            const f32x4 b0 = pb[2 * bj], b1 = pb[2 * bj + 1];
#pragma unroll
            for (int ai = 0; ai < 2; ++ai)
#pragma unroll
                for (int m = 0; m < 4; ++m) { const int tok = row0 + ai * 128 + m * 16;
                    const u32x4 yv = *(const u32x4*)(ys5 + (size_t)tok * 256 + n0);
                    const f32x4 v0 = acc[ai][bj][m][0] + b0, v1 = acc[ai][bj][m][1] + b1;
                    float o[8];
                    o[0] = bf2f(yv.x & 0xffffu) * sigmoidf_(v0[0]); o[1] = bf2f(yv.x >> 16) * sigmoidf_(v0[1]); o[2] = bf2f(yv.y & 0xffffu) * sigmoidf_(v0[2]); o[3] = bf2f(yv.y >> 16) * sigmoidf_(v0[3]);
                    o[4] = bf2f(yv.z & 0xffffu) * sigmoidf_(v1[0]); o[5] = bf2f(yv.z >> 16) * sigmoidf_(v1[1]); o[6] = bf2f(yv.w & 0xffffu) * sigmoidf_(v1[2]); o[7] = bf2f(yv.w >> 16) * sigmoidf_(v1[3]);
                    u32x4 w; w.x = cvt_pk_bf16(o[0], o[1]); w.y = cvt_pk_bf16(o[2], o[3]); w.z = cvt_pk_bf16(o[4], o[5]); w.w = cvt_pk_bf16(o[6], o[7]);
                    *(u32x4*)(mixed + (size_t)tok * 1024 + 768 + n0) = w; asm volatile("" ::: "memory"); } }
    }
};
struct EpiF32 { static constexpr int NB = 0; __device__ __forceinline__ void prefetch(const GUnit&, f32x4 (&b)[4]) const { }
    static constexpr bool PERM = false; float* C; int ldc;
    __device__ __forceinline__ void operator()(const f32x4 (&acc)[2][2][4][2], const GUnit& u, int wr, int wc, int fr, int fq, const f32x4 (&pb)[4]) const {
        const int row0 = u.pm * 256 + wr * 64 + fr, col0 = u.pn * 256 + wc * 32 + 4 * fq;
#pragma unroll
        for (int ai = 0; ai < 2; ++ai)
#pragma unroll
            for (int m = 0; m < 4; ++m) { float* rowp = C + (size_t)(row0 + ai * 128 + m * 16) * ldc + col0;
#pragma unroll
                for (int bj = 0; bj < 2; ++bj)
#pragma unroll
                    for (int n = 0; n < 2; ++n) *(f32x4*)(rowp + bj * 128 + n * 16) = acc[ai][bj][m][n]; }
    }
};
struct EpiBf16 { static constexpr int NB = 0; __device__ __forceinline__ void prefetch(const GUnit&, f32x4 (&b)[4]) const { }
    static constexpr bool PERM = true; bf16_t* C; int ldc;
    __device__ __forceinline__ void operator()(const f32x4 (&acc)[2][2][4][2], const GUnit& u, int wr, int wc, int fr, int fq, const f32x4 (&pb)[4]) const {
        const int row0 = u.pm * 256 + wr * 64 + fr, col0 = u.pn * 256 + wc * 32 + 8 * fq;
#pragma unroll
        for (int ai = 0; ai < 2; ++ai)
#pragma unroll
            for (int m = 0; m < 4; ++m) { bf16_t* rowp = C + (size_t)(row0 + ai * 128 + m * 16) * ldc + col0;
#pragma unroll
                for (int bj = 0; bj < 2; ++bj) { const f32x4 v0 = acc[ai][bj][m][0], v1 = acc[ai][bj][m][1];
                    u32x4 w; w.x = cvt_pk_bf16(v0[0], v0[1]); w.y = cvt_pk_bf16(v0[2], v0[3]); w.z = cvt_pk_bf16(v1[0], v1[1]); w.w = cvt_pk_bf16(v1[2], v1[3]);
                    *(u32x4*)(rowp + bj * 128) = w; } }
    }
};
constexpr float WUP_SCALE = 32.0f, WDN_SCALE = 64.0f;
struct EpiUp { static constexpr int NB = 2; static constexpr bool PERM = true; unsigned char* act; const bf16_t* bup16;
    __device__ __forceinline__ void prefetch(const GUnit& u, f32x4 (&b)[4]) const {
        const int _t = opq((int)threadIdx.x), _w = __builtin_amdgcn_readfirstlane(_t >> 6), _l = _t & 63, wc = _w & 3, fq = _l >> 4;
        const float* bg = (const float*)(bup16 + (((size_t)u.grp * 8 + u.pn) * 16 + wc * 4 + fq) * 16);
        pg8::gld128_asm(b[0], bg); pg8::gld128_asm(b[1], bg + 4); }
    __device__ __forceinline__ void operator()(const f32x4 (&acc)[2][2][4][2], const GUnit& u, int wr, int wc, int fr, int fq, const f32x4 (&pb)[4]) const {
        const int row0 = u.pm * 256 + wr * 64 + fr, jj0 = wc * 32 + 8 * fq;
        const u32x4 w0 = __builtin_bit_cast(u32x4, pb[0]), w1 = __builtin_bit_cast(u32x4, pb[1]);
        const f32x4 g0 = (f32x4){bf2f(w0.x & 0xffffu), bf2f(w0.x >> 16), bf2f(w0.y & 0xffffu), bf2f(w0.y >> 16)}, g1 = (f32x4){bf2f(w0.z & 0xffffu), bf2f(w0.z >> 16), bf2f(w0.w & 0xffffu), bf2f(w0.w >> 16)};
        const f32x4 l0 = (f32x4){bf2f(w1.x & 0xffffu), bf2f(w1.x >> 16), bf2f(w1.y & 0xffffu), bf2f(w1.y >> 16)}, l1 = (f32x4){bf2f(w1.z & 0xffffu), bf2f(w1.z >> 16), bf2f(w1.w & 0xffffu), bf2f(w1.w >> 16)};
        const f32x4 l0p = l0 + 1.0f, l1p = l1 + 1.0f;
#pragma unroll
        for (int ai = 0; ai < 2; ++ai)
#pragma unroll
            for (int m = 0; m < 4; ++m) { const int slot = row0 + ai * 128 + m * 16;
                float o[8];
#pragma unroll
                for (int hh = 0; hh < 2; ++hh) { const f32x4 ag = acc[ai][0][m][hh], al = acc[ai][1][m][hh], gb = hh ? g1 : g0, lb = hh ? l1p : l0p;
#pragma unroll
                    for (int j = 0; j < 4; j += 2) {
                        const f32x2 s2 = (f32x2){1.0f / WUP_SCALE, 1.0f / WUP_SCALE};
                        f32x2 xg = __builtin_elementwise_fma((f32x2){ag[j], ag[j + 1]}, s2, (f32x2){gb[j], gb[j + 1]});
                        f32x2 xl = __builtin_elementwise_fma((f32x2){al[j], al[j + 1]}, s2, (f32x2){lb[j], lb[j + 1]});
                        const f32x2 a = (f32x2){fminf(xg.x, 7.0f), fminf(xg.y, 7.0f)};
                        const f32x2 b1 = (f32x2){__builtin_amdgcn_fmed3f(xl.x, -6.0f, 8.0f), __builtin_amdgcn_fmed3f(xl.y, -6.0f, 8.0f)};
                        const f32x2 te = a * (f32x2){-2.4554669595930157f, -2.4554669595930157f};
                        const f32x2 den = (f32x2){__builtin_amdgcn_exp2f(te.x), __builtin_amdgcn_exp2f(te.y)} + (f32x2){1.0f, 1.0f};
                        const f32x2 r = (f32x2){rcpf(den.x), rcpf(den.y)};
                        const f32x2 res = (a * r) * b1; o[4 * hh + j] = res.x; o[4 * hh + j + 1] = res.y; } }
                u32x2 w; w.x = pk4_fp8(o[0], o[1], o[2], o[3]); w.y = pk4_fp8(o[4], o[5], o[6], o[7]);
                *(u32x2*)(act + (size_t)slot * 1024 + u.pn * 128 + jj0) = w; }
    }
};
constexpr float YV_SCALE = 16.0f;
struct EpiDown { static constexpr int NB = 2; static constexpr bool PERM = true; unsigned char* yv; const bf16_t* bdn16;
    __device__ __forceinline__ void prefetch(const GUnit& u, f32x4 (&b)[4]) const {
        const int _t = opq((int)threadIdx.x), _w = __builtin_amdgcn_readfirstlane(_t >> 6), _l = _t & 63, wc = _w & 3, fq = _l >> 4;
        const float* bp = (const float*)(bdn16 + (((size_t)u.grp * 4 + u.pn) * 16 + wc * 4 + fq) * 16);
        pg8::gld128_asm(b[0], bp); pg8::gld128_asm(b[1], bp + 4); }
    __device__ __forceinline__ void operator()(const f32x4 (&acc)[2][2][4][2], const GUnit& u, int wr, int wc, int fr, int fq, const f32x4 (&pb)[4]) const {
        const int row0 = u.pm * 256 + wr * 64 + fr;
#pragma unroll
        for (int bj = 0; bj < 2; ++bj) { const int col = u.pn * 256 + bj * 128 + wc * 32 + 8 * fq;
            const u32x4 wb = __builtin_bit_cast(u32x4, pb[bj]);
            const f32x4 b0 = (f32x4){bf2f(wb.x & 0xffffu), bf2f(wb.x >> 16), bf2f(wb.y & 0xffffu), bf2f(wb.y >> 16)}, b1 = (f32x4){bf2f(wb.z & 0xffffu), bf2f(wb.z >> 16), bf2f(wb.w & 0xffffu), bf2f(wb.w >> 16)};
#pragma unroll
            for (int ai = 0; ai < 2; ++ai)
#pragma unroll
                for (int m = 0; m < 4; ++m) { const int slot = row0 + ai * 128 + m * 16;
                    const f32x4 v0 = (acc[ai][bj][m][0] * (1.0f / WDN_SCALE) + b0) * YV_SCALE, v1 = (acc[ai][bj][m][1] * (1.0f / WDN_SCALE) + b1) * YV_SCALE;
                    u32x2 w; w.x = pk4_fp8(v0[0], v0[1], v0[2], v0[3]); w.y = pk4_fp8(v1[0], v1[1], v1[2], v1[3]);
                    *(u32x2*)(yv + (size_t)slot * 1024 + col) = w; } }
    }
};

__device__ __forceinline__ bf16x8 frag_lds(const LAS unsigned char* base, int row, int pitch_bytes, int k0, int lane) {
    return *(const LAS bf16x8*)(base + (row + (lane & 15)) * pitch_bytes + (k0 + 8 * (lane >> 4)) * 2);
}
__device__ __forceinline__ bf16x8 frag_glb(const bf16_t* base, size_t row, int pitch_elems, int k0, int lane) {
    return *(const bf16x8*)(base + (row + (lane & 15)) * (size_t)pitch_elems + k0 + 8 * (lane >> 4));
}
#define MFMA16(x, y, acc) __builtin_amdgcn_mfma_f32_16x16x32_bf16((x), (y), (acc), 0, 0, 0)

__device__ __forceinline__ void tr_item(const float* W, int ldw, int k0, int n0, bf16_t* dst, int r0, int ldd, LAS float* scr, int lane) {
    float wv[32];
#pragma unroll
    for (int i = 0; i < 32; ++i) wv[i] = W[(size_t)(k0 + 2 * i + (lane >> 5)) * ldw + n0 + (lane & 31)];
#pragma unroll
    for (int i = 0; i < 32; ++i) scr[(2 * i + (lane >> 5)) * 33 + (lane & 31)] = wv[i];
    asm volatile("s_waitcnt lgkmcnt(0)" ::: "memory");
    const int c = lane & 7;
#pragma unroll
    for (int j = 0; j < 4; ++j) { const int n = (lane >> 3) + 8 * j; const LAS float* s = scr + (8 * c) * 33 + n;
        u32x4 o; o.x = pk2(s[0 * 33], s[1 * 33]); o.y = pk2(s[2 * 33], s[3 * 33]); o.z = pk2(s[4 * 33], s[5 * 33]); o.w = pk2(s[6 * 33], s[7 * 33]);
        *(u32x4*)(dst + (size_t)(r0 + n) * ldd + k0 + 8 * c) = o; }
    asm volatile("s_waitcnt lgkmcnt(0)" ::: "memory");
}

__device__ __forceinline__ void tr_item_fp8(const float* W, int ldw, int k0, int n0, unsigned char* dst, int r0, int ldd, float scale, LAS float* scr, int lane) {
    float wv[32];
#pragma unroll
    for (int i = 0; i < 32; ++i) wv[i] = W[(size_t)(k0 + 2 * i + (lane >> 5)) * ldw + n0 + (lane & 31)];
#pragma unroll
    for (int i = 0; i < 32; ++i) scr[(2 * i + (lane >> 5)) * 33 + (lane & 31)] = wv[i] * scale;
    asm volatile("s_waitcnt lgkmcnt(0)" ::: "memory");
#pragma unroll
    for (int j = 0; j < 2; ++j) { const int idx = lane + 64 * j, n = idx >> 2, c = idx & 3; const LAS float* s = scr + (16 * c) * 33 + n;
        u32x4 o; o.x = pk4_fp8(s[0 * 33], s[1 * 33], s[2 * 33], s[3 * 33]); o.y = pk4_fp8(s[4 * 33], s[5 * 33], s[6 * 33], s[7 * 33]);
        o.z = pk4_fp8(s[8 * 33], s[9 * 33], s[10 * 33], s[11 * 33]); o.w = pk4_fp8(s[12 * 33], s[13 * 33], s[14 * 33], s[15 * 33]);
        *(u32x4*)(dst + (size_t)(r0 + n) * ldd + k0 + 16 * c) = o; }
    asm volatile("s_waitcnt lgkmcnt(0)" ::: "memory");
}
__device__ __forceinline__ void tr_item_fp8_64n(const float* W, int ldw, int k0, int n0, unsigned char* dst, int r0, int ldd, float scale, LAS float* scr, int lane) {
    const int n4 = lane & 15, kq = lane >> 4;
    LAS unsigned* sw = (LAS unsigned*)scr;
    f32x4 wv[32];
#pragma unroll
    for (int j = 0; j < 32; ++j) wv[j] = *(const f32x4*)(W + (size_t)(k0 + 16 * (j >> 2) + 4 * kq + (j & 3)) * ldw + n0 + 4 * n4);
#pragma unroll
    for (int jj = 0; jj < 8; ++jj)
#pragma unroll
        for (int m = 0; m < 4; ++m) sw[(4 * n4 + m) * 33 + 4 * jj + kq] = pk4_fp8(wv[jj * 4 + 0][m] * scale, wv[jj * 4 + 1][m] * scale, wv[jj * 4 + 2][m] * scale, wv[jj * 4 + 3][m] * scale);
    asm volatile("s_waitcnt lgkmcnt(0)" ::: "memory");
#pragma unroll
    for (int j = 0; j < 8; ++j) { const int idx = lane + 64 * j, n = idx >> 3, c = idx & 7; const LAS unsigned* s = sw + n * 33 + 4 * c;
        *(u32x4*)(dst + (size_t)(r0 + n) * ldd + k0 + 16 * c) = (u32x4){s[0], s[1], s[2], s[3]}; }
    asm volatile("s_waitcnt lgkmcnt(0)" ::: "memory");
}
constexpr int CONV_PER_WG = 8, CONV_N = 12288, CONV_B_GO = 216 * CONV_PER_WG, CONV_B_GLU = CONV_B_GO + 32 * CONV_PER_WG + 32 * 2 * CONV_PER_WG, CONV_B_OUT = CONV_B_GLU + 124 * CONV_PER_WG, CONV_Q012 = CONV_B_OUT + 240 * CONV_PER_WG, CONV_Q3 = CONV_B_OUT;
constexpr int CONV_DN = 64 * CONV_PER_WG;
__host__ __device__ constexpr int conv_q(int l) { return (l < 3 ? CONV_Q012 : CONV_Q3) + (l > 0 ? CONV_DN : 0); }
__device__ __forceinline__ void conv_expert_item(CArgsP A, unsigned char* ws, int l, int idx, LAS float* scr, int lane) {
    if (idx < 8192) { const int e = idx >> 8, q = idx & 255, kb = q >> 5, nb = q & 31, n0 = 64 * nb, half = n0 >> 10, within = n0 & 1023, ct = within >> 7, jj0 = within & 127, le = l * 32 + e;
        tr_item_fp8_64n(GIN(A, 29) + (size_t)le * 1024 * 2048, 2048, 128 * kb, n0, (unsigned char*)(ws + WS_WUP) + (size_t)le * 2048 * 1024, 256 * ct + 128 * half + jj0, 1024, WUP_SCALE, scr, lane); }
    else { const int r = idx - 8192, e = r >> 7, q = r & 127, kb = q >> 4, nb = q & 15, le = l * 32 + e;
        tr_item_fp8_64n(GIN(A, 31) + (size_t)le * 1024 * 1024, 1024, 128 * kb, 64 * nb, (unsigned char*)(ws + WS_WDN) + (size_t)le * 1024 * 1024, 64 * nb, 1024, WDN_SCALE, scr, lane); }
}
__device__ __forceinline__ void conv_slot(const Frame& F0, CArgsP A, int l, int base, int j, int per = CONV_PER_WG) {
    Frame F = F0; F.tid = opq(F0.tid); F.lane = F.tid & 63; F.wave = __builtin_amdgcn_readfirstlane(F.tid >> 6); F.ws = opq_p(F0.ws); F.lds = opq_l(F0.lds);
    asm volatile("s_waitcnt vmcnt(0)" ::: "memory"); __syncthreads();
    LAS float* scr = (LAS float*)(F.lds + F.wave * 16896);
    for (int it = F.wave; it < per; it += NWAVES) { const int idx = base + j * per + it; if (idx < CONV_N) conv_expert_item(A, F.ws, l, idx, scr, F.lane); }
}
__device__ __forceinline__ void ph0_prologue(const Frame& F0, CArgsP A) {
    Frame F = F0; F.tid = opq(F0.tid); F.lane = F.tid & 63; F.wave = __builtin_amdgcn_readfirstlane(F.tid >> 6); F.ws = opq_p(F0.ws); F.bid = opq_s(F0.bid); F.G = opq_s(F0.G); F.lds = opq_l(F0.lds); F.CTLW = (volatile LAS unsigned*)(F.lds + LDSCTL_OFF);
    unsigned char* ws = F.ws;
    {
        LAS float* sc = (LAS float*)F.lds;
        LAS float* part = sc + 640;
        const float* cvec = GIN(A, 1); const float* cctx = GIN(A, 3); const float* wmod = GIN(A, 4);
        float* modp = (float*)(ws + WS_MODP);
        for (int u = F.bid; u < 768; u += F.G) {
            const int l = u / 192, r = u % 192, cb = r >> 3, ks = r & 7;
            const int col = cb * 256 + (F.tid & 255), kh = F.tid >> 8;
            const float* wp = wmod + ((size_t)l * 1024 + ks * 128 + kh * 64) * 6144 + col;
            float wk[64];
#pragma unroll
            for (int kk = 0; kk < 64; ++kk) wk[kk] = wp[(size_t)kk * 6144];
            for (int i = F.tid; i < 640; i += NTHR) { const int v = i >> 7, kk = i & 127; const float x = v < 4 ? cvec[v * 1024 + ks * 128 + kk] : cctx[ks * 128 + kk]; sc[i] = siluf_(x); }
            __syncthreads();
            float a0 = 0.f, a1 = 0.f, a2 = 0.f, a3 = 0.f, a4 = 0.f;
#pragma unroll
            for (int kk = 0; kk < 64; ++kk) { const float w = wk[kk]; const int sk = kh * 64 + kk;
                a0 += sc[sk] * w; a1 += sc[128 + sk] * w; a2 += sc[256 + sk] * w; a3 += sc[384 + sk] * w; a4 += sc[512 + sk] * w; }
            if (kh == 1) { const int c = F.tid & 255; part[c] = a0; part[256 + c] = a1; part[512 + c] = a2; part[768 + c] = a3; part[1024 + c] = a4; }
            __syncthreads();
            if (kh == 0) { const int c = F.tid & 255; float* o = modp + ((size_t)(ks * 4 + l) * 5) * 6144 + col;
                o[0] = a0 + part[c]; o[6144] = a1 + part[256 + c]; o[2 * 6144] = a2 + part[512 + c]; o[3 * 6144] = a3 + part[768 + c]; o[4 * 6144] = a4 + part[1024 + c]; }
            __syncthreads();
        }
    }
    {
        LAS float* scr = (LAS float*)(F.lds + F.wave * 16896);
        const int gw = F.bid * NWAVES + F.wave, NGW = F.G * NWAVES;
        constexpr int LE0 = CONV_N - conv_q(0), LE1 = CONV_N - conv_q(1), LE2 = CONV_N - conv_q(2), LE3 = CONV_N - conv_q(3);
        constexpr int I_IN = 4 * 16 * 73, I_OUT = 4 * 16 * 32, I_EXP = LE0 + LE1 + LE2 + LE3, I_GLU = 4 * 4 * 8;
        constexpr int NITEMS = I_IN + I_OUT + I_EXP + I_GLU;
        for (int it = gw; it < NITEMS; it += NGW) {
            int r = it;
            if (r < I_IN) { const int l = r / 1168, q = r % 1168, kb = q / 73, nb = q % 73, n0 = 32 * nb;
                const int r0 = nb < 64 ? n0 : (nb == 64 ? 2304 : 2048 + (n0 - 2080));
                tr_item(GIN(A, 6) + (size_t)l * 1024 * NIN, NIN, 64 * kb, n0, (bf16_t*)(ws + WS_WIN) + (size_t)l * NINP * 1024, r0, 1024, scr, F.lane); continue; }
            r -= I_IN;
            if (r < I_OUT) { const int l = r / 512, q = r % 512, kb = q / 32, nb = q % 32;
                tr_item(GIN(A, 24) + (size_t)l * 1024 * 1024, 1024, 64 * kb, 32 * nb, (bf16_t*)(ws + WS_WOUT) + (size_t)l * 1024 * 1024, 32 * nb, 1024, scr, F.lane); continue; }
            r -= I_OUT;
            if (r < I_EXP) { const int l = r < LE0 ? 0 : (r < LE0 + LE1 ? 1 : (r < LE0 + LE1 + LE2 ? 2 : 3)); const int idx = conv_q(l) + r - (l == 0 ? 0 : (l == 1 ? LE0 : (l == 2 ? LE0 + LE1 : LE0 + LE1 + LE2)));
                conv_expert_item(A, ws, l, idx, scr, F.lane); continue; }
            r -= I_EXP;
            { const int l = r / 32, q = r % 32, kb = q / 8, nb = q % 8;
                tr_item(GIN(A, 22) + (size_t)l * 256 * 256, 256, 64 * kb, 32 * nb, (bf16_t*)(ws + WS_GLUT) + (size_t)l * 256 * 256, 32 * nb, 256, scr, F.lane); }
        }
        const int gt = F.bid * NTHR + F.tid, NGT = F.G * NTHR;
        for (int i = gt; i < 4 * 224 * 128; i += NGT) { const int l = i / (224 * 128), q = i % (224 * 128);
            *(u32x4*)((bf16_t*)(ws + WS_WIN) + ((size_t)l * NINP + 2336) * 1024 + (size_t)q * 8) = (u32x4){0u, 0u, 0u, 0u}; }
        { const float* bu = GIN(A, 30); bf16_t* bo = (bf16_t*)(ws + WS_BUP);
            for (int i = gt; i < 4 * 32 * 2048; i += NGT) { const int le = i >> 11, r = i & 2047, ct = r >> 8, wc = (r >> 6) & 3, fq = (r >> 4) & 3, j = r & 15;
                const int col = (j < 8 ? 0 : 1024) + ct * 128 + wc * 32 + fq * 8 + (j & 7); bo[i] = (bf16_t)f2bf(bu[(size_t)le * 2048 + col]); } }
        { const float* bd = GIN(A, 32); bf16_t* bo = (bf16_t*)(ws + WS_BDN);
            for (int i = gt; i < 4 * 32 * 1024; i += NGT) { const int le = i >> 10, r = i & 1023, ct = r >> 8, wc = (r >> 6) & 3, fq = (r >> 4) & 3, j = r & 15;
                const int col = ct * 256 + (j >> 3) * 128 + wc * 32 + fq * 8 + (j & 7); bo[i] = (bf16_t)f2bf(bd[(size_t)le * 1024 + col]); } }
        { const float* rw = GIN(A, 27); float* wrt = (float*)(ws + WS_WRT);
            bf16_t* wh = (bf16_t*)(ws + WS_WRH); bf16_t* wl = (bf16_t*)(ws + WS_WRL);
            for (int i = gt; i < 4 * D * NEXP; i += NGT) { const int l = i >> 15, q = i & 32767, e = q >> 10, k = q & 1023; const float w = rw[(size_t)l * 32768 + k * 32 + e]; wrt[i] = w;
                const unsigned hb = f2bf(w); wh[i] = (bf16_t)hb; wl[i] = (bf16_t)f2bf(w - bf2f(hb)); } }
        const float* sw = GIN(A, 9); bf16_t* swo = (bf16_t*)(ws + WS_SGUW);
        for (int i = gt; i < 4 * 4 * 128 * 128 / 4; i += NGT) { const f32x4 v = *(const f32x4*)(sw + (size_t)i * 4); u32x2 o; o.x = pk2(v[0], v[1]); o.y = pk2(v[2], v[3]); *(u32x2*)(swo + (size_t)i * 4) = o; }
    }
    __syncthreads();
    {
        LAS f32x2* LP = (LAS f32x2*)F.lds;
        LAS f32x2* BB = LP + 2 * 65 * 64;
        LAS f32x2* CC = BB + 2 * 64 * 16;
        const float* lam_re = GIN(A, 14); const float* lam_im = GIN(A, 15); const float* log_dt = GIN(A, 16);
        const float* b_re = GIN(A, 17); const float* b_im = GIN(A, 18); const float* c_re = GIN(A, 19); const float* c_im = GIN(A, 20);
        for (int uq = F.bid; uq < 256; uq += F.G) {
            const int u = uq >> 2, qd = uq & 3, l = u >> 4, g = u & 15;
            LAS f32x2* QQ = CC + 2 * 16 * 64;
            if (F.tid < 256) { const int z = (F.tid >> 6) & 1, p = F.tid & 63;
                const int idx = ((l * 2 + z) * 16 + g) * 64 + p; const double dt = exp((double)log_dt[(l * 2 + z) * 16 + g]);
                const double lr = lam_re[idx], li = lam_im[idx]; const double mag = exp(lr * dt), ang = li * dt; double sn, cs; sincos(ang, &sn, &cs);
                const double wr = mag * cs, wi = mag * sn;
                if (F.tid < 128) {
                    double ar = 1.0, ai = 0.0;
                    for (int n = 0; n < 65; ++n) { LP[(z * 65 + n) * 64 + p] = (f32x2){(float)ar, (float)ai};
                        if (n == 64 && qd == 0) *(f32x2*)((float*)(ws + WS_LB64) + (size_t)idx * 2) = (f32x2){(float)ar, (float)ai};
                        const double nr2 = ar * wr - ai * wi; ai = ar * wi + ai * wr; ar = nr2; }
                } else { const double nr = wr - 1.0, ni = wi, den = lr * lr + li * li;
                    QQ[z * 64 + p] = (f32x2){(float)((nr * lr + ni * li) / den), (float)((ni * lr - nr * li) / den)}; } }
            __syncthreads();
            for (int i = F.tid; i < 2 * 64 * 16; i += NTHR) { const int z = i >> 10, p = (i >> 4) & 63, h = i & 15;
                const int idx = ((l * 2 + z) * 16 + g) * 64 + p; const f32x2 q = QQ[z * 64 + p];
                const float br = b_re[(size_t)idx * 16 + h], bi = b_im[(size_t)idx * 16 + h];
                BB[i] = (f32x2){q.x * br - q.y * bi, q.x * bi + q.y * br}; }
            for (int i = F.tid; i < 2 * 16 * 64; i += NTHR) { const int z = i >> 10, h = (i >> 6) & 15, p = i & 63;
                const size_t idx = ((size_t)((l * 2 + z) * 16 + g) * 16 + h) * 64 + p; CC[i] = (f32x2){c_re[idx], c_im[idx]}; }
            __syncthreads();
            float* KT = (float*)(ws + WS_KTAB) + (size_t)u * 32768;
            {
                const int h = (F.tid >> 4) & 15, h2 = F.tid & 15, t0 = qd * 16 + (F.tid >> 8);
                for (int zz = 0; zz < 2; ++zz) { float acc8[8];
#pragma unroll
                    for (int jj = 0; jj < 8; ++jj) acc8[jj] = 0.f;
                    for (int p = 0; p < 64; ++p) { const f32x2 c = CC[(zz * 16 + h) * 64 + p], b = BB[(zz * 64 + p) * 16 + h2]; const float cbr = c.x * b.x - c.y * b.y, cbi = c.x * b.y + c.y * b.x;
#pragma unroll
                        for (int jj = 0; jj < 8; ++jj) { const f32x2 w = LP[(zz * 65 + t0 + 2 * jj) * 64 + p]; acc8[jj] += cbr * w.x - cbi * w.y; } }
#pragma unroll
                    for (int jj = 0; jj < 8; ++jj) KT[((zz * 64 + t0 + 2 * jj) * 16 + h) * 16 + h2] = acc8[jj]; } }
            bf16_t* Mo = (bf16_t*)(ws + WS_S5M) + (size_t)u * 1024 * S5K;
            for (int it = F.tid; it < 256 * 32; it += NTHR) { const int row = qd * 256 + (it >> 5), cv = 128 + (it & 31), t = row >> 4, h = row & 15; float v[8];
                const int idx0 = (cv - 128) * 8, z = idx0 >> 7, p0 = (idx0 & 127) >> 1, n = z == 0 ? t + 1 : 64 - t;
#pragma unroll
                for (int i = 0; i < 8; ++i) { const int p = p0 + (i >> 1); const f32x2 c = CC[(z * 16 + h) * 64 + p], w = LP[(z * 65 + n) * 64 + p];
                    v[i] = (i & 1) ? -(c.x * w.y + c.y * w.x) : (c.x * w.x - c.y * w.y); }
                u32x4 o; o.x = pk2(v[0], v[1]); o.y = pk2(v[2], v[3]); o.z = pk2(v[4], v[5]); o.w = pk2(v[6], v[7]);
                *(u32x4*)(Mo + (size_t)row * S5K + cv * 8) = o; }
            bf16_t* Fo = (bf16_t*)(ws + WS_S5F) + (size_t)u * 256 * 1024;
            for (int it = F.tid; it < 64 * 128; it += NTHR) { const int r = qd * 64 + (it >> 7), cv = it & 127, z = r >> 7, p = (r & 127) >> 1, ri = r & 1, s = cv >> 1, h0 = (cv & 1) * 8, m = z == 0 ? 63 - s : s;
                const f32x2 w = LP[(z * 65 + m) * 64 + p]; float v[8];
#pragma unroll
                for (int i = 0; i < 8; ++i) { const f32x2 b = BB[(z * 64 + p) * 16 + h0 + i]; v[i] = ri ? (w.x * b.y + w.y * b.x) : (w.x * b.x - w.y * b.y); }
                u32x4 o; o.x = pk2(v[0], v[1]); o.y = pk2(v[2], v[3]); o.z = pk2(v[4], v[5]); o.w = pk2(v[6], v[7]);
                *(u32x4*)(Fo + (size_t)r * 1024 + cv * 8) = o; }
            __syncthreads();
        }
    }
}

__device__ __forceinline__ void ph1_mod(const Frame& F0, CArgsP A) {
    Frame F = F0; F.tid = opq(F0.tid); F.lane = F.tid & 63; F.wave = __builtin_amdgcn_readfirstlane(F.tid >> 6); F.ws = opq_p(F0.ws); F.bid = opq_s(F0.bid); F.G = opq_s(F0.G); F.lds = opq_l(F0.lds); F.CTLW = (volatile LAS unsigned*)(F.lds + LDSCTL_OFF);
    const float* modp = (const float*)(F.ws + WS_MODP); float* mod = (float*)(F.ws + WS_MOD); const float* bmod = GIN(A, 5);
    for (int i = F.bid * NTHR + F.tid; i < 4 * 5 * 6144; i += F.G * NTHR) { const int l = i / 30720, j = i % 6144; float s = bmod[l * 6144 + j];
#pragma unroll
        for (int ks = 0; ks < 8; ++ks) s += modp[(size_t)ks * 122880 + i];
        mod[i] = s; }
    const float* dsk = GIN(A, 21);
    for (int it = F.bid * NTHR + F.tid; it < 64 * 1024 * 128; it += F.G * NTHR) { const int u = it >> 17, r = it & 131071, row = r >> 7, cv = r & 127, t = row >> 4, h = row & 15, s = cv >> 1, h0 = (cv & 1) * 8;
        const float* KT = (const float*)(F.ws + WS_KTAB) + (size_t)u * 32768; float v[8];
        if (s < t) { const f32x4 a = *(const f32x4*)(KT + ((0 * 64 + (t - s)) * 16 + h) * 16 + h0), b = *(const f32x4*)(KT + ((0 * 64 + (t - s)) * 16 + h) * 16 + h0 + 4);
            v[0] = a[0]; v[1] = a[1]; v[2] = a[2]; v[3] = a[3]; v[4] = b[0]; v[5] = b[1]; v[6] = b[2]; v[7] = b[3]; }
        else if (s > t) { const f32x4 a = *(const f32x4*)(KT + ((1 * 64 + (s - t)) * 16 + h) * 16 + h0), b = *(const f32x4*)(KT + ((1 * 64 + (s - t)) * 16 + h) * 16 + h0 + 4);
            v[0] = a[0]; v[1] = a[1]; v[2] = a[2]; v[3] = a[3]; v[4] = b[0]; v[5] = b[1]; v[6] = b[2]; v[7] = b[3]; }
        else { const float* k0 = KT + ((0 * 64 + 0) * 16 + h) * 16 + h0; const float* k1 = KT + ((1 * 64 + 0) * 16 + h) * 16 + h0; const float dd = dsk[u * 16 + h];
#pragma unroll
            for (int i = 0; i < 8; ++i) v[i] = k0[i] + k1[i] + ((h0 + i == h) ? dd : 0.f); }
        u32x4 o; o.x = pk2(v[0], v[1]); o.y = pk2(v[2], v[3]); o.z = pk2(v[4], v[5]); o.w = pk2(v[6], v[7]);
        *(u32x4*)((bf16_t*)(F.ws + WS_S5M) + ((size_t)u * 1024 + row) * S5K + cv * 8) = o; }
}
__device__ __forceinline__ void ph2_init(const Frame& F0, CArgsP A) {
    Frame F = F0; F.tid = opq(F0.tid); F.lane = F.tid & 63; F.wave = __builtin_amdgcn_readfirstlane(F.tid >> 6); F.ws = opq_p(F0.ws); F.bid = opq_s(F0.bid); F.G = opq_s(F0.G); F.lds = opq_l(F0.lds); F.CTLW = (volatile LAS unsigned*)(F.lds + LDSCTL_OFF);
    const float* mod = (const float*)(F.ws + WS_MOD); bf16_t* X = (bf16_t*)(F.ws + WS_X); bf16_t* H = (bf16_t*)(F.ws + WS_H);
    const int stride = F.G * NWAVES;
    for (int tk = F.bid * NWAVES + F.wave; tk < T; tk += 2 * stride) {
        const int tk2 = tk + stride < T ? tk + stride : tk; const bool two = tk + stride < T;
        const float* src0 = tk < TLAT ? GIN(A, 0) + (size_t)tk * D : GIN(A, 2) + (size_t)(tk - TLAT) * D;
        const float* src1 = tk2 < TLAT ? GIN(A, 0) + (size_t)tk2 * D : GIN(A, 2) + (size_t)(tk2 - TLAT) * D;
        const float* mv0 = mod + (size_t)tok_vec(tk) * 6144; const float* mv1 = mod + (size_t)tok_vec(tk2) * 6144;
        f32x4 x0[4], x1[4];
#pragma unroll
        for (int j = 0; j < 4; ++j) { const int c = 4 * F.lane + 256 * j; x0[j] = *(const f32x4*)(src0 + c); x1[j] = *(const f32x4*)(src1 + c); }
#pragma unroll
        for (int j = 0; j < 4; ++j) { const int c = 4 * F.lane + 256 * j; const f32x4 x = x0[j], sh = *(const f32x4*)(mv0 + c), sc = *(const f32x4*)(mv0 + 1024 + c);
            *(u32x2*)(X + (size_t)tk * D + c) = pk4(x); const f32x4 h = x * (sc + 1.0f) + sh;
            u32x2 o; o.x = pk2(h[0], h[1]); o.y = pk2(h[2], h[3]); *(u32x2*)(H + (size_t)tk * D + c) = o; }
        if (two) {
#pragma unroll
            for (int j = 0; j < 4; ++j) { const int c = 4 * F.lane + 256 * j; const f32x4 x = x1[j], sh = *(const f32x4*)(mv1 + c), sc = *(const f32x4*)(mv1 + 1024 + c);
                *(u32x2*)(X + (size_t)tk2 * D + c) = pk4(x); const f32x4 h = x * (sc + 1.0f) + sh;
                u32x2 o; o.x = pk2(h[0], h[1]); o.y = pk2(h[2], h[3]); *(u32x2*)(H + (size_t)tk2 * D + c) = o; } }
    }
}

template <int Z> __device__ __forceinline__ void gla_cols(const LAS float* GLs, const LAS unsigned char* Qs, const LAS unsigned char* Ks, LAS unsigned char* KTrow, const float (&gu)[16], float gb,
                                                          bf16_t* QHp, bf16_t* KNp, float& tot) {
    float b = 0.f;
    const LAS float* gl0 = GLs + Z * 16;
    const int tf = Z ? 63 : 0;
    f32x4 g0 = *(const LAS f32x4*)(gl0 + tf * 32), g1 = *(const LAS f32x4*)(gl0 + tf * 32 + 4), g2 = *(const LAS f32x4*)(gl0 + tf * 32 + 8), g3 = *(const LAS f32x4*)(gl0 + tf * 32 + 12);
    unsigned qw = *(const LAS unsigned short*)(Qs + tf * 528), kw = *(const LAS unsigned short*)(Ks + tf * 528);
    for (int j = 0; j < 8; ++j) { const int tg = Z ? 7 - j : j; unsigned w[4] = {0u, 0u, 0u, 0u};
#pragma unroll
        for (int tt = 0; tt < 8; ++tt) { const int ti = Z ? 7 - tt : tt, t = tg * 8 + ti;
            const int tn = Z ? t - 1 : t + 1;
            const f32x4 n0 = *(const LAS f32x4*)(gl0 + tn * 32), n1 = *(const LAS f32x4*)(gl0 + tn * 32 + 4), n2 = *(const LAS f32x4*)(gl0 + tn * 32 + 8), n3 = *(const LAS f32x4*)(gl0 + tn * 32 + 12);
            const unsigned qn = *(const LAS unsigned short*)(Qs + tn * 528), kn2 = *(const LAS unsigned short*)(Ks + tn * 528);
            f32x2 pa = (f32x2){gb, 0.0f}, pb = (f32x2){0.0f, 0.0f};
            pa = __builtin_elementwise_fma((f32x2){g0[0], g0[1]}, (f32x2){gu[0], gu[1]}, pa); pb = __builtin_elementwise_fma((f32x2){g0[2], g0[3]}, (f32x2){gu[2], gu[3]}, pb);
            pa = __builtin_elementwise_fma((f32x2){g1[0], g1[1]}, (f32x2){gu[4], gu[5]}, pa); pb = __builtin_elementwise_fma((f32x2){g1[2], g1[3]}, (f32x2){gu[6], gu[7]}, pb);
            pa = __builtin_elementwise_fma((f32x2){g2[0], g2[1]}, (f32x2){gu[8], gu[9]}, pa); pb = __builtin_elementwise_fma((f32x2){g2[2], g2[3]}, (f32x2){gu[10], gu[11]}, pb);
            pa = __builtin_elementwise_fma((f32x2){g3[0], g3[1]}, (f32x2){gu[12], gu[13]}, pa); pb = __builtin_elementwise_fma((f32x2){g3[2], g3[3]}, (f32x2){gu[14], gu[15]}, pb);
            const f32x2 pc = pa + pb; const float s2 = pc.x + pc.y;
            const float ls2 = fminf(s2, 0.0f) - __builtin_amdgcn_logf(1.0f + __builtin_amdgcn_exp2f(-fabsf(s2)));
            b += ls2 * (1.0f / 16.0f);
            const float e = __builtin_amdgcn_exp2f(b), ri = rcpf(e);
            const float qv = bf2f(qw) * 0.125f, kv = bf2f(kw);
            const unsigned qk = cvt_pk_bf16(qv * e, kv * ri);
            QHp[(size_t)t * 512] = (bf16_t)(qk & 0xffffu); KNp[(size_t)t * 256] = (bf16_t)(qk >> 16);
            w[ti >> 1] |= (ti & 1) ? (qk & 0xffff0000u) : (qk >> 16);
            g0 = n0; g1 = n1; g2 = n2; g3 = n3; qw = qn; kw = kn2; asm volatile("" ::: "memory"); }
        *(LAS u32x4*)(KTrow + tg * 16) = (u32x4){w[0], w[1], w[2], w[3]}; }
    tot = b;
}
__device__ __forceinline__ void gla_local(const Frame& F0, CArgsP A, int l) {
    Frame F = F0; F.tid = opq(F0.tid); F.lane = F.tid & 63; F.wave = __builtin_amdgcn_readfirstlane(F.tid >> 6); F.ws = opq_p(F0.ws); F.bid = opq_s(F0.bid); F.G = opq_s(F0.G); F.lds = opq_l(F0.lds); F.CTLW = (volatile LAS unsigned*)(F.lds + LDSCTL_OFF);
    unsigned char* ws = F.ws;
    LAS float* GLs = (LAS float*)(F.lds + 128);
    LAS unsigned char* KTl = F.lds + 8192 + 256;
    LAS unsigned char* Qs = F.lds + 81920 + 1024;
    LAS unsigned char* Ks = Qs + 64 * 528;
    LAS float* DEC = (LAS float*)(Ks + 64 * 528);
    const int z = F.tid >> 8, col = F.tid & 255, hh = col >> 6, dd = col & 63;
#define GLA_STAGE_LD(chx) { const int tkx = (chx) * 64; const unsigned char* wsx = opq_p(ws); const bf16_t* projx = (const bf16_t*)(wsx + WS_PROJ); \
        glv = *(const f32x4*)((const float*)(wsx + WS_GL) + (size_t)tkx * 32 + 4 * F.tid); \
        _Pragma("unroll") for (int i = 0; i < 4; ++i) { const int idx = F.tid + NTHR * i, row = idx >> 5, c16 = idx & 31; \
            qv4[i] = *(const u32x4*)(projx + (size_t)(tkx + row) * PROJW + 512 + c16 * 8); kv4[i] = *(const u32x4*)(projx + (size_t)(tkx + row) * PROJW + 768 + c16 * 8); } }
#define GLA_STAGE_ST() { *(LAS f32x4*)(GLs + 4 * F.tid) = glv; \
        _Pragma("unroll") for (int i = 0; i < 4; ++i) { const int idx = F.tid + NTHR * i, row = idx >> 5, c16 = idx & 31; \
            *(LAS u32x4*)(Qs + row * 528 + c16 * 16) = qv4[i]; *(LAS u32x4*)(Ks + row * 528 + c16 * 16) = kv4[i]; } }
    f32x4 glv; u32x4 qv4[4], kv4[4];
    if (F.bid < NCH) { GLA_STAGE_LD(F.bid) GLA_STAGE_ST() }
    for (int ch = F.bid; ch < NCH; ch += F.G) {
        unsigned char* wsl = opq_p(ws);
        const bf16_t* proj = (const bf16_t*)(wsl + WS_PROJ); const float* gl = (const float*)(wsl + WS_GL);
        bf16_t* KN = (bf16_t*)(wsl + WS_KS); bf16_t* QH = (bf16_t*)(wsl + WS_QH); const bf16_t* VTg = (const bf16_t*)(wsl + WS_VT);
        bf16_t* glast = (bf16_t*)(wsl + WS_GLAST); float* gdec = (float*)(wsl + WS_GDEC);
        const int tk0 = ch * 64;
        bf16x8 yfp[2][2][4];
#pragma unroll
        for (int ks = 0; ks < 2; ++ks)
#pragma unroll
            for (int b = 0; b < 4; ++b) yfp[0][ks][b] = frag_glb(VTg, ((size_t)ch * 4 + (F.wave >> 1)) * 128 + b * 16, 64, ks * 32, F.lane);
        float gu[16];
        {   CArgsP Ax = argp();
#pragma unroll
            for (int r = 0; r < 16; ++r) gu[r] = GIN(Ax, 11)[(((size_t)l * 2 + z) * 16 + r) * 256 + col] * 1.4426950408889634f;
        }
        const float gb = GIN(argp(), 12)[((size_t)l * 2 + z) * 256 + col] * 1.4426950408889634f;
        __syncthreads();
        float tot;
        bf16_t* QHp = QH + ((size_t)tk0 * 4 + hh) * 128 + z * 64 + dd; bf16_t* KNp = KN + ((size_t)z * T + tk0) * 256 + col;
        if (z == 0) gla_cols<0>(GLs, Qs + col * 2, Ks + col * 2, KTl + (0 * 256 + col) * 144, gu, gb, QHp, KNp, tot);
        else        gla_cols<1>(GLs, Qs + col * 2, Ks + col * 2, KTl + (1 * 256 + col) * 144, gu, gb, QHp, KNp, tot);
#pragma unroll
        for (int ks = 0; ks < 2; ++ks)
#pragma unroll
            for (int b = 0; b < 4; ++b) yfp[1][ks][b] = frag_glb(VTg, ((size_t)ch * 4 + (F.wave >> 1)) * 128 + 64 + b * 16, 64, ks * 32, F.lane);
        const float dec = __builtin_amdgcn_exp2f(tot);
        DEC[z * 256 + col] = dec; gdec[((size_t)ch * 2 + z) * 256 + col] = dec;
        __syncthreads();
        const bool more = ch + F.G < NCH;
        {
            const int wz = F.wave & 1, wh = F.wave >> 1, q = F.lane >> 4, c = F.lane & 15;
#pragma unroll
            for (int eh = 0; eh < 2; ++eh) {
                if (eh == 1) { asm volatile("" ::: "memory"); if (more) GLA_STAGE_LD(ch + F.G) }
                f32x4 acc[4][4];
#pragma unroll
                for (int a = 0; a < 4; ++a)
#pragma unroll
                    for (int b = 0; b < 4; ++b) acc[a][b] = (f32x4){0.f, 0.f, 0.f, 0.f};
#pragma unroll
                for (int ks = 0; ks < 2; ++ks) { bf16x8 xf[4];
#pragma unroll
                    for (int a = 0; a < 4; ++a) xf[a] = frag_lds(KTl, wz * 256 + wh * 64 + a * 16, 144, ks * 32, F.lane);
#pragma unroll
                    for (int a = 0; a < 4; ++a)
#pragma unroll
                        for (int b = 0; b < 4; ++b) acc[a][b] = MFMA16(xf[a], yfp[eh][ks][b], acc[a][b]); }
#pragma unroll
                for (int a = 0; a < 4; ++a) { const int d0 = a * 16 + 4 * q; const f32x4 dv = *(const LAS f32x4*)(DEC + wz * 256 + wh * 64 + d0);
#pragma unroll
                    for (int b = 0; b < 4; ++b) { const int e = eh * 64 + b * 16 + c;
                        *(u32x2*)(glast + (((size_t)ch * 4 + wh) * 128 + e) * 128 + wz * 64 + d0) = pk4(acc[a][b] * dv); } }
            }
        }
        if (more) GLA_STAGE_ST()
    }
#undef GLA_STAGE_LD
#undef GLA_STAGE_ST
}

__device__ __forceinline__ void sgu_phase(const Frame& F0, CArgsP A, int l) {
    Frame F = F0; F.tid = opq(F0.tid); F.lane = F.tid & 63; F.wave = __builtin_amdgcn_readfirstlane(F.tid >> 6); F.ws = opq_p(F0.ws); F.bid = opq_s(F0.bid); F.G = opq_s(F0.G); F.lds = opq_l(F0.lds); F.CTLW = (volatile LAS unsigned*)(F.lds + LDSCTL_OFF);
    unsigned char* ws = F.ws;
    const bf16_t* proj = (const bf16_t*)(ws + WS_PROJ); bf16_t* mixed = (bf16_t*)(ws + WS_MIXED); const bf16_t* sw = (const bf16_t*)(ws + WS_SGUW) + (size_t)l * 4 * 128 * 128;
    LAS unsigned char* VL = F.lds;
    const float* lng = GIN(A, 7) + l * 256; const float* lnb = GIN(A, 8) + l * 256; const float* bs = GIN(A, 10) + (size_t)l * 4 * 128;
    const float* stat = (const float*)(ws + WS_STAT);
    int u0, un; { const int b = F.bid; if (b < 16 || (b >= 128 && b < 176)) { u0 = 0; un = 0; } else { const int ci = b < 128 ? b - 16 : b - 176 + 112; if (ci < 96) { u0 = 6 * ci; un = 6; } else { u0 = 576 + 5 * (ci - 96); un = 5; } } }
    for (int uu = u0; uu < u0 + un; ++uu) {
        const int tk0 = (uu >> 2) * 128, h = uu & 3;
        const int ct = F.wave & 3, th = F.wave >> 2, q = F.lane >> 4, c = F.lane & 15;
        bf16x8 yfs[4][4]; u32x2 uws[4]; float bias4[4]; unsigned short tv[16];
#pragma unroll
        for (int i = 0; i < 16; ++i) { const int s = F.wave * 16 + i; tv[i] = proj[(size_t)(tk0 + s) * PROJW + 256 + h * 64 + (F.tid & 63)]; }
#pragma unroll
        for (int ks = 0; ks < 4; ++ks)
#pragma unroll
            for (int b = 0; b < 4; ++b) yfs[ks][b] = frag_glb(sw + (size_t)h * 128 * 128, th * 64 + b * 16, 128, ks * 32, F.lane);
#pragma unroll
        for (int b = 0; b < 4; ++b) { const int t = th * 64 + b * 16 + c; bias4[b] = bs[h * 128 + t]; uws[b] = *(const u32x2*)(proj + (size_t)(tk0 + t) * PROJW + h * 64 + ct * 16 + 4 * q); }
        asm volatile("" ::: "memory");
        int mean_l, rstd_l;
        {   const int s = F.wave * 16 + (F.lane & 15); const f32x4 pa = *(const f32x4*)(stat + (size_t)(tk0 + s) * 8), pb2 = *(const f32x4*)(stat + (size_t)(tk0 + s) * 8 + 4);
            asm volatile("" ::: "memory");
            const float sm = (pa[0] + pa[2]) + (pb2[0] + pb2[2]), sq = (pa[1] + pa[3]) + (pb2[1] + pb2[3]);
            const float mean = sm * (1.0f / 256.0f), rstd = rsqrtf(fmaxf(sq * (1.0f / 256.0f) - mean * mean, 0.0f) + LN_EPS);
            mean_l = __float_as_int(mean); rstd_l = __float_as_int(rstd); }
        {   const int chn = F.tid & 63, sq = F.wave; const float g = lng[h * 64 + chn], b = lnb[h * 64 + chn];
#pragma unroll
            for (int j = 0; j < 2; ++j) { unsigned w[4]; float vv[8];
#pragma unroll
                for (int tt = 0; tt < 8; ++tt) { const float mean = __int_as_float(__builtin_amdgcn_readlane(mean_l, j * 8 + tt)), rstd = __int_as_float(__builtin_amdgcn_readlane(rstd_l, j * 8 + tt));
                    vv[tt] = (bf2f(tv[j * 8 + tt]) - mean) * rstd * g + b; }
#pragma unroll
                for (int i = 0; i < 4; ++i) w[i] = pk2(vv[2 * i], vv[2 * i + 1]);
                *(LAS u32x4*)(VL + chn * 272 + sq * 32 + j * 16) = (u32x4){w[0], w[1], w[2], w[3]}; }
        }
        __syncthreads();
        {   f32x4 acc[4];
#pragma unroll
            for (int b = 0; b < 4; ++b) acc[b] = (f32x4){0.f, 0.f, 0.f, 0.f};
#pragma unroll
            for (int ks = 0; ks < 4; ++ks) { const bf16x8 xf = frag_lds(VL, ct * 16, 272, ks * 32, F.lane);
#pragma unroll
                for (int b = 0; b < 4; ++b) acc[b] = MFMA16(xf, yfs[ks][b], acc[b]); }
#pragma unroll
            for (int b = 0; b < 4; ++b) { const int t = th * 64 + b * 16 + c; const float bias = bias4[b];
                const int ch0 = h * 64 + ct * 16 + 4 * q; const u32x2 uw = uws[b];
                u32x2 o; o.x = pk2(bf2f(uw.x & 0xffffu) * (acc[b][0] + bias), bf2f(uw.x >> 16) * (acc[b][1] + bias));
                o.y = pk2(bf2f(uw.y & 0xffffu) * (acc[b][2] + bias), bf2f(uw.y >> 16) * (acc[b][3] + bias));
                *(u32x2*)(mixed + (size_t)(tk0 + t) * 1024 + ch0) = o; }
        }
        __syncthreads();
    }
}

__device__ __forceinline__ int scan_chunk(int z, int b, int st) {
    return z == 0 ? (st < 4 ? 512 + b * 4 + st : b * 128 + (st - 4)) : (st < 4 ? 512 + b * 4 + (3 - st) : b * 128 + (131 - st));
}
__device__ __forceinline__ void scan_phase(const Frame& F0, CArgsP A, int l) {
    Frame F = F0; F.tid = opq(F0.tid); F.lane = F.tid & 63; F.wave = __builtin_amdgcn_readfirstlane(F.tid >> 6); F.ws = opq_p(F0.ws); F.bid = opq_s(F0.bid); F.G = opq_s(F0.G); F.lds = opq_l(F0.lds); F.CTLW = (volatile LAS unsigned*)(F.lds + LDSCTL_OFF);
    unsigned char* ws = F.ws;
    const bf16_t* glast = (const bf16_t*)(ws + WS_GLAST); const float* gdec = (const float*)(ws + WS_GDEC); bf16_t* sprev = (bf16_t*)(ws + WS_SPREV);
    const float* hloc = (const float*)(ws + WS_HLOC); bf16_t* ucat = (bf16_t*)(ws + WS_UCAT); const float* lb64 = (const float*)(ws + WS_LB64);
    if (F.bid < 128 && F.wave == 7) { const int p = F.lane, z = F.bid & 1, b = (F.bid >> 1) & 3, g = F.bid >> 3;
        const f32x2 lb = *(const f32x2*)(lb64 + ((size_t)((l * 2 + z) * 16 + g) * 64 + p) * 2);
        float hr = 0.f, hi = 0.f;
        for (int sb = 0; sb < 132; sb += 44) { f32x2 hl[44];
#pragma unroll
            for (int j = 0; j < 44; ++j) { const int ch = scan_chunk(z, b, sb + j); hl[j] = *(const f32x2*)(hloc + ((size_t)g * NCHP + ch) * 256 + z * 128 + p * 2); }
#pragma unroll
            for (int j = 0; j < 44; ++j) { const int ch = scan_chunk(z, b, sb + j);
                *(unsigned*)(ucat + ((size_t)g * NCHP + ch) * S5K + 1024 + z * 128 + p * 2) = pk2(hr, hi);
                const float nr = lb.x * hr - lb.y * hi + hl[j].x, ni = lb.x * hi + lb.y * hr + hl[j].y; hr = nr; hi = ni; }
        }
    }
    {   const int idx = F.bid * NTHR + F.tid;
        const int b = idx >> 15, rem = (idx & 32767) * 2, h = rem >> 14, dcat = rem & 127, z = dcat >> 6, d = dcat & 63;
        const bf16_t* gsrc = glast + rem; bf16_t* gdst = sprev + rem; const float* dsrc = gdec + z * 256 + h * 64 + d;
        float S0 = 0.f, S1 = 0.f;
        unsigned dsA[22], dsB[22]; f32x2 dcA[22], dcB[22];
#define SCAN_LOAD(DS_, DC_, sb_) { _Pragma("unroll") for (int j = 0; j < 22; ++j) { const int c = scan_chunk(z, b, (sb_) + j); DS_[j] = *(const unsigned*)(gsrc + (size_t)c * 65536); DC_[j] = *(const f32x2*)(dsrc + (size_t)c * 512); } }
#define SCAN_STEP(DS_, DC_, sb_) { _Pragma("unroll") for (int j = 0; j < 22; ++j) { const int c = scan_chunk(z, b, (sb_) + j); *(unsigned*)(gdst + (size_t)c * 65536) = pk2(S0, S1); \
            S0 = DC_[j].x * S0 + bf2f(DS_[j] & 0xffffu); S1 = DC_[j].y * S1 + bf2f(DS_[j] >> 16); } }
        SCAN_LOAD(dsA, dcA, 0)
        for (int sb = 0; sb < 132; sb += 44) {
            SCAN_LOAD(dsB, dcB, sb + 22)
            SCAN_STEP(dsA, dcA, sb)
            if (sb + 44 < 132) SCAN_LOAD(dsA, dcA, sb + 44)
            SCAN_STEP(dsB, dcB, sb + 22)
        }
#undef SCAN_LOAD
#undef SCAN_STEP
    }
}

__device__ __forceinline__ void gla_out(const Frame& F0, CArgsP A, int l) {
    Frame F = F0; F.tid = opq(F0.tid); F.lane = F.tid & 63; F.wave = __builtin_amdgcn_readfirstlane(F.tid >> 6); F.ws = opq_p(F0.ws); F.bid = opq_s(F0.bid); F.G = opq_s(F0.G); F.lds = opq_l(F0.lds); F.CTLW = (volatile LAS unsigned*)(F.lds + LDSCTL_OFF);
    unsigned char* ws = F.ws;
    const bf16_t* proj = (const bf16_t*)(ws + WS_PROJ); bf16_t* mixed = (bf16_t*)(ws + WS_MIXED);
    const bf16_t* KN = (const bf16_t*)(ws + WS_KS); const bf16_t* QH = (const bf16_t*)(ws + WS_QH);
    const bf16_t* VTg = (const bf16_t*)(ws + WS_VT); const bf16_t* sprev = (const bf16_t*)(ws + WS_SPREV);
    const float* ng = GIN(A, 13) + (size_t)l * 512;
    LAS unsigned char* VT2 = F.lds;
    LAS unsigned char* SP2 = F.lds + 256 * 144;
    LAS unsigned char* Pw = F.lds + 256 * 144 + 256 * 272 + F.wave * 2304;
    const int q = F.lane >> 4, c = F.lane & 15, sub = F.wave >> 2, tm = F.wave & 3;
    const int nun = (l == DEPTH - 1) ? 1024 : NCH * 2;
    for (int uu = (F.bid + 64) & 255; uu < nun; uu += F.G) {
        const int ch = uu >> 1, hp = uu & 1, h = hp * 2 + sub, tk0 = ch * 64, tok = tk0 + tm * 16 + c;
        u32x4 sv[4], sp[8];
        const size_t erow0 = ((size_t)ch * 4 + hp * 2) * 128;
#pragma unroll
        for (int j = 0; j < 4; ++j) { const int idx = F.tid + NTHR * j; sv[j] = *(const u32x4*)(VTg + (erow0 + (idx >> 3)) * 64 + (idx & 7) * 8); }
#pragma unroll
        for (int j = 0; j < 8; ++j) { const int idx = F.tid + NTHR * j; sp[j] = *(const u32x4*)(sprev + (erow0 + (idx >> 4)) * 128 + (idx & 15) * 8); }
        bf16x8 qh[4], kf[4][2], kb[4][2];
#pragma unroll
        for (int j = 0; j < 4; ++j) qh[j] = frag_glb(QH + h * 128, (size_t)tk0 + tm * 16, 512, j * 32, F.lane);
#pragma unroll
        for (int st = 0; st < 4; ++st)
#pragma unroll
            for (int ks = 0; ks < 2; ++ks) { kf[st][ks] = frag_glb(KN + h * 64, (size_t)tk0 + st * 16, 256, ks * 32, F.lane); kb[st][ks] = frag_glb(KN + h * 64, (size_t)T + tk0 + st * 16, 256, ks * 32, F.lane); }
        u32x2 gw[8];
#pragma unroll
        for (int a = 0; a < 8; ++a) gw[a] = *(const u32x2*)(proj + (size_t)tok * PROJW + 1536 + h * 128 + a * 16 + 4 * q);
#pragma unroll
        for (int j = 0; j < 4; ++j) { const int idx = F.tid + NTHR * j; *(LAS u32x4*)(VT2 + (idx >> 3) * 144 + (idx & 7) * 16) = sv[j]; }
#pragma unroll
        for (int j = 0; j < 8; ++j) { const int idx = F.tid + NTHR * j; *(LAS u32x4*)(SP2 + (idx >> 4) * 272 + (idx & 15) * 16) = sp[j]; }
#pragma unroll
        for (int st = 0; st < 4; ++st) {
            f32x4 sf = (f32x4){0.f, 0.f, 0.f, 0.f}, sb = (f32x4){0.f, 0.f, 0.f, 0.f};
#pragma unroll
            for (int ks = 0; ks < 2; ++ks) { sf = MFMA16(kf[st][ks], qh[ks], sf); sb = MFMA16(kb[st][ks], qh[2 + ks], sb); }
            const int t = tm * 16 + c, s0 = st * 16 + 4 * q;
            u32x2 o; o.x = pk2((s0 + 0) <= t ? sf[0] : sb[0], (s0 + 1) <= t ? sf[1] : sb[1]); o.y = pk2((s0 + 2) <= t ? sf[2] : sb[2], (s0 + 3) <= t ? sf[3] : sb[3]);
            *(LAS u32x2*)(Pw + c * 144 + s0 * 2) = o; }
        __syncthreads();
        bf16x8 pf[2];
#pragma unroll
        for (int ks = 0; ks < 2; ++ks) pf[ks] = frag_lds(Pw, 0, 144, ks * 32, F.lane);
        f32x4 acc[8];
#pragma unroll
        for (int a = 0; a < 8; ++a) acc[a] = (f32x4){0.f, 0.f, 0.f, 0.f};
        bf16x8 f0[8], f1[8];
#define GO_LD(dst, base, pitch, kk) { _Pragma("unroll") for (int a = 0; a < 8; ++a) dst[a] = frag_lds(base, sub * 128 + a * 16, pitch, (kk) * 32, F.lane); asm volatile("" ::: "memory"); }
#define GO_MM(src, bop) { _Pragma("unroll") for (int a = 0; a < 8; ++a) acc[a] = MFMA16(src[a], bop, acc[a]); }
        GO_LD(f0, VT2, 144, 0)
        GO_LD(f1, VT2, 144, 1)  GO_MM(f0, pf[0])
        GO_LD(f0, SP2, 272, 0)  GO_MM(f1, pf[1])
        GO_LD(f1, SP2, 272, 1)  GO_MM(f0, qh[0])
        GO_LD(f0, SP2, 272, 2)  GO_MM(f1, qh[1])
        GO_LD(f1, SP2, 272, 3)  GO_MM(f0, qh[2])
        GO_MM(f1, qh[3])
#undef GO_LD
#undef GO_MM
        float ss = 0.f;
#pragma unroll
        for (int a = 0; a < 8; ++a) ss += (acc[a][0] * acc[a][0] + acc[a][1] * acc[a][1]) + (acc[a][2] * acc[a][2] + acc[a][3] * acc[a][3]);
        ss += __shfl_xor(ss, 16); ss += __shfl_xor(ss, 32);
        const float rinv = rsqrtf(ss * (1.0f / 128.0f) + LN_EPS);
#pragma unroll
        for (int a = 0; a < 8; ++a) { const int e0 = h * 128 + a * 16 + 4 * q; const f32x4 nv = *(const f32x4*)(ng + e0);
            u32x2 o; o.x = pk2(acc[a][0] * rinv * nv[0] * siluf_(bf2f(gw[a].x & 0xffffu)), acc[a][1] * rinv * nv[1] * siluf_(bf2f(gw[a].x >> 16)));
            o.y = pk2(acc[a][2] * rinv * nv[2] * siluf_(bf2f(gw[a].y & 0xffffu)), acc[a][3] * rinv * nv[3] * siluf_(bf2f(gw[a].y >> 16)));
            *(u32x2*)(mixed + (size_t)tok * 1024 + 256 + e0) = o; }
        __syncthreads();
    }
}

__device__ __forceinline__ float rs32(const float (&pe)[32], int lane) {
    float r16[16], r8[8], r4[4], r2[2], r1;
    { const bool hi = (lane & 32) != 0;
#pragma unroll
        for (int i = 0; i < 16; ++i) { const float mine = hi ? pe[16 + i] : pe[i], oth = hi ? pe[i] : pe[16 + i]; r16[i] = mine + __shfl_xor(oth, 32); } }
    { const bool hi = (lane & 16) != 0;
#pragma unroll
        for (int i = 0; i < 8; ++i) { const float mine = hi ? r16[8 + i] : r16[i], oth = hi ? r16[i] : r16[8 + i]; r8[i] = mine + __shfl_xor(oth, 16); } }
    { const bool hi = (lane & 8) != 0;
#pragma unroll
        for (int i = 0; i < 4; ++i) { const float mine = hi ? r8[4 + i] : r8[i], oth = hi ? r8[i] : r8[4 + i]; r4[i] = mine + __shfl_xor(oth, 8); } }
    { const bool hi = (lane & 4) != 0;
#pragma unroll
        for (int i = 0; i < 2; ++i) { const float mine = hi ? r4[2 + i] : r4[i], oth = hi ? r4[i] : r4[2 + i]; r2[i] = mine + __shfl_xor(oth, 4); } }
    { const bool hi = (lane & 2) != 0; const float mine = hi ? r2[1] : r2[0], oth = hi ? r2[0] : r2[1]; r1 = mine + __shfl_xor(oth, 2); }
    r1 += __shfl_xor(r1, 1);
    return r1;
}
__device__ __forceinline__ float rs16(const float (&r16)[16], int lane) {
    float r8[8], r4[4], r2[2], r1;
    { const bool hi = (lane & 16) != 0;
#pragma unroll
        for (int i = 0; i < 8; ++i) { const float mine = hi ? r16[8 + i] : r16[i], oth = hi ? r16[i] : r16[8 + i]; r8[i] = mine + __shfl_xor(oth, 16); } }
    { const bool hi = (lane & 8) != 0;
#pragma unroll
        for (int i = 0; i < 4; ++i) { const float mine = hi ? r8[4 + i] : r8[i], oth = hi ? r8[i] : r8[4 + i]; r4[i] = mine + __shfl_xor(oth, 8); } }
    { const bool hi = (lane & 4) != 0;
#pragma unroll
        for (int i = 0; i < 2; ++i) { const float mine = hi ? r4[2 + i] : r4[i], oth = hi ? r4[i] : r4[2 + i]; r2[i] = mine + __shfl_xor(oth, 4); } }
    { const bool hi = (lane & 2) != 0; const float mine = hi ? r2[1] : r2[0], oth = hi ? r2[0] : r2[1]; r1 = mine + __shfl_xor(oth, 2); }
    r1 += __shfl_xor(r1, 1);
    return r1;
}
__device__ __forceinline__ void top4_store(float val, int lane, LAS int* topi_row, float* gate_row, volatile LAS int* hist, bool valid, LAS float* scr) {
    const int mye = lane >> 1;
    if ((lane & 1) == 0) scr[mye] = val;
    asm volatile("s_waitcnt lgkmcnt(0)" ::: "memory");
    int rank = 0;
#pragma unroll
    for (int i = 0; i < 8; ++i) { const f32x4 o = *(const LAS f32x4*)(scr + 4 * i);
#pragma unroll
        for (int j = 0; j < 4; ++j) asm volatile("v_cmp_gt_f32_e32 vcc, %1, %2\n\tv_addc_co_u32_e32 %0, vcc, 0, %0, vcc" : "+v"(rank) : "v"(o[j]), "v"(val) : "vcc"); }
    {
        const bool ev = (lane & 1) == 0;
        const bool ok = __builtin_popcountll(__ballot(ev && rank == 0)) == 1 && __builtin_popcountll(__ballot(ev && rank == 1)) == 1 && __builtin_popcountll(__ballot(ev && rank == 2)) == 1 && __builtin_popcountll(__ballot(ev && rank == 3)) == 1;
        if (!ok) { rank = 0;
#pragma unroll
            for (int i = 0; i < 8; ++i) { const f32x4 o = *(const LAS f32x4*)(scr + 4 * i);
#pragma unroll
                for (int j = 0; j < 4; ++j) { const int e2 = 4 * i + j; rank += (o[j] > val || (o[j] == val && e2 < mye)) ? 1 : 0; } } } }
    if ((lane & 1) == 0 && rank < 4) { scr[32 + rank] = val; ((LAS int*)scr)[36 + rank] = mye; }
    asm volatile("s_waitcnt lgkmcnt(0)" ::: "memory");
    const f32x4 tv = *(const LAS f32x4*)(scr + 32); const s32x4 te = *(const LAS s32x4*)(scr + 36);
    const float e1 = __expf(tv[1] - tv[0]), e2 = __expf(tv[2] - tv[0]), e3 = __expf(tv[3] - tv[0]); const float inv = 1.0f / (1.0f + e1 + e2 + e3);
    if (valid) {
        if (lane == 0) *(f32x4*)gate_row = (f32x4){inv, e1 * inv, e2 * inv, e3 * inv};
        if (lane < 4) { const int e = lane == 0 ? te[0] : (lane == 1 ? te[1] : (lane == 2 ? te[2] : te[3])); const int r = __hip_atomic_fetch_add((LAS int*)&hist[e], 1, __ATOMIC_RELAXED, __HIP_MEMORY_SCOPE_WORKGROUP); topi_row[lane] = e | (r << 8); } }
    asm volatile("s_waitcnt lgkmcnt(0)" ::: "memory");
}
__device__ __forceinline__ void ln1_router(const Frame& F0, CArgsP A, int l, int ntok, bool dry = false) {
    Frame F = F0; F.tid = opq(F0.tid); F.lane = F.tid & 63; F.wave = __builtin_amdgcn_readfirstlane(F.tid >> 6); F.ws = opq_p(F0.ws); F.bid = opq_s(F0.bid); F.G = opq_s(F0.G); F.lds = opq_l(F0.lds); F.CTLW = (volatile LAS unsigned*)(F.lds + LDSCTL_OFF);
    unsigned char* ws = F.ws;
    bf16_t* X = (bf16_t*)(ws + WS_X); const bf16_t* TMP = (const bf16_t*)(ws + WS_TMP); unsigned char* H8 = (unsigned char*)(ws + WS_QS); const float* mod = (const float*)(ws + WS_MOD) + (size_t)l * 5 * 6144;
    float* gate = (float*)(ws + WS_GATE);
    const float* lg = GIN(A, 25) + (size_t)(l * 2 + 0) * D; const float* lb = GIN(A, 26) + (size_t)(l * 2 + 0) * D;
    const float* rb = GIN(A, 28) + l * NEXP;
    LAS unsigned char* HS = F.lds;
    LAS float* PL = (LAS float*)(F.lds + 16 * 4112);
    volatile LAS int* hist = (volatile LAS int*)(F.CTLW + 32);
    LAS int* ltopi = (LAS int*)(F.lds + 90112);
    bf16x8 wh[2][4], wl[2][4];
    { const bf16_t* gh = (const bf16_t*)(ws + WS_WRH) + (size_t)l * 32768; const bf16_t* gl2 = (const bf16_t*)(ws + WS_WRL) + (size_t)l * 32768;
#pragma unroll
        for (int nt = 0; nt < 2; ++nt)
#pragma unroll
            for (int ks = 0; ks < 4; ++ks) { wh[nt][ks] = frag_glb(gh, nt * 16, 1024, F.wave * 128 + ks * 32, F.lane); wl[nt][ks] = frag_glb(gl2, nt * 16, 1024, F.wave * 128 + ks * 32, F.lane); } }
    if (F.tid < 32) hist[F.tid] = 0;
    LAS float* PV = (LAS float*)(F.lds + 92224);
    for (int i = F.tid; i < 512; i += NTHR) ((LAS f32x4*)PV)[i] = i < 256 ? *(const f32x4*)(lg + 4 * i) : *(const f32x4*)(lb + 4 * (i - 256));
    for (int i = F.tid; i < 5 * 768; i += NTHR) { const int vv = i / 768, r = i % 768; f32x4 x = *(const f32x4*)(mod + (size_t)vv * 6144 + 2048 + 4 * r); if (r >= 512) x += 1.0f; ((LAS f32x4*)(PV + 2048 + vv * 3072))[r] = x; }
    __syncthreads();
    const int per = ntok / F.G, t0 = F.bid * per;
    f32x4 xq[2][4]; u32x2 tq[2][4];
#define LN1_TOK(it_, k_) (t0 + (((it_) * 16 + F.wave * 2 + (k_)) < per ? ((it_) * 16 + F.wave * 2 + (k_)) : per - 1))
#pragma unroll
    for (int k = 0; k < 2; ++k)
#pragma unroll
        for (int j = 0; j < 4; ++j) { const int c = 4 * F.lane + 256 * j, t = LN1_TOK(0, k); xq[k][j] = unpk4(*(const u32x2*)(X + (size_t)t * D + c)); tq[k][j] = *(const u32x2*)(TMP + (size_t)t * D + c); }
    for (int it = 0; it * 16 < per; ++it) {
        int tk[2]; bool valid[2];
#pragma unroll
        for (int k = 0; k < 2; ++k) { const int ti = it * 16 + F.wave * 2 + k; valid[k] = ti < per; tk[k] = t0 + (valid[k] ? ti : per - 1); valid[k] = valid[k] && !dry; }
        f32x4 v[2][4]; float s[2] = {0.f, 0.f};
#pragma unroll
        for (int k = 0; k < 2; ++k) { const LAS float* mv = PV + 2048 + tok_vec(tk[k]) * 3072;
#pragma unroll
            for (int j = 0; j < 4; ++j) { const int c = 4 * F.lane + 256 * j; const f32x4 x = xq[k][j], g1 = *(const LAS f32x4*)(mv + c); const u32x2 tw = tq[k][j];
                const f32x4 tp = (f32x4){bf2f(tw.x & 0xffffu), bf2f(tw.x >> 16), bf2f(tw.y & 0xffffu), bf2f(tw.y >> 16)};
                v[k][j] = x * DN_ALPHA + g1 * tp; s[k] += (v[k][j][0] + v[k][j][1]) + (v[k][j][2] + v[k][j][3]); } }
#pragma unroll
        for (int k = 0; k < 2; ++k)
#pragma unroll
            for (int j = 0; j < 4; ++j) { const int c = 4 * F.lane + 256 * j, t = LN1_TOK(it + 1, k); xq[k][j] = unpk4(*(const u32x2*)(X + (size_t)t * D + c)); tq[k][j] = *(const u32x2*)(TMP + (size_t)t * D + c); }
        float mean[2], s2[2] = {0.f, 0.f}, rstd[2];
#pragma unroll
        for (int k = 0; k < 2; ++k) mean[k] = wave_sum(s[k]) * (1.0f / D);
#pragma unroll
        for (int k = 0; k < 2; ++k)
#pragma unroll
            for (int j = 0; j < 4; ++j) { v[k][j] = v[k][j] - mean[k]; s2[k] += (v[k][j][0] * v[k][j][0] + v[k][j][1] * v[k][j][1]) + (v[k][j][2] * v[k][j][2] + v[k][j][3] * v[k][j][3]); }
#pragma unroll
        for (int k = 0; k < 2; ++k) rstd[k] = rsqrtf(wave_sum(s2[k]) * (1.0f / D) + LN_EPS);
#pragma unroll
        for (int k = 0; k < 2; ++k) { const LAS float* mv = PV + 2048 + tok_vec(tk[k]) * 3072;
#pragma unroll
            for (int j = 0; j < 4; ++j) { const int c = 4 * F.lane + 256 * j; const f32x4 g = *(const LAS f32x4*)(PV + c), b = *(const LAS f32x4*)(PV + 1024 + c);
                const f32x4 xn = v[k][j] * rstd[k] * g + b;
                const f32x4 sh = *(const LAS f32x4*)(mv + 1024 + c), sc1 = *(const LAS f32x4*)(mv + 2048 + c); const f32x4 h = xn * sc1 + sh; v[k][j] = h;
                if (valid[k]) { *(u32x2*)(X + (size_t)tk[k] * D + c) = pk4(xn); *(unsigned*)(H8 + (size_t)tk[k] * D + c) = pk4_fp8(h[0], h[1], h[2], h[3]); }
                if (dry) asm volatile("" :: "v"(xn[0]), "v"(xn[1]), "v"(xn[2]), "v"(xn[3])); } }
#pragma unroll
        for (int k = 0; k < 2; ++k)
#pragma unroll
            for (int j = 0; j < 4; ++j) { const f32x4 h = v[k][j]; const unsigned h0 = f2bf(h[0]), h1 = f2bf(h[1]), h2b = f2bf(h[2]), h3 = f2bf(h[3]);
                u32x2 hi; hi.x = h0 | (h1 << 16); hi.y = h2b | (h3 << 16);
                u32x2 lo; lo.x = pk2(h[0] - bf2f(h0), h[1] - bf2f(h1)); lo.y = pk2(h[2] - bf2f(h2b), h[3] - bf2f(h3));
                LAS unsigned char* rowp = HS + (F.wave * 2 + k) * 4112 + (4 * F.lane + 256 * j) * 2;
                *(LAS u32x2*)rowp = hi; *(LAS u32x2*)(rowp + 2048) = lo; }
        __syncthreads();
        {   f32x4 pa[2] = {(f32x4){0.f, 0.f, 0.f, 0.f}, (f32x4){0.f, 0.f, 0.f, 0.f}};
#pragma unroll
            for (int ks = 0; ks < 4; ++ks) { const bf16x8 ah = frag_lds(HS, 0, 4112, F.wave * 128 + ks * 32, F.lane), al = frag_lds(HS, 0, 4112, 1024 + F.wave * 128 + ks * 32, F.lane);
#pragma unroll
                for (int nt = 0; nt < 2; ++nt) { pa[nt] = MFMA16(wh[nt][ks], ah, pa[nt]); pa[nt] = MFMA16(wl[nt][ks], ah, pa[nt]); pa[nt] = MFMA16(wh[nt][ks], al, pa[nt]); } }
            const int q = F.lane >> 4, c = F.lane & 15;
#pragma unroll
            for (int nt = 0; nt < 2; ++nt) *(LAS f32x4*)(PL + (F.wave * 16 + c) * 32 + nt * 16 + 4 * q) = pa[nt]; }
        __syncthreads();
        float l0 = rb[F.lane >> 1], l1 = l0;
#pragma unroll
        for (int w = 0; w < 8; ++w) { l0 += PL[(w * 16 + F.wave * 2 + 0) * 32 + (F.lane >> 1)]; l1 += PL[(w * 16 + F.wave * 2 + 1) * 32 + (F.lane >> 1)]; }
        if (dry) asm volatile("" :: "v"(l0), "v"(l1));
        LAS float* scr = (LAS float*)(F.lds + 16 * 4112 + 8 * 16 * 32 * 4) + F.wave * 96;
        top4_store(l0, F.lane, ltopi + (tk[0] - t0) * 4, gate + (size_t)tk[0] * 4, hist, valid[0], scr);
        top4_store(l1, F.lane, ltopi + (tk[1] - t0) * 4, gate + (size_t)tk[1] * 4, hist, valid[1], scr + 48);
    }
    __syncthreads();
    if (dry) return;
    {   unsigned* gc = (unsigned*)(ws + WS_CTL) + 64 + l * 960;
        unsigned* xbar = (unsigned*)(ws + WS_CTL) + CW_BAR;
        int* tok_slot = (int*)(ws + WS_TOKSLOT); unsigned short* slot_tok = (unsigned short*)(ws + WS_SLOTTOK); int* ecnt = (int*)(ws + WS_ECNT);
        volatile LAS int* tot = (volatile LAS int*)(F.CTLW + 64); volatile LAS int* cur = (volatile LAS int*)(F.CTLW + 96); volatile LAS int* ebase = (volatile LAS int*)(F.CTLW + 128);
        if (F.tid < 32) cur[F.tid] = (int)xb_add(gc + 16 * F.tid, (unsigned)hist[F.tid]);
        asm volatile("s_waitcnt vmcnt(0) lgkmcnt(0)" ::: "memory");
        __syncthreads();
        if (F.tid == 0) { (void)xb_add(gc + 16 * 32, 1u); XB_SPIN(xb_ld(gc + 16 * 32) != (unsigned)F.G, xbar); }
        __syncthreads();
        if (F.tid < 32) tot[F.tid] = (int)xb_ld(gc + 16 * F.tid);
        __syncthreads();
        if (F.tid == 0) { int p = 0; for (int e = 0; e < 32; ++e) { ebase[e] = p * 256; p += (tot[e] + 255) >> 8; } }
        __syncthreads();
        if (F.tid < 32) { cur[F.tid] += ebase[F.tid]; if (F.bid == 0) ecnt[F.tid] = tot[F.tid]; }
        __syncthreads();
        for (int i = F.tid; i < per * 4; i += NTHR) { const int v = ltopi[i]; const int slot = cur[v & 255] + (v >> 8);
            slot_tok[(slot >> 8) * 256 + 2 * (slot & 127) + ((slot >> 7) & 1)] = (unsigned short)(t0 + (i >> 2)); tok_slot[(size_t)t0 * 4 + i] = slot; }
        if (F.bid < 32) { const int e = F.bid; const int lo = ebase[e] + tot[e], hi = ebase[e] + (((tot[e] + 255) >> 8) << 8); for (int sl = lo + F.tid; sl < hi; sl += NTHR) slot_tok[(sl >> 8) * 256 + 2 * (sl & 127) + ((sl >> 7) & 1)] = 0; }
    }
}

__device__ __forceinline__ void moe_prefix(const Frame& F0) {
    Frame F = F0; F.tid = opq(F0.tid); F.lane = F.tid & 63; F.wave = __builtin_amdgcn_readfirstlane(F.tid >> 6); F.ws = opq_p(F0.ws); F.bid = opq_s(F0.bid); F.G = opq_s(F0.G); F.lds = opq_l(F0.lds); F.CTLW = (volatile LAS unsigned*)(F.lds + LDSCTL_OFF);
    const int* ecnt = (const int*)(F.ws + WS_ECNT); volatile LAS int* pref = (volatile LAS int*)(F.CTLW + 160);
    __syncthreads();
    if (F.tid < 32) {
        const int c = (ecnt[F.tid] + 255) >> 8; int incl = c;
#pragma unroll
        for (int o = 1; o < 32; o <<= 1) { const int v = __shfl_up(incl, o, 32); if (F.tid >= o) incl += v; }
        pref[F.tid] = incl - c; if (F.tid == 31) pref[32] = incl; }
    __syncthreads();
}

__device__ __forceinline__ void combine_ln2(const Frame& F0, CArgsP A, int l, int ntok, bool dry = false) {
    Frame F = F0; F.tid = opq(F0.tid); F.lane = F.tid & 63; F.wave = __builtin_amdgcn_readfirstlane(F.tid >> 6); F.ws = opq_p(F0.ws); F.bid = opq_s(F0.bid); F.G = opq_s(F0.G); F.lds = opq_l(F0.lds); F.CTLW = (volatile LAS unsigned*)(F.lds + LDSCTL_OFF);
    unsigned char* ws = F.ws;
    bf16_t* X = (bf16_t*)(ws + WS_X); bf16_t* H = (bf16_t*)(ws + WS_H); const unsigned char* YV = (const unsigned char*)(ws + WS_YV);
    const float* mod = (const float*)(ws + WS_MOD) + (size_t)l * 5 * 6144; const float* modn = (const float*)(ws + WS_MOD) + (size_t)(l + 1 < DEPTH ? l + 1 : l) * 5 * 6144;
    const int* tok_slot = (const int*)(ws + WS_TOKSLOT); const float* gate = (const float*)(ws + WS_GATE);
    const float* lg = GIN(A, 25) + (size_t)(l * 2 + 1) * D; const float* lb = GIN(A, 26) + (size_t)(l * 2 + 1) * D;
    const bool lastl = (l == DEPTH - 1);
    const int stride = F.G * NWAVES, tb0 = F.bid * NWAVES + F.wave;
    LAS float* PV = (LAS float*)F.lds;
    for (int i = F.tid; i < 512; i += NTHR) ((LAS f32x4*)PV)[i] = i < 256 ? *(const f32x4*)(lg + 4 * i) : *(const f32x4*)(lb + 4 * (i - 256));
    for (int i = F.tid; i < 5 * 768; i += NTHR) { const int vv = i / 768, r = i % 768; f32x4 x = r < 256 ? *(const f32x4*)(mod + (size_t)vv * 6144 + 5120 + 4 * r) : *(const f32x4*)(modn + (size_t)vv * 6144 + 4 * (r - 256));
        if (r >= 512) x += 1.0f; ((LAS f32x4*)(PV + 2048 + vv * 3072))[r] = x; }
    __syncthreads();
#define CMB_TOK(it_, k_) ((tb0 + (2 * (it_) + (k_)) * stride) < ntok ? (tb0 + (2 * (it_) + (k_)) * stride) : tb0)
    s32x4 slq[2]; f32x4 gtq[2], gtc[2]; unsigned yq[2][4][4]; f32x4 xq[2][4];
#pragma unroll
    for (int k = 0; k < 2; ++k) { const int t = CMB_TOK(0, k); slq[k] = *(const s32x4*)(tok_slot + (size_t)t * 4); gtq[k] = *(const f32x4*)(gate + (size_t)t * 4); }
#pragma unroll
    for (int k = 0; k < 2; ++k) { const int t = CMB_TOK(0, k); gtc[k] = gtq[k];
#pragma unroll
        for (int j = 0; j < 4; ++j) { const int c = 4 * F.lane + 256 * j; xq[k][j] = unpk4(*(const u32x2*)(X + (size_t)t * D + c));
#pragma unroll
            for (int e = 0; e < 4; ++e) yq[k][e][j] = *(const unsigned*)(YV + (size_t)slq[k][e] * 1024 + c); } }
#pragma unroll
    for (int k = 0; k < 2; ++k) { const int t = CMB_TOK(1, k); slq[k] = *(const s32x4*)(tok_slot + (size_t)t * 4); gtq[k] = *(const f32x4*)(gate + (size_t)t * 4); }
    for (int it = 0; tb0 + 2 * it * stride < ntok; ++it) {
        int tk[2]; bool valid[2];
#pragma unroll
        for (int k = 0; k < 2; ++k) { const int t = tb0 + (2 * it + k) * stride; valid[k] = (t < ntok) && !dry; tk[k] = t < ntok ? t : tb0; }
        f32x4 v[2][4]; float s[2] = {0.f, 0.f};
#pragma unroll
        for (int k = 0; k < 2; ++k) { const LAS float* mv = PV + 2048 + tok_vec(tk[k]) * 3072; const f32x4 gt = gtc[k];
#pragma unroll
            for (int j = 0; j < 4; ++j) { const int c = 4 * F.lane + 256 * j;
                f32x4 f = (f32x4){0.f, 0.f, 0.f, 0.f};
#pragma unroll
                for (int e = 0; e < 4; ++e) { const f32x2 lo = __builtin_amdgcn_cvt_pk_f32_fp8((int)yq[k][e][j], false), hi = __builtin_amdgcn_cvt_pk_f32_fp8((int)yq[k][e][j], true);
                    const float ge = gt[e] * (1.0f / YV_SCALE); f[0] += ge * lo.x; f[1] += ge * lo.y; f[2] += ge * hi.x; f[3] += ge * hi.y; }
                const f32x4 x = xq[k][j], g2 = *(const LAS f32x4*)(mv + c);
                v[k][j] = x * DN_ALPHA + g2 * f; s[k] += (v[k][j][0] + v[k][j][1]) + (v[k][j][2] + v[k][j][3]); } }
#pragma unroll
        for (int k = 0; k < 2; ++k) { const int t = CMB_TOK(it + 1, k); gtc[k] = gtq[k];
#pragma unroll
            for (int j = 0; j < 4; ++j) { const int c = 4 * F.lane + 256 * j; xq[k][j] = unpk4(*(const u32x2*)(X + (size_t)t * D + c));
#pragma unroll
                for (int e = 0; e < 4; ++e) yq[k][e][j] = *(const unsigned*)(YV + (size_t)slq[k][e] * 1024 + c); } }
#pragma unroll
        for (int k = 0; k < 2; ++k) { const int t = CMB_TOK(it + 2, k); slq[k] = *(const s32x4*)(tok_slot + (size_t)t * 4); gtq[k] = *(const f32x4*)(gate + (size_t)t * 4); }
        float mean[2], s2[2] = {0.f, 0.f}, rstd[2];
#pragma unroll
        for (int k = 0; k < 2; ++k) mean[k] = wave_sum(s[k]) * (1.0f / D);
#pragma unroll
        for (int k = 0; k < 2; ++k)
#pragma unroll
            for (int j = 0; j < 4; ++j) { v[k][j] = v[k][j] - mean[k]; s2[k] += (v[k][j][0] * v[k][j][0] + v[k][j][1] * v[k][j][1]) + (v[k][j][2] * v[k][j][2] + v[k][j][3] * v[k][j][3]); }
#pragma unroll
        for (int k = 0; k < 2; ++k) rstd[k] = rsqrtf(wave_sum(s2[k]) * (1.0f / D) + LN_EPS);
        if (dry) asm volatile("" :: "v"(rstd[0]), "v"(rstd[1]));
#pragma unroll
        for (int k = 0; k < 2; ++k) { if (!valid[k]) continue; const LAS float* mn = PV + 2048 + tok_vec(tk[k]) * 3072;
#pragma unroll
            for (int j = 0; j < 4; ++j) { const int c = 4 * F.lane + 256 * j; const f32x4 g = *(const LAS f32x4*)(PV + c), b = *(const LAS f32x4*)(PV + 1024 + c); const f32x4 xn = v[k][j] * rstd[k] * g + b;
                if (lastl) { *(f32x4*)(GOUT(A) + (size_t)tk[k] * D + c) = xn; }
                else { *(u32x2*)(X + (size_t)tk[k] * D + c) = pk4(xn); const f32x4 sh = *(const LAS f32x4*)(mn + 1024 + c), sc1 = *(const LAS f32x4*)(mn + 2048 + c); const f32x4 h = xn * sc1 + sh;
                    u32x2 o; o.x = pk2(h[0], h[1]); o.y = pk2(h[2], h[3]); *(u32x2*)(H + (size_t)tk[k] * D + c) = o; } } }
    }
}

#ifndef STAGGER_UP
#define STAGGER_UP 0
#endif
#ifndef STAGGER_DN
#define STAGGER_DN 0
#endif
__device__ __forceinline__ void stagger(int bid, int step) {
    if (step > 0) { const unsigned long long t0 = __builtin_amdgcn_s_memrealtime(), d = (unsigned long long)((bid & 7) * step);
        while (__builtin_amdgcn_s_memrealtime() - t0 < d) __builtin_amdgcn_s_sleep(8); }
}
constexpr int NPL = 10, NPH = 3 + DEPTH * NPL;
#ifndef REPMASK
#define REPMASK 0u
#endif
__device__ __forceinline__ int reps_of(int b) { int r = 1 + (int)((REPMASK >> b) & 1u); if (REPMASK != 0u) asm volatile("" : "+s"(r)); return r; }

__global__ void __launch_bounds__(NTHR, 2) hybrid_fwd(Args args) {
    extern __shared__ __attribute__((aligned(16))) unsigned char lds[];
    Frame F;
    F.lds = (LAS unsigned char*)lds; F.CTLW = (volatile LAS unsigned*)(F.lds + LDSCTL_OFF);
    F.tid = threadIdx.x; F.lane = F.tid & 63; F.wave = __builtin_amdgcn_readfirstlane(F.tid >> 6); F.G = gridDim.x; F.bid = blockIdx.x; F.ws = args.ws;
    unsigned char* ws = args.ws;
    for (int u = F.tid; u < 256; u += NTHR) F.CTLW[u] = 0u;
    __syncthreads();
    XcdBarrier bar; bar.bar = (unsigned*)(ws + WS_CTL) + CW_BAR; bar.x = 0; bar.st = nullptr;
    if (MK_N_LAUNCHES == 1) bar = xcd_barrier_post((unsigned*)(ws + WS_CTL) + CW_BAR, F.CTLW + 8);
    const int lo = args.ph_lo, hi = args.ph_hi;
#ifndef PHMASK
#define PHMASK 0xFFFFFFFFu
#endif
#define IN(k) (lo <= (k) && (k) < hi)
#define ON(b) ((PHMASK >> (b)) & 1u)
#define REPS(b) reps_of(b)
#define REPBAR(b) do { if (rep + 1 < REPS(b)) { XcdBarrier _b = bar; _b.bar = (unsigned*)opq_p((unsigned char*)_b.bar); asm volatile("" : "+s"(_b.x)); xcd_barrier(_b); } } while (0)
#ifndef NBAR
#define NBAR 1
#endif
#define SEAM(k) do { if (IN((k) + 1)) { for (int _r = 0; _r < NBAR; ++_r) { XcdBarrier _b = bar; _b.bar = (unsigned*)opq_p((unsigned char*)_b.bar); asm volatile("" : "+s"(_b.x)); xcd_barrier(_b); } } } while (0)
    if (ON(0) && IN(0)) { for (int rep = 0; rep < REPS(0); ++rep) { ph0_prologue(F, argp()); REPBAR(0); } SEAM(0); }
    if (ON(1) && IN(1)) { ph1_mod(F, argp()); SEAM(1); }
    if (ON(2) && IN(2)) { ph2_init(F, argp()); SEAM(2); }
    for (int l = 0; l < DEPTH; ++l) {
        const int pb = 3 + l * NPL;
        const int ntok = (l == DEPTH - 1) ? TLAT : T;
        if (ON(3) && IN(pb + 0)) { for (int rep = 0; rep < REPS(3); ++rep) {
            unsigned char* ws = opq_p(F.ws); CArgsP AP = argp(); (void)AP;
            typedef pg8::DenseSched<T / 256, NINP / 256> SchedT; SchedT S{(const char*)(ws + WS_H), (const char*)(ws + WS_WIN) + (size_t)l * NINP * 2048, (size_t)256 * 2048, (size_t)256 * 2048, opq_s(F.G), opq_s(F.bid), T / 256};
            EpiInProj E{(bf16_t*)(ws + WS_PROJ), (bf16_t*)(ws + WS_UCAT), (float*)(ws + WS_GL), (bf16_t*)(ws + WS_VT), (float*)(ws + WS_STAT)};
            pg8::gemm_phase<EpiInProj, SchedT, false>(F.lds, 2048u, 2048u, 1024, S, E);
            if (opq_s(F.bid) >= 40) conv_slot(F, argp(), l, 0, opq_s(F.bid) - 40);
            REPBAR(3); } SEAM(pb + 0);
        }
        if (ON(4) && IN(pb + 1)) { for (int rep = 0; rep < REPS(4); ++rep) {
            unsigned char* ws = opq_p(F.ws); CArgsP AP = argp(); (void)AP;
            typedef pg8::BatchSched<NCHP / 256, 1, 16> SchedT; SchedT S{(const char*)(ws + WS_UCAT), (const char*)(ws + WS_S5F) + (size_t)l * 16 * 256 * 2048, (size_t)NCHP * S5K * 2, (size_t)256 * 2048, (size_t)256 * S5K * 2, (size_t)256 * 2048, opq_s(F.G), (opq_s(F.bid) + 128) & 255};
            EpiHloc E{(float*)(ws + WS_HLOC)};
#ifndef SUBMASK
#define SUBMASK 7
#endif
            if (SUBMASK & 1) pg8::gemm_phase<EpiHloc, SchedT, false>(F.lds, (unsigned)(S5K * 2), 2048u, 1024, S, E);
            __syncthreads();
#ifndef SUBREP
#define SUBREP 0
#endif
            if (SUBMASK & 2) gla_local(F, argp(), l);
            if (SUBREP & 2) { __syncthreads(); gla_local(F, argp(), l); }
            __syncthreads(); asm volatile("" ::: "memory");
            if (SUBMASK & 4) sgu_phase(F, argp(), l);
            if (SUBREP & 4) { __syncthreads(); sgu_phase(F, argp(), l); }
            REPBAR(4); } SEAM(pb + 1);
        }
        if (ON(5) && IN(pb + 2)) { for (int rep = 0; rep < REPS(5); ++rep) { scan_phase(F, argp(), l); REPBAR(5); } SEAM(pb + 2); }
        if (ON(6) && IN(pb + 3)) { for (int rep = 0; rep < REPS(6); ++rep) {
            unsigned char* ws = opq_p(F.ws); CArgsP AP = argp(); (void)AP;
            typedef pg8::BatchSched<NCHP / 256, 4, 16> SchedT; SchedT S{(const char*)(ws + WS_UCAT), (const char*)(ws + WS_S5M) + (size_t)l * 16 * 1024 * S5K * 2, (size_t)NCHP * S5K * 2, (size_t)1024 * S5K * 2, (size_t)256 * S5K * 2, (size_t)256 * S5K * 2, opq_s(F.G), opq_s(F.bid)};
            EpiS5Y E{(bf16_t*)(ws + WS_YS5)};
            pg8::gemm_phase<EpiS5Y, SchedT, false>(F.lds, (unsigned)(S5K * 2), (unsigned)(S5K * 2), S5K, S, E);
            __syncthreads();
            gla_out(F, argp(), l);
            if (opq_s(F.bid) >= 224) conv_slot(F, argp(), l, CONV_B_GO + 32 * CONV_PER_WG, opq_s(F.bid) - 224, 2 * CONV_PER_WG);
            else if (opq_s(F.bid) >= 192) conv_slot(F, argp(), l, CONV_B_GO, opq_s(F.bid) - 192);
            REPBAR(6); } SEAM(pb + 3);
        }
        if (ON(7) && IN(pb + 4)) { for (int rep = 0; rep < REPS(7); ++rep) {
            unsigned char* ws = opq_p(F.ws); CArgsP AP = argp(); (void)AP;
            typedef pg8::DenseSched<T / 256, 1> SchedT; SchedT S{(const char*)(ws + WS_YS5), (const char*)(ws + WS_GLUT) + (size_t)l * 256 * 512, (size_t)256 * 512, (size_t)256 * 512, opq_s(F.G), opq_s(F.bid), T / 256};
            EpiGlu E{(const bf16_t*)(ws + WS_YS5), (bf16_t*)(ws + WS_MIXED), GIN(AP, 23) + l * 256};
            pg8::gemm_phase<EpiGlu, SchedT, false>(F.lds, 512u, 512u, 256, S, E);
            if (opq_s(F.bid) >= 132) conv_slot(F, argp(), l, CONV_B_GLU, opq_s(F.bid) - 132);
            REPBAR(7); } SEAM(pb + 4);
        }
        if (ON(8) && IN(pb + 5)) { for (int rep = 0; rep < REPS(8); ++rep) {
            unsigned char* ws = opq_p(F.ws); CArgsP AP = argp(); (void)AP;
            typedef pg8::DenseSched<T / 256, 4> SchedT; SchedT S{(const char*)(ws + WS_MIXED), (const char*)(ws + WS_WOUT) + (size_t)l * 1024 * 2048, (size_t)256 * 2048, (size_t)256 * 2048, opq_s(F.G), opq_s(F.bid), opq_s(ntok / 256)};
            EpiBf16 E{(bf16_t*)(ws + WS_TMP), 1024};
            pg8::gemm_phase<EpiBf16, SchedT, false>(F.lds, 2048u, 2048u, 1024, S, E);
            if (l < DEPTH - 1 && opq_s(F.bid) >= 16) conv_slot(F, argp(), l, CONV_B_OUT, opq_s(F.bid) - 16);
            REPBAR(8); } SEAM(pb + 5);
        }
        if (ON(9) && IN(pb + 6)) { if (REPMASK & 0x200u) { ln1_router(F, argp(), l, ntok, true); __syncthreads(); } ln1_router(F, argp(), l, ntok); SEAM(pb + 6); }
        if (ON(11) && IN(pb + 7)) { for (int rep = 0; rep < REPS(11); ++rep) {
            unsigned char* ws = opq_p(F.ws); CArgsP AP = argp(); (void)AP;
            moe_prefix(F); stagger(F.bid, STAGGER_UP);
            pg8::MoeSched<8, true> S{(const char*)(ws + WS_QS), (const char*)(ws + WS_WUP) + (size_t)l * 32 * 2048 * 1024, (const int*)(ws + WS_SLOTTOK), (const LAS int*)(F.CTLW + 160), 0, (size_t)2048 * 1024, (size_t)256 * 1024, opq_s(F.G), opq_s(F.bid)};
            EpiUp E{(unsigned char*)(ws + WS_ACT), (const bf16_t*)(ws + WS_BUP) + (size_t)l * 32 * 2048};
            pg8::gemm_phase<EpiUp, pg8::MoeSched<8, true>, true, true>(F.lds, 1024u, 1024u, 1024, S, E);
            REPBAR(11); } SEAM(pb + 7);
        }
        if (ON(12) && IN(pb + 8)) { for (int rep = 0; rep < REPS(12); ++rep) {
            unsigned char* ws = opq_p(F.ws); CArgsP AP = argp(); (void)AP;
            moe_prefix(F); stagger(F.bid, STAGGER_DN);
            pg8::MoeSched<4, false> S{(const char*)(ws + WS_ACT), (const char*)(ws + WS_WDN) + (size_t)l * 32 * 1024 * 1024, (const int*)(ws + WS_SLOTTOK), (const LAS int*)(F.CTLW + 160), (size_t)256 * 1024, (size_t)1024 * 1024, (size_t)256 * 1024, opq_s(F.G), opq_s(F.bid)};
            EpiDown E{(unsigned char*)(ws + WS_YV), (const bf16_t*)(ws + WS_BDN) + (size_t)l * 32 * 1024};
            pg8::gemm_phase<EpiDown, pg8::MoeSched<4, false>, false, true>(F.lds, 1024u, 1024u, 1024, S, E);
            if (l + 1 < DEPTH && opq_s(F.bid) >= 192) conv_slot(F, argp(), l + 1, conv_q(l + 1) - CONV_DN, opq_s(F.bid) - 192);
            REPBAR(12); } SEAM(pb + 8);
        }
        if (ON(13) && IN(pb + 9)) { if (REPMASK & 0x2000u) { combine_ln2(F, argp(), l, ntok, true); __syncthreads(); } combine_ln2(F, argp(), l, ntok); SEAM(pb + 9); }
    }
#undef IN
#undef SEAM
}

extern "C" void kernel_launch(void* const* d_in, const int* in_sizes, int n_in, void* d_out, int out_size, void* d_ws, size_t ws_size, hipStream_t stream) {
    static int grid = 0;
    if (grid == 0) {
        if (n_in != 33 || out_size != TLAT * D || ws_size < WS_END) { fprintf(stderr, "kernel_launch: unexpected problem (n_in %d, out %d, ws %zu)\n", n_in, out_size, ws_size); grid = -1; return; }
        int dev = 0, cus = 0, per_cu = 0;
        if (hipGetDevice(&dev) != hipSuccess || hipDeviceGetAttribute(&cus, hipDeviceAttributeMultiprocessorCount, dev) != hipSuccess) { grid = -1; return; }
        if (hipFuncSetAttribute((const void*)hybrid_fwd, hipFuncAttributeMaxDynamicSharedMemorySize, LDS_BYTES) != hipSuccess) { fprintf(stderr, "kernel_launch: hipFuncSetAttribute failed\n"); grid = -1; return; }
        if (hipOccupancyMaxActiveBlocksPerMultiprocessor(&per_cu, (const void*)hybrid_fwd, NTHR, LDS_BYTES) != hipSuccess || per_cu < 1) fprintf(stderr, "kernel_launch: occupancy query says %d\n", per_cu);
        (void)hipGetLastError();
        grid = cus;
        if (grid != 256) { fprintf(stderr, "kernel_launch: built for 256 CUs, found %d\n", cus); grid = -1; return; }
    }
    if (grid < 0) return;
    if (hipMemsetAsync((char*)d_ws + WS_CTL, 0, CTL_ZERO_BYTES, stream) != hipSuccess) return;
    Args a{};
    for (int i = 0; i < 33; ++i) a.in[i] = (const float*)d_in[i];
    a.out = (float*)d_out; a.ws = (unsigned char*)d_ws;
#if MK_N_LAUNCHES == 1
    a.ph_lo = 0; a.ph_hi = NPH;
    hipLaunchKernelGGL(hybrid_fwd, dim3(grid), dim3(NTHR), LDS_BYTES, stream, a);
#else
    for (int p = 0; p < NPH; ++p) { a.ph_lo = p; a.ph_hi = p + 1; hipLaunchKernelGGL(hybrid_fwd, dim3(grid), dim3(NTHR), LDS_BYTES, stream, a); }
#endif
}
```
